# Optimizing an MI355X kernel written in HIP

```python
import jax, jax.numpy as jnp
from jax import lax
import numpy as np


D_MODEL = 2048
BATCH = 4
SEQ = 2048
DEPTH = 1
DEC_BATCH = 128
DEC_SEQ = 1
PAST_LEN = 16384
PAGE_SIZE = 128

D_MIX = D_MODEL
D_CHUNK = D_MIX // 2
CHUNK_HEADS = 8
CHUNK_HEAD_DIM = D_CHUNK // CHUNK_HEADS
CHUNK_LEN = 128
D_SSM = D_MIX - D_CHUNK
SSM_HEAD_DIM = 64
SSM_HEADS = D_SSM // SSM_HEAD_DIM
SSM_GROUPS = 2
SSM_HEADS_PER_GROUP = SSM_HEADS // SSM_GROUPS
D_STATE = 128
CONV_W = 4
CONV_DIM = D_SSM + 2 * SSM_GROUPS * D_STATE
SSD_CHUNK = 128
D_IN_PROJ = 2 * D_CHUNK + D_SSM + CONV_DIM + SSM_HEADS
D_FF = -(-8 * D_MODEL // (3 * 256)) * 256
EPS = 1e-6

kernel_name = 'hybrid_chunkmlp_ssd_decoder_step'


def rmsnorm(x, g):
    xf = x.astype(jnp.float32)
    y = xf * lax.rsqrt(jnp.mean(xf * xf, axis=-1, keepdims=True) + EPS)
    return (y * g.astype(jnp.float32)).astype(x.dtype)


def chunk_spatial_gate(u, v, w_s, b_s):
    bsz, t = v.shape[:2]
    L = min(CHUNK_LEN, t)
    n_c = -(-t // L)
    pad = n_c * L - t
    vc = jnp.pad(v, ((0, 0), (0, pad), (0, 0), (0, 0))).reshape(bsz, n_c, L, CHUNK_HEADS, CHUNK_HEAD_DIM)
    causal = jnp.tril(jnp.ones((L, L), bool))
    w = jnp.where(causal[None], w_s[:, :L, :L], 0.0).astype(vc.dtype)
    mixed = jnp.einsum('hts,bcshd->bcthd', w, vc) + b_s[:, :L].T.astype(vc.dtype)[None, None, :, :, None]
    mixed = mixed.reshape(bsz, n_c * L, CHUNK_HEADS, CHUNK_HEAD_DIM)[:, :t]
    return u * mixed


def ssd_scan(x, dt, a, bm, cm, h0):
    bsz, t = x.shape[:2]
    Q = min(SSD_CHUNK, t)
    n_c = -(-t // Q)
    pad = n_c * Q - t

    def chunks(z):
        z = jnp.pad(z, [(0, 0), (0, pad)] + [(0, 0)] * (z.ndim - 2))
        return z.reshape((bsz, n_c, Q) + z.shape[2:])

    xc, dtc, bc, cc = chunks(x), chunks(dt), chunks(bm), chunks(cm)
    acum = jnp.moveaxis(jnp.cumsum(dtc * a, axis=2), 2, -1)
    diff = acum[..., :, None] - acum[..., None, :]
    causal = jnp.tril(jnp.ones((Q, Q), bool))
    decay = jnp.exp(jnp.where(causal, diff, -jnp.inf))
    xdt = xc * dtc[..., None]
    cb = jnp.einsum('bctgn,bcsgn->bcgts', cc, bc)
    y_diag = jnp.einsum('bcgets,bcsgep->bctgep', cb[:, :, :, None] * decay, xdt)
    a_last = acum[..., -1]
    to_end = jnp.exp(a_last[..., None] - acum)
    states = jnp.einsum('bcsgn,bcges,bcsgep->bcgepn', bc, to_end, xdt)

    def step(h, inp):
        st, al = inp
        return h * jnp.exp(al)[..., None, None] + st, h

    h_final, h_prev = lax.scan(step, h0, (jnp.moveaxis(states, 1, 0), jnp.moveaxis(a_last, 1, 0)))
    h_prev = jnp.moveaxis(h_prev, 0, 1)
    y_off = jnp.einsum('bctgn,bcgepn,bcget->bctgep', cc, h_prev, jnp.exp(acum))
    y = (y_diag + y_off).reshape(bsz, n_c * Q, SSM_GROUPS, SSM_HEADS_PER_GROUP, SSM_HEAD_DIM)[:, :t]
    return y, h_final


def hybrid_layer(x, conv_prefix, h0, norm_mix_g, w_in, chunk_v_norm_g, chunk_w_s, chunk_b_s,
                 chunk_out_norm_g, ssd_conv_w, ssd_conv_b, ssd_dt_bias, ssd_a_log, ssd_d,
                 ssd_norm_g, w_out, norm_ffn_g, w_gate, w_up, w_down):
    bsz, t, _ = x.shape
    n = rmsnorm(x, norm_mix_g)
    proj = n @ w_in
    splits = [D_CHUNK, 2 * D_CHUNK, 2 * D_CHUNK + D_SSM, 2 * D_CHUNK + D_SSM + CONV_DIM]
    u_raw, v_raw, z, xbc, dt_raw = jnp.split(proj, splits, axis=-1)

    u = jax.nn.gelu(u_raw).reshape(bsz, t, CHUNK_HEADS, CHUNK_HEAD_DIM)
    v_rows = rmsnorm(jax.nn.gelu(v_raw), chunk_v_norm_g)
    y_a = chunk_spatial_gate(u, v_rows.reshape(bsz, t, CHUNK_HEADS, CHUNK_HEAD_DIM), chunk_w_s, chunk_b_s)
    y_a = rmsnorm(y_a.reshape(bsz, t, D_CHUNK), chunk_out_norm_g)

    padded = jnp.concatenate([conv_prefix.astype(xbc.dtype), xbc], axis=1)
    conv = ssd_conv_b
    for k in range(CONV_W):
        conv = conv + padded[:, k:k + t] * ssd_conv_w[k]
    xbc_act = jax.nn.silu(conv)
    new_conv = padded[:, -(CONV_W - 1):]
    xs, bm, cm = jnp.split(xbc_act, [D_SSM, D_SSM + SSM_GROUPS * D_STATE], axis=-1)
    xs = xs.astype(jnp.float32).reshape(bsz, t, SSM_GROUPS, SSM_HEADS_PER_GROUP, SSM_HEAD_DIM)
    bm = bm.astype(jnp.float32).reshape(bsz, t, SSM_GROUPS, D_STATE)
    cm = cm.astype(jnp.float32).reshape(bsz, t, SSM_GROUPS, D_STATE)
    dt = jax.nn.softplus(dt_raw.astype(jnp.float32) + ssd_dt_bias.astype(jnp.float32))
    dt = dt.reshape(bsz, t, SSM_GROUPS, SSM_HEADS_PER_GROUP)
    a = -jnp.exp(ssd_a_log.astype(jnp.float32)).reshape(SSM_GROUPS, SSM_HEADS_PER_GROUP)
    h0g = h0.astype(jnp.float32).reshape(bsz, SSM_GROUPS, SSM_HEADS_PER_GROUP, SSM_HEAD_DIM, D_STATE)
    y_b, h_final = ssd_scan(xs, dt, a, bm, cm, h0g)
    y_b = y_b + ssd_d.astype(jnp.float32).reshape(SSM_GROUPS, SSM_HEADS_PER_GROUP)[..., None] * xs
    y_b = y_b.reshape(bsz, t, D_SSM) * jax.nn.silu(z.astype(jnp.float32))
    y_b = y_b.reshape(bsz, t, SSM_GROUPS, D_SSM // SSM_GROUPS)
    y_b = y_b * lax.rsqrt(jnp.mean(y_b * y_b, axis=-1, keepdims=True) + EPS)
    y_b = (y_b.reshape(bsz, t, D_SSM) * ssd_norm_g.astype(jnp.float32)).astype(x.dtype)

    h = x + jnp.concatenate([y_a, y_b], axis=-1) @ w_out
    m = rmsnorm(h, norm_ffn_g)
    h = h + (jax.nn.silu(m @ w_gate) * (m @ w_up)) @ w_down
    new_ssm = h_final.reshape(bsz, SSM_HEADS, SSM_HEAD_DIM, D_STATE)
    return h, new_conv, new_ssm, v_rows


def setup_inputs(seed: int = 0) -> dict:
    key = jax.random.key(seed)
    ks = jax.random.split(key, 24)
    f32 = jnp.float32

    def nrm(k, shape, scale):
        return jax.random.normal(k, shape, f32) * scale

    dt0 = jnp.exp(jax.random.uniform(ks[12], (DEPTH, SSM_HEADS), f32, np.log(1e-3), np.log(1e-1)))
    return {
        'x_prompt': nrm(ks[0], (BATCH, SEQ, D_MODEL), 1.0),
        'x_sample': nrm(ks[1], (DEC_BATCH, DEC_SEQ, D_MODEL), 1.0),
        'state_conv': nrm(ks[2], (DEPTH, DEC_BATCH, CONV_W - 1, CONV_DIM), 1.0),
        'state_ssm': nrm(ks[3], (DEPTH, DEC_BATCH, SSM_HEADS, SSM_HEAD_DIM, D_STATE), 0.3),
        'norm_mix_g': 1.0 + nrm(ks[4], (DEPTH, D_MODEL), 0.05),
        'w_in': nrm(ks[5], (DEPTH, D_MODEL, D_IN_PROJ), D_MODEL ** -0.5),
        'chunk_v_norm_g': 1.0 + nrm(ks[6], (DEPTH, D_CHUNK), 0.05),
        'chunk_w_s': nrm(ks[7], (DEPTH, CHUNK_HEADS, CHUNK_LEN, CHUNK_LEN), CHUNK_LEN ** -0.5),
        'chunk_b_s': 1.0 + nrm(ks[8], (DEPTH, CHUNK_HEADS, CHUNK_LEN), 0.1),
        'chunk_out_norm_g': 1.0 + nrm(ks[9], (DEPTH, D_CHUNK), 0.05),
        'ssd_conv_w': nrm(ks[10], (DEPTH, CONV_W, CONV_DIM), CONV_W ** -0.5),
        'ssd_conv_b': nrm(ks[11], (DEPTH, CONV_DIM), 0.02),
        'ssd_dt_bias': dt0 + jnp.log(-jnp.expm1(-dt0)),
        'ssd_a_log': jnp.log(jax.random.uniform(ks[13], (DEPTH, SSM_HEADS), f32, 1.0, 16.0)),
        'ssd_d': 1.0 + nrm(ks[14], (DEPTH, SSM_HEADS), 0.1),
        'ssd_norm_g': 1.0 + nrm(ks[15], (DEPTH, D_SSM), 0.05),
        'w_out': nrm(ks[16], (DEPTH, D_MIX, D_MODEL), D_MIX ** -0.5),
        'norm_ffn_g': 1.0 + nrm(ks[17], (DEPTH, D_MODEL), 0.05),
        'w_gate': nrm(ks[18], (DEPTH, D_MODEL, D_FF), D_MODEL ** -0.5),
        'w_up': nrm(ks[19], (DEPTH, D_MODEL, D_FF), D_MODEL ** -0.5),
        'w_down': nrm(ks[20], (DEPTH, D_FF, D_MODEL), D_FF ** -0.5),
        'norm_final_g': 1.0 + nrm(ks[21], (D_MODEL,), 0.05),
    }


def reference(x_prompt, x_sample, state_conv, state_ssm, norm_mix_g, w_in, chunk_v_norm_g,
              chunk_w_s, chunk_b_s, chunk_out_norm_g, ssd_conv_w, ssd_conv_b, ssd_dt_bias,
              ssd_a_log, ssd_d, ssd_norm_g, w_out, norm_ffn_g, w_gate, w_up, w_down, norm_final_g):
    hp, hs = x_prompt, x_sample
    conv_p, ssm_p, conv_s, ssm_s, v_s = [], [], [], [], []
    for l in range(DEPTH):
        params = (norm_mix_g[l], w_in[l], chunk_v_norm_g[l], chunk_w_s[l], chunk_b_s[l],
                  chunk_out_norm_g[l], ssd_conv_w[l], ssd_conv_b[l], ssd_dt_bias[l], ssd_a_log[l],
                  ssd_d[l], ssd_norm_g[l], w_out[l], norm_ffn_g[l], w_gate[l], w_up[l], w_down[l])
        zero_conv = jnp.zeros((hp.shape[0], CONV_W - 1, CONV_DIM), hp.dtype)
        zero_ssm = jnp.zeros((hp.shape[0], SSM_HEADS, SSM_HEAD_DIM, D_STATE), jnp.float32)
        hp, cp, sp, _ = hybrid_layer(hp, zero_conv, zero_ssm, *params)
        hs, cs, ss, vs = hybrid_layer(hs, state_conv[l], state_ssm[l], *params)
        conv_p.append(cp)
        ssm_p.append(sp)
        conv_s.append(cs)
        ssm_s.append(ss)
        v_s.append(vs)
    y_prompt = rmsnorm(hp, norm_final_g)
    y_sample = rmsnorm(hs, norm_final_g)
    return (y_prompt, y_sample, jnp.stack(conv_p), jnp.stack(ssm_p), jnp.stack(conv_s), jnp.stack(ssm_s), jnp.stack(v_s))
```

```cpp
#include <hip/hip_runtime.h>
#include <hip/hip_cooperative_groups.h>
#include <cstdio>
namespace cg = cooperative_groups;
namespace pg8 {
#define PG8_LAS __attribute__((address_space(3)))
typedef unsigned short bf16_t;
typedef short bf16x8 __attribute__((ext_vector_type(8)));
typedef float f32x4 __attribute__((ext_vector_type(4)));
typedef unsigned u32x4 __attribute__((ext_vector_type(4)));
constexpr int BM = 256, BK = 64, HALF = 128, HTB = HALF * BK * 2  , STAGE_BYTES = 8 * HTB, NXCD = 8, WGM = 8;

__host__ __device__ __forceinline__ int lds_byte(int r, int c) { const int st = (r >> 4) * 2 + (c >> 5), rr = r & 15, cc = c & 31, ob = rr * 64 + cc * 2; return st * 1024 + (ob ^ (((ob >> 9) & 1) << 5)); }
__host__ __device__ __forceinline__ void stage_rc(int b, int& R, int& C) { const int st = b / 1024, sb = b % 1024, swz = sb ^ (((sb >> 9) & 1) << 5); R = (st >> 1) * 16 + swz / 64; C = (st & 1) * 32 + (swz % 64) / 2; }
__host__ __device__ __forceinline__ int perm32(int rho) { const int n = rho >> 4, i = rho & 15; return 8 * (i >> 2) + 4 * n + (i & 3); }

struct Unit { int pm, pn; };
struct Gemm { const bf16_t* A; const bf16_t* Bt; int M, N, K; };

struct StaticOrder {
    int nM, nN, nwg, G, c;
    __host__ __device__ void init(int M, int N, int G_, int c_) { nM = M / BM; nN = N / BM; nwg = nM * nN; G = G_; c = c_; }
    __host__ __device__ bool next(int i, Unit& u) const {
        const long L = (long)i * G + c; if (L >= nwg) return false;
        int wgid = (int)L; { const int q = nwg / NXCD, r = nwg % NXCD, xcd = wgid % NXCD, off = wgid / NXCD; wgid = (xcd < r ? xcd * (q + 1) : r * (q + 1) + (xcd - r) * q) + off; }
        const int nig = WGM * nN, gid = wgid / nig, fm = gid * WGM, gsz = (nM - fm) < WGM ? (nM - fm) : WGM;
        u.pm = fm + ((wgid % nig) % gsz); u.pn = (wgid % nig) / gsz; return true;
    }
    __device__ __forceinline__ void a_ready(const Unit&) const {}
    __device__ __forceinline__ void done(const Unit&) const {}
};
__device__ __forceinline__ unsigned cvt_pk_bf16(float lo, float hi) { unsigned r; asm volatile("v_cvt_pk_bf16_f32 %0, %1, %2" : "=v"(r) : "v"(lo), "v"(hi)); return r; }

template <class Epi, class Sched, bool STAMP = false>
__device__ __forceinline__ void gemm_phase(PG8_LAS unsigned char* lds, const Gemm g, const Sched& S, const Epi& E, unsigned long long* stamps) {
    int tid_ = threadIdx.x; asm volatile("" : "+v"(tid_));
    const int tid = tid_, wid = __builtin_amdgcn_readfirstlane(tid >> 6), lane = tid & 63, wr = wid >> 2, wc = wid & 3, fr = lane & 15, fq = lane >> 4;
    const int K = g.K, nt = K / BK;
    int ts_lo = 0, ts_hi = 0, nts = 0; const unsigned long long rt_entry = STAMP ? (unsigned long long)wall_clock64() : 0ull;
#define PG8_STAMP() do { if (STAMP && wid == 0 && nts < 64) { const unsigned long long _c = (unsigned long long)clock64(); \
        ts_lo = (lane == nts) ? (int)(unsigned)_c : ts_lo; ts_hi = (lane == nts) ? (int)(unsigned)(_c >> 32) : ts_hi; ++nts; } } while (0)
    PG8_STAMP();
    unsigned voffA[2], voffB[2];
#pragma unroll
    for (int i = 0; i < 2; ++i) { int R, C; stage_rc(tid * 16 + i * 8192, R, C); const int Rb = Epi::PERM ? ((R & ~31) + perm32(R & 31)) : R;
        voffA[i] = (unsigned)(R * K + C) * 2u; voffB[i] = (unsigned)(Rb * K + C) * 2u; }
    const size_t kstep = (size_t)(BK * 2);
    const size_t hstep = (size_t)HALF * K * 2;
    const size_t tstep = 2 * hstep;
    const unsigned ldsw = (unsigned)wid * 1024u;
    const int aoff = lds_byte(wr * 64 + fr, fq * 8), boff = lds_byte(wc * 32 + fr, fq * 8);
#define PG8_SA(b, h) (((b) * 2 + (h)) * HTB)
#define PG8_SB(b, h) ((4 + (b) * 2 + (h)) * HTB)
#define PG8_STAGE(bufoff, gbase, voff) do { _Pragma("unroll") for (int _i = 0; _i < 2; ++_i) \
        __builtin_amdgcn_global_load_lds((const unsigned*)((const char*)(gbase) + (voff)[_i]), (PG8_LAS unsigned*)(lds + (bufoff) + ldsw + _i * 8192), 16, 0, 0); } while (0)
#define PG8_LDA(dst, b, h) do { _Pragma("unroll") for (int m = 0; m < 4; ++m) _Pragma("unroll") for (int k = 0; k < 2; ++k) dst[m][k] = *(const PG8_LAS bf16x8*)(lds + PG8_SA(b, h) + aoff + m * 2048 + k * 1024); } while (0)
#define PG8_LDB(dst, b, h) do { _Pragma("unroll") for (int n = 0; n < 2; ++n) _Pragma("unroll") for (int k = 0; k < 2; ++k) dst[n][k] = *(const PG8_LAS bf16x8*)(lds + PG8_SB(b, h) + boff + n * 2048 + k * 1024); } while (0)
#define PG8_MMA(ai, bj, At, Bt) do { __builtin_amdgcn_s_setprio(1); _Pragma("unroll") for (int m = 0; m < 4; ++m) _Pragma("unroll") for (int n = 0; n < 2; ++n) _Pragma("unroll") for (int k = 0; k < 2; ++k) \
        acc[ai][bj][m][n] = __builtin_amdgcn_mfma_f32_16x16x32_bf16(Bt[n][k], At[m][k], acc[ai][bj][m][n], 0, 0, 0); __builtin_amdgcn_s_setprio(0); } while (0)
#define PG8_WAIT_V(n) asm volatile("s_waitcnt vmcnt(" #n ")" ::: "memory")
#define PG8_WAIT_L(n) asm volatile("s_waitcnt lgkmcnt(" #n ")" ::: "memory")
#define PG8_BAR __builtin_amdgcn_s_barrier()
#define PG8_SCHED __builtin_amdgcn_sched_barrier(0)
    Unit cur, nxt; int ui = 0;
    if (!S.next(0, cur)) return;
    f32x4 acc[2][2][4][2];
#pragma unroll
    for (int a = 0; a < 2; ++a)
#pragma unroll
        for (int b = 0; b < 2; ++b)
#pragma unroll
            for (int m = 0; m < 4; ++m)
#pragma unroll
                for (int n = 0; n < 2; ++n) acc[a][b][m][n] = (f32x4){0.f, 0.f, 0.f, 0.f};
    bf16x8 At[4][2], B0[2][2], B1[2][2];
    const char* cA = (const char*)g.A + (size_t)cur.pm * tstep; const char* cB = (const char*)g.Bt + (size_t)cur.pn * tstep;
    S.a_ready(cur);
    PG8_STAGE(PG8_SB(0, 0), cB, voffB); PG8_STAGE(PG8_SA(0, 0), cA, voffA); PG8_STAGE(PG8_SB(0, 1), cB + hstep, voffB); PG8_STAGE(PG8_SA(0, 1), cA + hstep, voffA);
    if (wr == 1) PG8_BAR;
    PG8_WAIT_V(4); PG8_BAR;
    PG8_STAGE(PG8_SB(1, 0), cB + kstep, voffB); PG8_STAGE(PG8_SA(1, 0), cA + kstep, voffA); PG8_STAGE(PG8_SB(1, 1), cB + hstep + kstep, voffB);
    PG8_WAIT_V(6); PG8_BAR;
    PG8_STAMP();
    for (;;) {
        const bool has_next = S.next(ui + 1, nxt);
        const char* nA = has_next ? (const char*)g.A + (size_t)nxt.pm * tstep : cA; const char* nB = has_next ? (const char*)g.Bt + (size_t)nxt.pn * tstep : cB;
        for (int t = 0; t < nt; t += 2) {
            const bool last = (t == nt - 2);
            const char* a1 = cA + (size_t)(t + 1) * kstep;
            const char* a2 = last ? nA : cA + (size_t)(t + 2) * kstep; const char* b2 = last ? nB : cB + (size_t)(t + 2) * kstep;
            const char* a3 = a2 + kstep; const char* b3 = b2 + kstep;
            if (last && has_next) S.a_ready(nxt);
            PG8_LDB(B0, 0, 0); PG8_SCHED; PG8_LDA(At, 0, 0); PG8_STAGE(PG8_SA(1, 1), a1 + hstep, voffA);
            PG8_WAIT_L(8); PG8_BAR; PG8_WAIT_L(0); PG8_MMA(0, 0, At, B0); PG8_BAR; PG8_SCHED;
            PG8_LDB(B1, 0, 1); PG8_STAGE(PG8_SB(0, 0), b2, voffB);
            PG8_BAR; PG8_WAIT_L(0); PG8_MMA(0, 1, At, B1); PG8_BAR;
            PG8_LDA(At, 0, 1); PG8_STAGE(PG8_SA(0, 0), a2, voffA);
            PG8_BAR; PG8_WAIT_L(0); PG8_MMA(1, 0, At, B0); PG8_BAR; PG8_SCHED;
            PG8_STAGE(PG8_SB(0, 1), b2 + hstep, voffB);
            PG8_WAIT_V(6); PG8_BAR; PG8_MMA(1, 1, At, B1); PG8_BAR;
            PG8_LDB(B0, 1, 0); PG8_SCHED; PG8_LDA(At, 1, 0); PG8_STAGE(PG8_SA(0, 1), a2 + hstep, voffA);
            PG8_WAIT_L(8); PG8_BAR; PG8_WAIT_L(0); PG8_MMA(0, 0, At, B0); PG8_BAR; PG8_SCHED;
            PG8_LDB(B1, 1, 1); PG8_STAGE(PG8_SB(1, 0), b3, voffB);
            PG8_BAR; PG8_WAIT_L(0); PG8_MMA(0, 1, At, B1); PG8_BAR;
            PG8_LDA(At, 1, 1); PG8_STAGE(PG8_SA(1, 0), a3, voffA);
            PG8_BAR; PG8_WAIT_L(0); PG8_MMA(1, 0, At, B0); PG8_BAR; PG8_SCHED;
            PG8_STAGE(PG8_SB(1, 1), b3 + hstep, voffB);
            PG8_WAIT_V(6); PG8_BAR; PG8_MMA(1, 1, At, B1); PG8_BAR;
        }
        PG8_STAMP();
        if constexpr (!Epi::AFTER_DRAIN) { E(acc, cur, wr, wc, fr, fq); S.done(cur); }
        PG8_STAMP();
        if (!has_next) break;
#pragma unroll
        for (int a = 0; a < 2; ++a)
#pragma unroll
            for (int b = 0; b < 2; ++b)
#pragma unroll
                for (int m = 0; m < 4; ++m)
#pragma unroll
                    for (int n = 0; n < 2; ++n) acc[a][b][m][n] = (f32x4){0.f, 0.f, 0.f, 0.f};
        cur = nxt; cA = nA; cB = nB; ++ui;
    }
    PG8_WAIT_V(0);
    if (wr == 0) PG8_BAR;
    PG8_BAR;
    if constexpr (Epi::AFTER_DRAIN) { E.fused(acc, cur, wr, wc, fr, fq, lds, wid, lane); S.done(cur); }
    PG8_STAMP();
    if (STAMP && wid == 0) { stamps[lane] = lane < nts ? (((unsigned long long)(unsigned)ts_hi << 32) | (unsigned)ts_lo) : 0ull;
        if (lane == 62) stamps[62] = rt_entry; if (lane == 63) stamps[63] = (unsigned long long)wall_clock64(); }
#undef PG8_STAMP
#undef PG8_SA
#undef PG8_SB
#undef PG8_STAGE
#undef PG8_LDA
#undef PG8_LDB
#undef PG8_MMA
#undef PG8_WAIT_V
#undef PG8_WAIT_L
#undef PG8_BAR
#undef PG8_SCHED
}
}

#define LAS __attribute__((address_space(3)))
using pg8::bf16_t; using pg8::bf16x8; using pg8::f32x4; using pg8::u32x4; using pg8::cvt_pk_bf16;
typedef unsigned u32x2 __attribute__((ext_vector_type(2)));

constexpr float EPS = 1e-6f;
constexpr int MROWS = 8320, MPAD = 8448;
constexpr int LDS_BYTES = 131072 + 1024;
constexpr int NPHASE = 10;

constexpr size_t OFF_WTIN = 0;
constexpr size_t OFF_WTOUT = OFF_WTIN + 4864ull * 2048 * 2;
constexpr size_t OFF_WTGU = OFF_WTOUT + 2048ull * 2048 * 2;
constexpr size_t OFF_WTDN = OFF_WTGU + 11264ull * 2048 * 2;
constexpr size_t OFF_SS = OFF_WTDN + 2048ull * 5632 * 2;
constexpr size_t OFF_CTL = OFF_SS + 8448ull * 8 * 4;
constexpr size_t OFF_EAL = OFF_CTL + 16384;
constexpr size_t OFF_XB = OFF_EAL + 4096;
constexpr size_t OFF_C = OFF_XB + 8448ull * 2048 * 2;
constexpr size_t OFF_PROJ = OFF_C;
constexpr size_t OFF_DT = OFF_PROJ + 8448ull * 4608 * 2;
constexpr size_t OFF_STATES = OFF_DT + 8448ull * 16 * 4;
constexpr size_t OFF_HPREV = OFF_STATES + 64ull * 16 * 8192 * 4;
constexpr size_t OFF_YD = OFF_HPREV + 64ull * 16 * 8192 * 2;
constexpr size_t OFF_CC = OFF_YD + 8192ull * 1024 * 4;
constexpr size_t OFF_EAC = OFF_CC + 8192ull * 256 * 2;
constexpr size_t END_C1 = OFF_EAC + 8192ull * 16 * 4;
constexpr size_t OFF_HB = OFF_C;
constexpr size_t OFF_ACT = OFF_HB + 8448ull * 2048 * 2;
constexpr size_t END_C2 = OFF_ACT + 8448ull * 5632 * 2;
constexpr size_t WS_NEED = END_C1 > END_C2 ? END_C1 : END_C2;

constexpr size_t O_Y = 0, O_CONVP = 17039360, O_SSMP = 17057792, O_CONVS = 17582080, O_SSMS = 18171904, O_VS = 34949120;

struct Params {
    const float* xp; const float* xs; const float* sconv; const float* sssm; const float* g_mix; const float* w_in; const float* g_cv; const float* w_s; const float* b_s;
    const float* g_co; const float* conv_w; const float* conv_b; const float* dt_bias; const float* a_log; const float* dvec; const float* g_sn; const float* w_out;
    const float* g_ffn; const float* w_gate; const float* w_up; const float* w_down; const float* g_fin;
    float* out; unsigned char* ws; int ph_lo, ph_hi;
};

__device__ __forceinline__ float bf2f(unsigned v) { return __uint_as_float(v << 16); }
__device__ __forceinline__ bf16_t f2bf(float x) { return (bf16_t)(cvt_pk_bf16(x, x) & 0xffffu); }
__device__ __forceinline__ float sigmoid_f(float x) { return __builtin_amdgcn_rcpf(1.0f + __expf(-x)); }
__device__ __forceinline__ float silu_f(float x) { return x * sigmoid_f(x); }
__device__ __forceinline__ float gelu_f(float x) { return x * sigmoid_f(1.5957691216f * (x + 0.044715f * x * x * x)); }
__device__ __forceinline__ float softplus_f(float x) { return x > 20.f ? x : log1pf(expf(x)); }
__device__ __forceinline__ f32x4 mfma16(bf16x8 a, bf16x8 b, f32x4 c) { return __builtin_amdgcn_mfma_f32_16x16x32_bf16(a, b, c, 0, 0, 0); }
__device__ __forceinline__ u32x4 pack8(const float* v) { u32x4 o; o.x = cvt_pk_bf16(v[0], v[1]); o.y = cvt_pk_bf16(v[2], v[3]); o.z = cvt_pk_bf16(v[4], v[5]); o.w = cvt_pk_bf16(v[6], v[7]); return o; }

struct EpiProj {
    static constexpr bool PERM = true, AFTER_DRAIN = false;
    bf16_t* proj; float* dt; const float* xss; float* vss;
    __device__ __forceinline__ void operator()(const f32x4 (&acc)[2][2][4][2], const pg8::Unit& u, int wr, int wc, int fr, int fq) const {
        const int row0 = u.pm * 256 + wr * 64 + fr, pn = u.pn;
        if (pn == 18) {
            if (wc == 0 && fq < 2) {
#pragma unroll
                for (int ai = 0; ai < 2; ++ai)
#pragma unroll
                    for (int m = 0; m < 4; ++m) { const int row = row0 + ai * 128 + m * 16; const float rs = rsqrtf(xss[row] * (1.0f / 2048.0f) + EPS);
                        float* d = dt + (size_t)row * 16 + fq * 8; *(f32x4*)d = acc[ai][0][m][0] * rs; *(f32x4*)(d + 4) = acc[ai][0][m][1] * rs; }
            }
            return;
        }
        const int kind = pn < 4 ? 0 : pn < 8 ? 1 : pn < 12 ? 2 : 3;
        const int col0 = pn * 256 + wc * 32 + 8 * fq;
#pragma unroll
        for (int ai = 0; ai < 2; ++ai)
#pragma unroll
            for (int m = 0; m < 4; ++m) { const int row = row0 + ai * 128 + m * 16; const float rs = rsqrtf(xss[row] * (1.0f / 2048.0f) + EPS); float ssq = 0.f;
#pragma unroll
                for (int bj = 0; bj < 2; ++bj) { float v[8];
#pragma unroll
                    for (int j = 0; j < 4; ++j) { v[j] = acc[ai][bj][m][0][j] * rs; v[4 + j] = acc[ai][bj][m][1][j] * rs; }
                    if (kind <= 1) {
#pragma unroll
                        for (int j = 0; j < 8; ++j) v[j] = gelu_f(v[j]);
                    } else if (kind == 2) {
#pragma unroll
                        for (int j = 0; j < 8; ++j) v[j] = silu_f(v[j]);
                    }
                    if (kind == 1) {
#pragma unroll
                        for (int j = 0; j < 8; ++j) ssq += v[j] * v[j];
                    }
                    *(u32x4*)(proj + (size_t)row * 4608 + col0 + bj * 128) = pack8(v); }
                if (kind == 1) { ssq += __shfl_xor(ssq, 16); ssq += __shfl_xor(ssq, 32); if (fq == 0) unsafeAtomicAdd(vss + row, ssq); }
            }
    }
};
struct EpiOut {
    static constexpr bool PERM = false, AFTER_DRAIN = false;
    const float* xp; const float* xs; float* hout; bf16_t* hb; float* hss;
    __device__ __forceinline__ void operator()(const f32x4 (&acc)[2][2][4][2], const pg8::Unit& u, int wr, int wc, int fr, int fq) const {
        const int row0 = u.pm * 256 + wr * 64 + fr, col0 = u.pn * 256 + wc * 32 + 4 * fq;
#pragma unroll
        for (int ai = 0; ai < 2; ++ai)
#pragma unroll
            for (int m = 0; m < 4; ++m) { const int row = row0 + ai * 128 + m * 16; const int rc = row < MROWS ? row : MROWS - 1;
                const float* xr = (rc < 8192 ? xp + (size_t)rc * 2048 : xs + (size_t)(rc - 8192) * 2048) + col0; float ssq = 0.f;
#pragma unroll
                for (int bj = 0; bj < 2; ++bj)
#pragma unroll
                    for (int n = 0; n < 2; ++n) { const f32x4 hv = *(const f32x4*)(xr + bj * 128 + n * 16) + acc[ai][bj][m][n];
                        ssq += hv[0] * hv[0] + hv[1] * hv[1] + hv[2] * hv[2] + hv[3] * hv[3];
                        if (row < MROWS) *(f32x4*)(hout + (size_t)row * 2048 + col0 + bj * 128 + n * 16) = hv;
                        u32x2 o; o.x = cvt_pk_bf16(hv[0], hv[1]); o.y = cvt_pk_bf16(hv[2], hv[3]); *(u32x2*)(hb + (size_t)row * 2048 + col0 + bj * 128 + n * 16) = o; }
                ssq += __shfl_xor(ssq, 16); ssq += __shfl_xor(ssq, 32); if (fq == 0) unsafeAtomicAdd(hss + row, ssq);
            }
    }
};
struct EpiGU {
    static constexpr bool PERM = true, AFTER_DRAIN = false;
    bf16_t* act; const float* hss;
    __device__ __forceinline__ void operator()(const f32x4 (&acc)[2][2][4][2], const pg8::Unit& u, int wr, int wc, int fr, int fq) const {
        const int row0 = u.pm * 256 + wr * 64 + fr, col0 = u.pn * 128 + wc * 32 + 8 * fq;
#pragma unroll
        for (int ai = 0; ai < 2; ++ai)
#pragma unroll
            for (int m = 0; m < 4; ++m) { const int row = row0 + ai * 128 + m * 16; const float rs = rsqrtf(hss[row] * (1.0f / 2048.0f) + EPS); float v[8];
#pragma unroll
                for (int j = 0; j < 4; ++j) { v[j] = silu_f(acc[ai][0][m][0][j] * rs) * (acc[ai][1][m][0][j] * rs); v[4 + j] = silu_f(acc[ai][0][m][1][j] * rs) * (acc[ai][1][m][1][j] * rs); }
                *(u32x4*)(act + (size_t)row * 5632 + col0) = pack8(v); }
    }
};
struct EpiDown {
    static constexpr bool PERM = false, AFTER_DRAIN = false;
    float* hout; float* oss;
    __device__ __forceinline__ void operator()(const f32x4 (&acc)[2][2][4][2], const pg8::Unit& u, int wr, int wc, int fr, int fq) const {
        const int row0 = u.pm * 256 + wr * 64 + fr, col0 = u.pn * 256 + wc * 32 + 4 * fq;
#pragma unroll
        for (int ai = 0; ai < 2; ++ai)
#pragma unroll
            for (int m = 0; m < 4; ++m) { const int row = row0 + ai * 128 + m * 16; float ssq = 0.f;
                if (row < MROWS) { float* hr = hout + (size_t)row * 2048 + col0;
#pragma unroll
                    for (int bj = 0; bj < 2; ++bj)
#pragma unroll
                        for (int n = 0; n < 2; ++n) { const f32x4 o = *(const f32x4*)(hr + bj * 128 + n * 16) + acc[ai][bj][m][n];
                            ssq += o[0] * o[0] + o[1] * o[1] + o[2] * o[2] + o[3] * o[3]; *(f32x4*)(hr + bj * 128 + n * 16) = o; } }
                ssq += __shfl_xor(ssq, 16); ssq += __shfl_xor(ssq, 32); if (fq == 0 && row < MROWS) unsafeAtomicAdd(oss + row, ssq);
            }
    }
};

__device__ __forceinline__ void phase_prep(const Params& p, LAS unsigned char* lds) {
    const int tid = threadIdx.x, lane = tid & 63, wv = tid >> 6, G = gridDim.x;
    unsigned char* ws = p.ws;
    float* ss = (float*)(ws + OFF_SS);
    for (int i = blockIdx.x * 512 + tid; i < 8448 * 7; i += G * 512) ss[8448 + i] = 0.f;
    if (blockIdx.x == 0 && tid < 128) ss[MROWS + tid] = 2048.f;
    bf16_t* XB = (bf16_t*)(ws + OFF_XB);
    for (int row = blockIdx.x * 8 + wv; row < MROWS; row += G * 8) {
        const float* src = row < 8192 ? p.xp + (size_t)row * 2048 : p.xs + (size_t)(row - 8192) * 2048;
        float s = 0.f;
#pragma unroll
        for (int j = 0; j < 8; ++j) { const f32x4 v = *(const f32x4*)(src + j * 256 + lane * 4); s += v[0] * v[0] + v[1] * v[1] + v[2] * v[2] + v[3] * v[3];
            u32x2 o; o.x = cvt_pk_bf16(v[0], v[1]); o.y = cvt_pk_bf16(v[2], v[3]); *(u32x2*)(XB + (size_t)row * 2048 + j * 256 + lane * 4) = o; }
#pragma unroll
        for (int o = 32; o >= 1; o >>= 1) s += __shfl_xor(s, o);
        if (lane == 0) ss[row] = s;
    }
    LAS float* tile = (LAS float*)lds;
    for (int t = blockIdx.x; t < 11808; t += G) {
        const float* W; bf16_t* dst; int N, ldt, kt, nt, drow0, gsel;
        if (t < 2336) { kt = t & 31; nt = t >> 5; W = p.w_in; N = 4624; ldt = 2048; dst = (bf16_t*)(ws + OFF_WTIN); drow0 = nt * 64; gsel = 0; }
        else if (t < 3360) { const int q = t - 2336; kt = q & 31; nt = q >> 5; W = p.w_out; N = 2048; ldt = 2048; dst = (bf16_t*)(ws + OFF_WTOUT); drow0 = nt * 64; gsel = 1; }
        else if (t < 6176) { const int q = t - 3360; kt = q & 31; nt = q >> 5; W = p.w_gate; N = 5632; ldt = 2048; dst = (bf16_t*)(ws + OFF_WTGU); drow0 = 256 * (nt >> 1) + (nt & 1) * 64; gsel = 2; }
        else if (t < 8992) { const int q = t - 6176; kt = q & 31; nt = q >> 5; W = p.w_up; N = 5632; ldt = 2048; dst = (bf16_t*)(ws + OFF_WTGU); drow0 = 256 * (nt >> 1) + 128 + (nt & 1) * 64; gsel = 2; }
        else { const int q = t - 8992; kt = q % 88; nt = q / 88; W = p.w_down; N = 2048; ldt = 5632; dst = (bf16_t*)(ws + OFF_WTDN); drow0 = nt * 64; gsel = 3; }
        const int k0 = kt * 64, n0 = nt * 64;
        { const int r = tid >> 4, c4 = (tid & 15) * 4;
#pragma unroll
            for (int rr = r; rr < 64; rr += 32) { const int k = k0 + rr;
                const float gk = gsel == 0 ? p.g_mix[k] : gsel == 1 ? (k < 1024 ? p.g_co[k] : p.g_sn[k - 1024]) : gsel == 2 ? p.g_ffn[k] : 1.0f;
                f32x4 v = (f32x4){0.f, 0.f, 0.f, 0.f}; if (n0 + c4 < N) v = *(const f32x4*)(W + (size_t)k * N + n0 + c4);
                tile[rr * 65 + c4 + 0] = v[0] * gk; tile[rr * 65 + c4 + 1] = v[1] * gk; tile[rr * 65 + c4 + 2] = v[2] * gk; tile[rr * 65 + c4 + 3] = v[3] * gk; } }
        __syncthreads();
        { const int n = tid >> 3, kq = tid & 7; float v[8];
#pragma unroll
            for (int i = 0; i < 8; ++i) v[i] = tile[(kq * 8 + i) * 65 + n];
            *(u32x4*)(dst + (size_t)(drow0 + n) * ldt + k0 + kq * 8) = pack8(v); }
        __syncthreads();
    }
    { u32x4* z = (u32x4*)(ws + OFF_WTIN + 4672ull * 2048 * 2); for (int i = blockIdx.x * 512 + tid; i < 49152; i += G * 512) z[i] = (u32x4){0u, 0u, 0u, 0u}; }
}

__device__ __forceinline__ void conv16(const Params& p, const bf16_t* PROJ, int R0, int t0, bool first, int ch, float (&o)[16]) {
    float in[19];
    const bf16_t* src = PROJ + (size_t)(R0 + t0) * 4608 + 3072 + ch;
#pragma unroll
    for (int j = 0; j < 19; ++j) { in[j] = 0.f; if (!(first && t0 - 3 + j < 0)) in[j] = bf2f(src[(ptrdiff_t)(j - 3) * 4608]); }
    const float w0 = p.conv_w[ch], w1 = p.conv_w[1536 + ch], w2 = p.conv_w[3072 + ch], w3 = p.conv_w[4608 + ch], cb = p.conv_b[ch];
#pragma unroll
    for (int t = 0; t < 16; ++t) o[t] = silu_f(cb + w0 * in[t] + w1 * in[t + 1] + w2 * in[t + 2] + w3 * in[t + 3]);
}

__device__ __forceinline__ void ssd_local(const Params& p, LAS unsigned char* lds, int b, int c, int h) {
    const int tid = threadIdx.x, lane = tid & 63, w = __builtin_amdgcn_readfirstlane(tid >> 6), g = h >> 3, fr = lane & 15, fq = lane >> 4;
    const int R0 = b * 2048 + c * 128, t0 = w * 16;
    unsigned char* ws = p.ws;
    const bf16_t* PROJ = (const bf16_t*)(ws + OFF_PROJ);
    const float* DT = (const float*)(ws + OFF_DT);
    float* EAC = (float*)(ws + OFF_EAC); float* EAL = (float*)(ws + OFF_EAL);
    LAS unsigned char* CcL = lds; LAS unsigned char* BcL = lds + 34816; LAS unsigned char* BTL = lds + 69632; LAS unsigned char* xTL = lds + 104448;
    LAS float* fa = (LAS float*)(lds + 121856); LAS float* fd = fa + 128; LAS float* fw = fa + 256; LAS float* ftot = fa + 384;
    float dtv = 0.f, xa = 0.f;
    if (tid < 128) {
        const float raw = DT[(size_t)(R0 + tid) * 16 + h] + p.dt_bias[h];
        dtv = softplus_f(raw);
        xa = dtv * (-expf(p.a_log[h]));
#pragma unroll
        for (int o = 1; o < 64; o <<= 1) { const float t = __shfl_up(xa, o); if (lane >= o) xa += t; }
        if (lane == 63) ftot[w] = xa;
    }
    __syncthreads();
    if (tid < 128) { if (w == 1) xa += ftot[0]; fa[tid] = xa; fd[tid] = dtv; }
    __syncthreads();
    const float a_last = fa[127];
    if (tid < 128) { fw[tid] = expf(a_last - xa) * dtv; EAC[(size_t)(R0 + tid) * 16 + h] = expf(xa); if (tid == 127) EAL[(b * 16 + c) * 16 + h] = expf(a_last); }
    __syncthreads();
    const bool first = (c == 0);
    { float o[16]; conv16(p, PROJ, R0, t0, first, h * 64 + lane, o);
        *(LAS u32x4*)(xTL + lane * 272 + t0 * 2) = pack8(o); *(LAS u32x4*)(xTL + lane * 272 + t0 * 2 + 16) = pack8(o + 8); }
#pragma unroll
    for (int half = 0; half < 2; ++half) { const int n = lane + 64 * half; float o[16]; conv16(p, PROJ, R0, t0, first, 1024 + g * 128 + n, o);
#pragma unroll
        for (int i = 0; i < 16; ++i) { *(LAS bf16_t*)(BcL + (t0 + i) * 272 + n * 2) = f2bf(o[i]); o[i] *= fw[t0 + i]; }
        *(LAS u32x4*)(BTL + n * 272 + t0 * 2) = pack8(o); *(LAS u32x4*)(BTL + n * 272 + t0 * 2 + 16) = pack8(o + 8); }
#pragma unroll
    for (int half = 0; half < 2; ++half) { const int n = lane + 64 * half; float o[16]; conv16(p, PROJ, R0, t0, first, 1280 + g * 128 + n, o);
#pragma unroll
        for (int i = 0; i < 16; ++i) *(LAS bf16_t*)(CcL + (t0 + i) * 272 + n * 2) = f2bf(o[i]); }
    __syncthreads();
    if ((h & 7) == 0) { bf16_t* CC = (bf16_t*)(ws + OFF_CC); const int t = tid >> 2, q = tid & 3;
#pragma unroll
        for (int i = 0; i < 4; ++i) *(u32x4*)(CC + (size_t)(R0 + t) * 256 + g * 128 + q * 32 + i * 8) = *(LAS u32x4*)(CcL + t * 272 + (q * 32 + i * 8) * 2); }
    f32x4 cbt[8];
#pragma unroll
    for (int j = 0; j < 8; ++j) cbt[j] = (f32x4){0.f, 0.f, 0.f, 0.f};
#pragma unroll
    for (int ks = 0; ks < 4; ++ks) { const bf16x8 a = *(LAS bf16x8*)(CcL + (t0 + fr) * 272 + (ks * 32 + fq * 8) * 2);
#pragma unroll
        for (int j = 0; j < 8; ++j) if (j <= w) { const bf16x8 bb = *(LAS bf16x8*)(BcL + (j * 16 + fr) * 272 + (ks * 32 + fq * 8) * 2); cbt[j] = mfma16(a, bb, cbt[j]); } }
    __syncthreads();
    LAS unsigned char* ML = BcL;
#pragma unroll
    for (int j = 0; j < 8; ++j) if (j <= (w | 1)) {
#pragma unroll
        for (int i = 0; i < 4; ++i) { const int t = t0 + fq * 4 + i, s = j * 16 + fr; float v = 0.f; if (j <= w && s <= t) v = cbt[j][i] * __expf(fa[t] - fa[s]) * fd[s];
            *(LAS bf16_t*)(ML + t * 272 + s * 2) = f2bf(v); } }
    const int nks = (w >> 1) + 1;
    f32x4 yd[4];
#pragma unroll
    for (int j = 0; j < 4; ++j) yd[j] = (f32x4){0.f, 0.f, 0.f, 0.f};
#pragma unroll
    for (int ks = 0; ks < 4; ++ks) if (ks < nks) { const bf16x8 a = *(LAS bf16x8*)(ML + (t0 + fr) * 272 + (ks * 32 + fq * 8) * 2);
#pragma unroll
        for (int pj = 0; pj < 4; ++pj) { const bf16x8 bb = *(LAS bf16x8*)(xTL + (pj * 16 + fr) * 272 + (ks * 32 + fq * 8) * 2); yd[pj] = mfma16(a, bb, yd[pj]); } }
    { float* YD = (float*)(ws + OFF_YD); const float Dh = p.dvec[h];
#pragma unroll
        for (int pj = 0; pj < 4; ++pj)
#pragma unroll
            for (int i = 0; i < 4; ++i) { const int t = t0 + fq * 4 + i, pc = pj * 16 + fr; const float xv = bf2f(*(LAS bf16_t*)(xTL + pc * 272 + t * 2));
                YD[(size_t)(R0 + t) * 1024 + h * 64 + pc] = yd[pj][i] + Dh * xv; } }
    f32x4 st[4];
#pragma unroll
    for (int j = 0; j < 4; ++j) st[j] = (f32x4){0.f, 0.f, 0.f, 0.f};
#pragma unroll
    for (int ks = 0; ks < 4; ++ks) { const bf16x8 bb = *(LAS bf16x8*)(BTL + (t0 + fr) * 272 + (ks * 32 + fq * 8) * 2);
#pragma unroll
        for (int pi = 0; pi < 4; ++pi) { const bf16x8 a = *(LAS bf16x8*)(xTL + (pi * 16 + fr) * 272 + (ks * 32 + fq * 8) * 2); st[pi] = mfma16(a, bb, st[pi]); } }
    { float* S = (float*)(ws + OFF_STATES) + (size_t)((b * 16 + c) * 16 + h) * 8192;
#pragma unroll
        for (int pi = 0; pi < 4; ++pi)
#pragma unroll
            for (int i = 0; i < 4; ++i) S[(pi * 16 + fq * 4 + i) * 128 + t0 + fr] = st[pi][i]; }
    __syncthreads();
}

__device__ __forceinline__ void chunk_mlp(const Params& p, LAS unsigned char* lds, int b, int c, int h) {
    const int tid = threadIdx.x, lane = tid & 63, w = __builtin_amdgcn_readfirstlane(tid >> 6), fr = lane & 15, fq = lane >> 4;
    const int R0 = b * 2048 + c * 128, t0 = w * 16;
    unsigned char* ws = p.ws;
    const bf16_t* PROJ = (const bf16_t*)(ws + OFF_PROJ);
    float* ss = (float*)(ws + OFF_SS); const float* vss = ss + 8448; float* yss = ss + 2 * 8448;
    bf16_t* Y = (bf16_t*)(ws + OFF_XB);
    LAS unsigned char* gvT = lds; LAS float* rsv = (LAS float*)(lds + 34816);
    if (tid < 128) rsv[tid] = rsqrtf(vss[R0 + tid] * (1.0f / 1024.0f) + EPS);
    __syncthreads();
#pragma unroll
    for (int half = 0; half < 2; ++half) { const int d = lane + 64 * half; const float gd = p.g_cv[h * 128 + d]; float o[16];
#pragma unroll
        for (int i = 0; i < 16; ++i) o[i] = bf2f(PROJ[(size_t)(R0 + t0 + i) * 4608 + 1024 + h * 128 + d]) * rsv[t0 + i] * gd;
        *(LAS u32x4*)(gvT + d * 272 + t0 * 2) = pack8(o); *(LAS u32x4*)(gvT + d * 272 + t0 * 2 + 16) = pack8(o + 8); }
    __syncthreads();
    f32x4 acc[8];
#pragma unroll
    for (int j = 0; j < 8; ++j) acc[j] = (f32x4){0.f, 0.f, 0.f, 0.f};
    const int nks = (w >> 1) + 1, trow = t0 + fr;
#pragma unroll
    for (int ks = 0; ks < 4; ++ks) if (ks < nks) { const int s0 = ks * 32 + fq * 8; const float* wp = p.w_s + (size_t)h * 16384 + trow * 128 + s0;
        const f32x4 w0 = *(const f32x4*)wp, w1 = *(const f32x4*)(wp + 4); float wv[8];
#pragma unroll
        for (int e = 0; e < 4; ++e) { wv[e] = (s0 + e <= trow) ? w0[e] : 0.f; wv[4 + e] = (s0 + 4 + e <= trow) ? w1[e] : 0.f; }
        const bf16x8 a = __builtin_bit_cast(bf16x8, pack8(wv));
#pragma unroll
        for (int dj = 0; dj < 8; ++dj) { const bf16x8 bb = *(LAS bf16x8*)(gvT + (dj * 16 + fr) * 272 + s0 * 2); acc[dj] = mfma16(a, bb, acc[dj]); } }
#pragma unroll
    for (int i = 0; i < 4; ++i) { const int t = t0 + fq * 4 + i; const float bias = p.b_s[h * 128 + t]; float ssq = 0.f;
#pragma unroll
        for (int dj = 0; dj < 8; ++dj) { const int d = dj * 16 + fr; const float u = bf2f(PROJ[(size_t)(R0 + t) * 4608 + h * 128 + d]); const float v = u * (acc[dj][i] + bias);
            ssq += v * v; Y[(size_t)(R0 + t) * 2048 + h * 128 + d] = f2bf(v); }
        ssq += __shfl_xor(ssq, 1); ssq += __shfl_xor(ssq, 2); ssq += __shfl_xor(ssq, 4); ssq += __shfl_xor(ssq, 8);
        if (fr == 0) unsafeAtomicAdd(yss + (size_t)(R0 + t) * 4, ssq); }
    __syncthreads();
}

__device__ __forceinline__ float conv1s(const Params& p, const bf16_t* PROJ, int row, const float* sc, float* ocs, int ch, bool wr) {
    const float xn = bf2f(PROJ[(size_t)row * 4608 + 3072 + ch]); const float s0 = sc[ch], s1 = sc[1536 + ch], s2 = sc[3072 + ch];
    if (wr) { ocs[ch] = s1; ocs[1536 + ch] = s2; ocs[3072 + ch] = xn; }
    return silu_f(p.conv_b[ch] + p.conv_w[ch] * s0 + p.conv_w[1536 + ch] * s1 + p.conv_w[3072 + ch] * s2 + p.conv_w[4608 + ch] * xn);
}
__device__ __forceinline__ void sample_item(const Params& p, LAS unsigned char* lds, int b, int g) {
    const int tid = threadIdx.x, lane = tid & 63, w = __builtin_amdgcn_readfirstlane(tid >> 6), h = g * 8 + w, row = 8192 + b;
    unsigned char* ws = p.ws;
    const bf16_t* PROJ = (const bf16_t*)(ws + OFF_PROJ);
    const float* DT = (const float*)(ws + OFF_DT);
    float* ss = (float*)(ws + OFF_SS); const float* vss = ss + 8448; float* yss = ss + 2 * 8448;
    bf16_t* Y = (bf16_t*)(ws + OFF_XB);
    LAS float* wl = (LAS float*)(lds + w * 2048);
    const float* sc = p.sconv + (size_t)b * 3 * 1536; float* ocs = p.out + O_CONVS + (size_t)b * 3 * 1536;
    const float xv = conv1s(p, PROJ, row, sc, ocs, h * 64 + lane, true);
    const float B0 = conv1s(p, PROJ, row, sc, ocs, 1024 + g * 128 + lane, w == 0), B1 = conv1s(p, PROJ, row, sc, ocs, 1024 + g * 128 + 64 + lane, w == 0);
    const float C0 = conv1s(p, PROJ, row, sc, ocs, 1280 + g * 128 + lane, w == 0), C1 = conv1s(p, PROJ, row, sc, ocs, 1280 + g * 128 + 64 + lane, w == 0);
    const float dt = softplus_f(DT[(size_t)row * 16 + h] + p.dt_bias[h]); const float dA = expf(-expf(p.a_log[h]) * dt);
    wl[lane] = B0; wl[64 + lane] = B1; wl[128 + lane] = C0; wl[192 + lane] = C1; wl[256 + lane] = xv * dt; wl[320 + lane] = xv;
    const int nn = (lane & 31) * 4, ph = lane >> 5;
    const f32x4 B4 = *(LAS f32x4*)(wl + nn), C4 = *(LAS f32x4*)(wl + 128 + nn);
    const float* h0 = p.sssm + (size_t)(b * 16 + h) * 8192; float* hn = p.out + O_SSMS + (size_t)(b * 16 + h) * 8192;
#pragma unroll 8
    for (int it = 0; it < 32; ++it) { const int pp = it * 2 + ph; const f32x4 hv = *(const f32x4*)(h0 + pp * 128 + nn); const float xd = wl[256 + pp];
        const f32x4 r = hv * dA + B4 * xd; *(f32x4*)(hn + pp * 128 + nn) = r;
        float part = r[0] * C4[0] + r[1] * C4[1] + r[2] * C4[2] + r[3] * C4[3];
        part += __shfl_xor(part, 1); part += __shfl_xor(part, 2); part += __shfl_xor(part, 4); part += __shfl_xor(part, 8); part += __shfl_xor(part, 16);
        if ((lane & 31) == 0) wl[384 + pp] = part; }
    float y = wl[384 + lane] + p.dvec[h] * xv;
    y *= bf2f(PROJ[(size_t)row * 4608 + 2048 + h * 64 + lane]);
    float ssq = y * y;
#pragma unroll
    for (int o = 32; o >= 1; o >>= 1) ssq += __shfl_xor(ssq, o);
    if (lane == 0) unsafeAtomicAdd(yss + (size_t)row * 4 + 1 + g, ssq);
    Y[(size_t)row * 2048 + 1024 + h * 64 + lane] = f2bf(y);
    { const int cidx = g * 512 + tid, hh = cidx >> 7; const float gv = bf2f(PROJ[(size_t)row * 4608 + 1024 + cidx]); const float rs = rsqrtf(vss[row] * (1.0f / 1024.0f) + EPS);
        const float vrow = gv * rs * p.g_cv[cidx]; p.out[O_VS + (size_t)b * 1024 + cidx] = vrow;
        const float mixed = p.w_s[(size_t)hh * 16384] * vrow + p.b_s[hh * 128]; const float ya = bf2f(PROJ[(size_t)row * 4608 + cidx]) * mixed;
        Y[(size_t)row * 2048 + cidx] = f2bf(ya); float s2 = ya * ya;
#pragma unroll
        for (int o = 32; o >= 1; o >>= 1) s2 += __shfl_xor(s2, o);
        if (lane == 0) unsafeAtomicAdd(yss + (size_t)row * 4, s2); }
    __syncthreads();
}

__device__ __forceinline__ void phase_mixer(const Params& p, LAS unsigned char* lds) {
    for (int it = blockIdx.x; it < 1796; it += gridDim.x) {
        if (it < 1024) ssd_local(p, lds, it >> 8, (it >> 4) & 15, it & 15);
        else if (it < 1536) { const int j = it - 1024; chunk_mlp(p, lds, j >> 7, (j >> 3) & 15, j & 7); }
        else if (it < 1792) { const int j = it - 1536; sample_item(p, lds, j >> 1, j & 1); }
        else { const int b = it - 1792; const bf16_t* PROJ = (const bf16_t*)(p.ws + OFF_PROJ);
            for (int i = threadIdx.x; i < 4608; i += 512) { const int k = i / 1536, ch = i - k * 1536;
                p.out[O_CONVP + (size_t)(b * 3 + k) * 1536 + ch] = bf2f(PROJ[(size_t)(b * 2048 + 2045 + k) * 4608 + 3072 + ch]); } }
    }
}

__device__ __forceinline__ void phase_scan(const Params& p) {
    const float* STATES = (const float*)(p.ws + OFF_STATES); const float* EAL = (const float*)(p.ws + OFF_EAL); bf16_t* HPREV = (bf16_t*)(p.ws + OFF_HPREV);
    for (int i = blockIdx.x * 512 + threadIdx.x; i < 131072; i += gridDim.x * 512) {
        const int b = i >> 15, e = (i & 32767) * 4, h = e >> 13;
        f32x4 run = (f32x4){0.f, 0.f, 0.f, 0.f};
#pragma unroll
        for (int c = 0; c < 16; ++c) { const f32x4 st = *(const f32x4*)(STATES + (size_t)(b * 16 + c) * 131072 + e); const float eal = EAL[(b * 16 + c) * 16 + h];
            u32x2 o; o.x = cvt_pk_bf16(run[0], run[1]); o.y = cvt_pk_bf16(run[2], run[3]); *(u32x2*)(HPREV + (size_t)(b * 16 + c) * 131072 + e) = o;
            run = run * eal + st; }
        *(f32x4*)(p.out + O_SSMP + (size_t)b * 131072 + e) = run;
    }
}

__device__ __forceinline__ void phase_combine(const Params& p) {
    const int tid = threadIdx.x, lane = tid & 63, w = tid >> 6, fr = lane & 15, fq = lane >> 4, t0 = w * 16;
    unsigned char* ws = p.ws;
    const bf16_t* PROJ = (const bf16_t*)(ws + OFF_PROJ); const bf16_t* CC = (const bf16_t*)(ws + OFF_CC); const bf16_t* HPREV = (const bf16_t*)(ws + OFF_HPREV);
    const float* YD = (const float*)(ws + OFF_YD); const float* EAC = (const float*)(ws + OFF_EAC);
    float* yss = (float*)(ws + OFF_SS) + 2 * 8448; bf16_t* Y = (bf16_t*)(ws + OFF_XB);
    for (int it = blockIdx.x; it < 1024; it += gridDim.x) {
        const int b = it >> 8, c = (it >> 4) & 15, h = it & 15, g = h >> 3, R0 = b * 2048 + c * 128;
        f32x4 acc[4];
#pragma unroll
        for (int j = 0; j < 4; ++j) acc[j] = (f32x4){0.f, 0.f, 0.f, 0.f};
        const bf16_t* ccp = CC + (size_t)(R0 + t0 + fr) * 256 + g * 128 + fq * 8;
        const bf16_t* hp = HPREV + (size_t)((b * 16 + c) * 16 + h) * 8192 + fr * 128 + fq * 8;
#pragma unroll
        for (int ks = 0; ks < 4; ++ks) { const bf16x8 a = *(const bf16x8*)(ccp + ks * 32);
#pragma unroll
            for (int pj = 0; pj < 4; ++pj) { const bf16x8 bb = *(const bf16x8*)(hp + pj * 2048 + ks * 32); acc[pj] = mfma16(a, bb, acc[pj]); } }
#pragma unroll
        for (int i = 0; i < 4; ++i) { const int r = R0 + t0 + fq * 4 + i; const float ea = EAC[(size_t)r * 16 + h]; float ssq = 0.f;
#pragma unroll
            for (int pj = 0; pj < 4; ++pj) { const int pc = pj * 16 + fr; float y = YD[(size_t)r * 1024 + h * 64 + pc] + ea * acc[pj][i];
                y *= bf2f(PROJ[(size_t)r * 4608 + 2048 + h * 64 + pc]); Y[(size_t)r * 2048 + 1024 + h * 64 + pc] = f2bf(y); ssq += y * y; }
            ssq += __shfl_xor(ssq, 1); ssq += __shfl_xor(ssq, 2); ssq += __shfl_xor(ssq, 4); ssq += __shfl_xor(ssq, 8);
            if (fr == 0) unsafeAtomicAdd(yss + (size_t)r * 4 + 1 + g, ssq); }
    }
}

__device__ __forceinline__ void phase_ynorm(const Params& p) {
    const float* yss = (const float*)(p.ws + OFF_SS) + 2 * 8448; bf16_t* Y = (bf16_t*)(p.ws + OFF_XB);
    for (int i = blockIdx.x * 512 + threadIdx.x; i < MROWS * 256; i += gridDim.x * 512) {
        const int row = i >> 8, c8 = (i & 255) * 8, seg = c8 < 1024 ? 0 : (c8 < 1536 ? 1 : 2);
        const float rs = rsqrtf(yss[(size_t)row * 4 + seg] * (seg ? (1.0f / 512.0f) : (1.0f / 1024.0f)) + EPS);
        u32x4* ptr = (u32x4*)(Y + (size_t)row * 2048 + c8); const u32x4 v = *ptr; float f[8];
        f[0] = bf2f(v.x & 0xffffu); f[1] = bf2f(v.x >> 16); f[2] = bf2f(v.y & 0xffffu); f[3] = bf2f(v.y >> 16); f[4] = bf2f(v.z & 0xffffu); f[5] = bf2f(v.z >> 16); f[6] = bf2f(v.w & 0xffffu); f[7] = bf2f(v.w >> 16);
#pragma unroll
        for (int j = 0; j < 8; ++j) f[j] *= rs;
        *ptr = pack8(f);
    }
}
__device__ __forceinline__ void phase_final(const Params& p) {
    const float* oss = (const float*)(p.ws + OFF_SS) + 7 * 8448;
    for (int i = blockIdx.x * 512 + threadIdx.x; i < MROWS * 512; i += gridDim.x * 512) {
        const int row = i >> 9, c4 = (i & 511) * 4; const float rs = rsqrtf(oss[row] * (1.0f / 2048.0f) + EPS);
        f32x4* ptr = (f32x4*)(p.out + (size_t)row * 2048 + c4); const f32x4 gf = *(const f32x4*)(p.g_fin + c4); *ptr = *ptr * rs * gf;
    }
}

__global__ void __launch_bounds__(512, 2) mega(Params p) {
    extern __shared__ __attribute__((aligned(16))) unsigned char lds_raw[];
    LAS unsigned char* lds = (LAS unsigned char*)lds_raw;
    unsigned char* ws = p.ws; float* ss = (float*)(ws + OFF_SS);
#ifndef PHMASK
#define PHMASK 0x3ff
#endif
#define PH_ON(k) ((PHMASK >> (k)) & 1) && p.ph_lo <= (k) && (k) < p.ph_hi
#define PH_SYNC(k) if (p.ph_lo <= (k) && (k) + 1 < p.ph_hi) cg::this_grid().sync();
    if (PH_ON(0)) phase_prep(p, lds);
    PH_SYNC(0)
    if (PH_ON(1)) { pg8::Gemm g; g.A = (const bf16_t*)(ws + OFF_XB); g.Bt = (const bf16_t*)(ws + OFF_WTIN); g.M = MPAD; g.N = 4864; g.K = 2048;
        pg8::StaticOrder S; S.init(MPAD, 4864, (int)gridDim.x, (int)blockIdx.x);
        EpiProj E; E.proj = (bf16_t*)(ws + OFF_PROJ); E.dt = (float*)(ws + OFF_DT); E.xss = ss; E.vss = ss + 8448;
        pg8::gemm_phase<EpiProj, pg8::StaticOrder, false>(lds, g, S, E, nullptr); }
    PH_SYNC(1)
    if (PH_ON(2)) phase_mixer(p, lds);
    PH_SYNC(2)
    if (PH_ON(3)) phase_scan(p);
    PH_SYNC(3)
    if (PH_ON(4)) phase_combine(p);
    PH_SYNC(4)
    if (PH_ON(5)) phase_ynorm(p);
    PH_SYNC(5)
    if (PH_ON(6)) { pg8::Gemm g; g.A = (const bf16_t*)(ws + OFF_XB); g.Bt = (const bf16_t*)(ws + OFF_WTOUT); g.M = MPAD; g.N = 2048; g.K = 2048;
        pg8::StaticOrder S; S.init(MPAD, 2048, (int)gridDim.x, (int)blockIdx.x);
        EpiOut E; E.xp = p.xp; E.xs = p.xs; E.hout = p.out; E.hb = (bf16_t*)(ws + OFF_HB); E.hss = ss + 6 * 8448;
        pg8::gemm_phase<EpiOut, pg8::StaticOrder, false>(lds, g, S, E, nullptr); }
    PH_SYNC(6)
    if (PH_ON(7)) { pg8::Gemm g; g.A = (const bf16_t*)(ws + OFF_HB); g.Bt = (const bf16_t*)(ws + OFF_WTGU); g.M = MPAD; g.N = 11264; g.K = 2048;
        pg8::StaticOrder S; S.init(MPAD, 11264, (int)gridDim.x, (int)blockIdx.x);
        EpiGU E; E.act = (bf16_t*)(ws + OFF_ACT); E.hss = ss + 6 * 8448;
        pg8::gemm_phase<EpiGU, pg8::StaticOrder, false>(lds, g, S, E, nullptr); }
    PH_SYNC(7)
    if (PH_ON(8)) { pg8::Gemm g; g.A = (const bf16_t*)(ws + OFF_ACT); g.Bt = (const bf16_t*)(ws + OFF_WTDN); g.M = MPAD; g.N = 2048; g.K = 5632;
        pg8::StaticOrder S; S.init(MPAD, 2048, (int)gridDim.x, (int)blockIdx.x);
        EpiDown E; E.hout = p.out; E.oss = ss + 7 * 8448;
        pg8::gemm_phase<EpiDown, pg8::StaticOrder, false>(lds, g, S, E, nullptr); }
    PH_SYNC(8)
    if (PH_ON(9)) phase_final(p);
}

#ifndef N_LAUNCHES
#define N_LAUNCHES 1
#endif
extern "C" void kernel_launch(void* const* d_in, const int* in_sizes, int n_in, void* d_out, int out_size, void* d_ws, size_t ws_size, hipStream_t stream) {
    static int grid = 0;
    if (grid == 0) {
        if (n_in != 22 || ws_size < WS_NEED) { fprintf(stderr, "kernel_launch: bad inputs n_in %d ws %zu need %zu\n", n_in, ws_size, (size_t)WS_NEED); grid = -1; return; }
        int dev = 0, cus = 0, per_cu = 0;
        (void)hipGetDevice(&dev); (void)hipDeviceGetAttribute(&cus, hipDeviceAttributeMultiprocessorCount, dev);
        if (hipFuncSetAttribute((const void*)mega, hipFuncAttributeMaxDynamicSharedMemorySize, LDS_BYTES) != hipSuccess) { fprintf(stderr, "kernel_launch: hipFuncSetAttribute failed\n"); grid = -1; return; }
        if (hipOccupancyMaxActiveBlocksPerMultiprocessor(&per_cu, (const void*)mega, 512, LDS_BYTES) != hipSuccess || per_cu < 1) { fprintf(stderr, "kernel_launch: occupancy query says %d\n", per_cu); per_cu = 1; }
        (void)hipGetLastError();
        grid = cus > 0 ? cus : 256;
    }
    if (grid < 0) return;
    Params p{};
    const float** pin = (const float**)&p;
    for (int i = 0; i < 22; ++i) pin[i] = (const float*)d_in[i];
    p.out = (float*)d_out; p.ws = (unsigned char*)d_ws;
#if N_LAUNCHES == 1
    p.ph_lo = 0; p.ph_hi = NPHASE;
    void* args[] = {&p};
    hipError_t e = hipLaunchCooperativeKernel((const void*)mega, dim3(grid), dim3(512), args, LDS_BYTES, stream);
    if (e != hipSuccess) fprintf(stderr, "cooperative launch failed: %s (grid %d)\n", hipGetErrorString(e), grid);
#else
    for (int ph = 0; ph < NPHASE; ++ph) { p.ph_lo = ph; p.ph_hi = ph + 1; hipLaunchKernelGGL(mega, dim3(grid), dim3(512), LDS_BYTES, stream, p); }
#endif
}
```

```cpp
#include <hip/hip_runtime.h>
#include <hip/hip_cooperative_groups.h>
#include <cstdio>
namespace cg = cooperative_groups;
namespace pg8 {
#define PG8_LAS __attribute__((address_space(3)))
typedef unsigned short bf16_t;
typedef short bf16x8 __attribute__((ext_vector_type(8)));
typedef float f32x4 __attribute__((ext_vector_type(4)));
typedef unsigned u32x4 __attribute__((ext_vector_type(4)));
constexpr int BM = 256, BK = 64, HALF = 128, HTB = HALF * BK * 2  , STAGE_BYTES = 8 * HTB, NXCD = 8, WGM = 8;

__host__ __device__ __forceinline__ int lds_byte(int r, int c) { const int st = (r >> 4) * 2 + (c >> 5), rr = r & 15, cc = c & 31, ob = rr * 64 + cc * 2; return st * 1024 + (ob ^ (((ob >> 9) & 1) << 5)); }
__host__ __device__ __forceinline__ void stage_rc(int b, int& R, int& C) { const int st = b / 1024, sb = b % 1024, swz = sb ^ (((sb >> 9) & 1) << 5); R = (st >> 1) * 16 + swz / 64; C = (st & 1) * 32 + (swz % 64) / 2; }
__host__ __device__ __forceinline__ int perm32(int rho) { const int n = rho >> 4, i = rho & 15; return 8 * (i >> 2) + 4 * n + (i & 3); }

struct Unit { int pm, pn, k0, nk; };
struct Gemm { const bf16_t* A; const bf16_t* Bt; int M, N, K, ld; };

struct StaticOrder {
    int nM, nN, nwg, G, c, ntk;
    __host__ __device__ void init(int M, int N, int G_, int c_, int K_) { nM = M / BM; nN = N / BM; nwg = nM * nN; G = G_; c = c_; ntk = K_ / BK; }
    __host__ __device__ bool next(int i, Unit& u) const {
        const long L = (long)i * G + c; if (L >= nwg) return false;
        int wgid = (int)L; { const int q = nwg / NXCD, r = nwg % NXCD, xcd = wgid % NXCD, off = wgid / NXCD; wgid = (xcd < r ? xcd * (q + 1) : r * (q + 1) + (xcd - r) * q) + off; }
        const int nig = WGM * nN, gid = wgid / nig, fm = gid * WGM, gsz = (nM - fm) < WGM ? (nM - fm) : WGM;
        u.pm = fm + ((wgid % nig) % gsz); u.pn = (wgid % nig) / gsz; u.k0 = 0; u.nk = ntk; return true;
    }
    __device__ __forceinline__ void a_ready(const Unit&) const {}
    __device__ __forceinline__ void done(const Unit&) const {}
};
__device__ __forceinline__ unsigned cvt_pk_bf16(float lo, float hi) { unsigned r; asm volatile("v_cvt_pk_bf16_f32 %0, %1, %2" : "=v"(r) : "v"(lo), "v"(hi)); return r; }

template <class Epi, class Sched, bool STAMP = false>
__device__ __forceinline__ void gemm_phase(PG8_LAS unsigned char* lds, const Gemm g, const Sched& S, const Epi& E, unsigned long long* stamps) {
    int tid_ = threadIdx.x; asm volatile("" : "+v"(tid_));
    const int tid = tid_, wid = __builtin_amdgcn_readfirstlane(tid >> 6), lane = tid & 63, wr = wid >> 2, wc = wid & 3, fr = lane & 15, fq = lane >> 4;
    const int K = g.ld;
    int ts_lo = 0, ts_hi = 0, nts = 0; const unsigned long long rt_entry = STAMP ? (unsigned long long)wall_clock64() : 0ull;
#define PG8_STAMP() do { if (STAMP && wid == 0 && nts < 64) { const unsigned long long _c = (unsigned long long)clock64(); \
        ts_lo = (lane == nts) ? (int)(unsigned)_c : ts_lo; ts_hi = (lane == nts) ? (int)(unsigned)(_c >> 32) : ts_hi; ++nts; } } while (0)
    PG8_STAMP();
    unsigned voffA[2], voffB[2];
#pragma unroll
    for (int i = 0; i < 2; ++i) { int R, C; stage_rc(tid * 16 + i * 8192, R, C); const int Rb = Epi::PERM ? ((R & ~31) + perm32(R & 31)) : R;
        voffA[i] = (unsigned)(R * K + C) * 2u; voffB[i] = (unsigned)(Rb * K + C) * 2u; }
    const size_t kstep = (size_t)(BK * 2);
    const size_t hstep = (size_t)HALF * K * 2;
    const size_t tstep = 2 * hstep;
    const unsigned ldsw = (unsigned)wid * 1024u;
    const int aoff = lds_byte(wr * 64 + fr, fq * 8), boff = lds_byte(wc * 32 + fr, fq * 8);
#define PG8_SA(b, h) (((b) * 2 + (h)) * HTB)
#define PG8_SB(b, h) ((4 + (b) * 2 + (h)) * HTB)
#define PG8_STAGE(bufoff, gbase, voff) do { _Pragma("unroll") for (int _i = 0; _i < 2; ++_i) \
        __builtin_amdgcn_global_load_lds((const unsigned*)((const char*)(gbase) + (voff)[_i]), (PG8_LAS unsigned*)(lds + (bufoff) + ldsw + _i * 8192), 16, 0, 0); } while (0)
#define PG8_LDA(dst, b, h) do { _Pragma("unroll") for (int m = 0; m < 4; ++m) _Pragma("unroll") for (int k = 0; k < 2; ++k) dst[m][k] = *(const PG8_LAS bf16x8*)(lds + PG8_SA(b, h) + aoff + m * 2048 + k * 1024); } while (0)
#define PG8_LDB(dst, b, h) do { _Pragma("unroll") for (int n = 0; n < 2; ++n) _Pragma("unroll") for (int k = 0; k < 2; ++k) dst[n][k] = *(const PG8_LAS bf16x8*)(lds + PG8_SB(b, h) + boff + n * 2048 + k * 1024); } while (0)
#define PG8_MMA(ai, bj, At, Bt) do { __builtin_amdgcn_s_setprio(1); _Pragma("unroll") for (int m = 0; m < 4; ++m) _Pragma("unroll") for (int n = 0; n < 2; ++n) _Pragma("unroll") for (int k = 0; k < 2; ++k) \
        acc[ai][bj][m][n] = __builtin_amdgcn_mfma_f32_16x16x32_bf16(Bt[n][k], At[m][k], acc[ai][bj][m][n], 0, 0, 0); __builtin_amdgcn_s_setprio(0); } while (0)
#define PG8_WAIT_V(n) asm volatile("s_waitcnt vmcnt(" #n ")" ::: "memory")
#define PG8_WAIT_L(n) asm volatile("s_waitcnt lgkmcnt(" #n ")" ::: "memory")
#define PG8_BAR __builtin_amdgcn_s_barrier()
#define PG8_SCHED __builtin_amdgcn_sched_barrier(0)
    Unit cur, nxt; int ui = 0;
    if (!S.next(0, cur)) return;
    f32x4 acc[2][2][4][2];
#pragma unroll
    for (int a = 0; a < 2; ++a)
#pragma unroll
        for (int b = 0; b < 2; ++b)
#pragma unroll
            for (int m = 0; m < 4; ++m)
#pragma unroll
                for (int n = 0; n < 2; ++n) acc[a][b][m][n] = (f32x4){0.f, 0.f, 0.f, 0.f};
    bf16x8 At[4][2], B0[2][2], B1[2][2];
    const char* cA = (const char*)g.A + (size_t)cur.pm * tstep + (size_t)cur.k0 * kstep; const char* cB = (const char*)g.Bt + (size_t)cur.pn * tstep + (size_t)cur.k0 * kstep;
    S.a_ready(cur);
    float pre8[8]; E.prefetch(cur, wr, fr, pre8);
    PG8_STAGE(PG8_SB(0, 0), cB, voffB); PG8_STAGE(PG8_SA(0, 0), cA, voffA); PG8_STAGE(PG8_SB(0, 1), cB + hstep, voffB); PG8_STAGE(PG8_SA(0, 1), cA + hstep, voffA);
    if (wr == 1) PG8_BAR;
    PG8_WAIT_V(4); PG8_BAR;
    PG8_STAGE(PG8_SB(1, 0), cB + kstep, voffB); PG8_STAGE(PG8_SA(1, 0), cA + kstep, voffA); PG8_STAGE(PG8_SB(1, 1), cB + hstep + kstep, voffB);
    PG8_WAIT_V(6); PG8_BAR;
    PG8_STAMP();
    for (;;) {
        const bool has_next = S.next(ui + 1, nxt);
        const char* nA = has_next ? (const char*)g.A + (size_t)nxt.pm * tstep + (size_t)nxt.k0 * kstep : cA; const char* nB = has_next ? (const char*)g.Bt + (size_t)nxt.pn * tstep + (size_t)nxt.k0 * kstep : cB;
        const int nt = cur.nk;
        for (int t = 0; t < nt; t += 2) {
            const bool last = (t == nt - 2);
            const char* a1 = cA + (size_t)(t + 1) * kstep;
            const char* a2 = last ? nA : cA + (size_t)(t + 2) * kstep; const char* b2 = last ? nB : cB + (size_t)(t + 2) * kstep;
            const char* a3 = a2 + kstep; const char* b3 = b2 + kstep;
            if (last && has_next) S.a_ready(nxt);
            PG8_LDB(B0, 0, 0); PG8_SCHED; PG8_LDA(At, 0, 0); PG8_STAGE(PG8_SA(1, 1), a1 + hstep, voffA);
            PG8_WAIT_L(8); PG8_BAR; PG8_WAIT_L(0); PG8_MMA(0, 0, At, B0); PG8_BAR; PG8_SCHED;
            PG8_LDB(B1, 0, 1); PG8_STAGE(PG8_SB(0, 0), b2, voffB);
            PG8_BAR; PG8_WAIT_L(0); PG8_MMA(0, 1, At, B1); PG8_BAR;
            PG8_LDA(At, 0, 1); PG8_STAGE(PG8_SA(0, 0), a2, voffA);
            PG8_BAR; PG8_WAIT_L(0); PG8_MMA(1, 0, At, B0); PG8_BAR; PG8_SCHED;
            PG8_STAGE(PG8_SB(0, 1), b2 + hstep, voffB);
            PG8_WAIT_V(6); PG8_BAR; PG8_MMA(1, 1, At, B1); PG8_BAR;
            PG8_LDB(B0, 1, 0); PG8_SCHED; PG8_LDA(At, 1, 0); PG8_STAGE(PG8_SA(0, 1), a2 + hstep, voffA);
            PG8_WAIT_L(8); PG8_BAR; PG8_WAIT_L(0); PG8_MMA(0, 0, At, B0); PG8_BAR; PG8_SCHED;
            PG8_LDB(B1, 1, 1); PG8_STAGE(PG8_SB(1, 0), b3, voffB);
            PG8_BAR; PG8_WAIT_L(0); PG8_MMA(0, 1, At, B1); PG8_BAR;
            PG8_LDA(At, 1, 1); PG8_STAGE(PG8_SA(1, 0), a3, voffA);
            PG8_BAR; PG8_WAIT_L(0); PG8_MMA(1, 0, At, B0); PG8_BAR; PG8_SCHED;
            PG8_STAGE(PG8_SB(1, 1), b3 + hstep, voffB);
            PG8_WAIT_V(6); PG8_BAR; PG8_MMA(1, 1, At, B1); PG8_BAR;
        }
        PG8_STAMP();
        if constexpr (!Epi::AFTER_DRAIN) { E(acc, cur, wr, wc, fr, fq, pre8); S.done(cur); }
        PG8_STAMP();
        if (!has_next) break;
#pragma unroll
        for (int a = 0; a < 2; ++a)
#pragma unroll
            for (int b = 0; b < 2; ++b)
#pragma unroll
                for (int m = 0; m < 4; ++m)
#pragma unroll
                    for (int n = 0; n < 2; ++n) acc[a][b][m][n] = (f32x4){0.f, 0.f, 0.f, 0.f};
        cur = nxt; cA = nA; cB = nB; ++ui; E.prefetch(cur, wr, fr, pre8);
    }
    PG8_WAIT_V(0);
    if (wr == 0) PG8_BAR;
    PG8_BAR;
    if constexpr (Epi::AFTER_DRAIN) { E.fused(acc, cur, wr, wc, fr, fq, lds, wid, lane); S.done(cur); }
    PG8_STAMP();
    if (STAMP && wid == 0) { stamps[lane] = lane < nts ? (((unsigned long long)(unsigned)ts_hi << 32) | (unsigned)ts_lo) : 0ull;
        if (lane == 62) stamps[62] = rt_entry; if (lane == 63) stamps[63] = (unsigned long long)wall_clock64(); }
#undef PG8_STAMP
#undef PG8_SA
#undef PG8_SB
#undef PG8_STAGE
#undef PG8_LDA
#undef PG8_LDB
#undef PG8_MMA
#undef PG8_WAIT_V
#undef PG8_WAIT_L
#undef PG8_BAR
#undef PG8_SCHED
}
}

#define LAS __attribute__((address_space(3)))
using pg8::bf16_t; using pg8::bf16x8; using pg8::f32x4; using pg8::u32x4; using pg8::cvt_pk_bf16;
typedef unsigned u32x2 __attribute__((ext_vector_type(2)));

constexpr float EPS = 1e-6f;
constexpr int MROWS = 8320, MPAD = 8448;
constexpr int LDS_BAR_OFF = 157696;
constexpr int LDS_BYTES = LDS_BAR_OFF + 256;
constexpr int NPHASE = 10;
constexpr int LD_DN = 5632 + 64;

constexpr size_t OFF_WTIN = 0;
constexpr size_t OFF_WTOUT = OFF_WTIN + 4864ull * 2048 * 2;
constexpr size_t OFF_WTGU = OFF_WTOUT + 2048ull * 2048 * 2;
constexpr size_t OFF_WTDN = OFF_WTGU + 11264ull * 2048 * 2;
constexpr size_t OFF_SS = OFF_WTDN + 2048ull * LD_DN * 2;
constexpr size_t OFF_CTL = OFF_SS + 8448ull * 8 * 4;
constexpr size_t OFF_EAL = OFF_CTL + 16384;
constexpr size_t OFF_XB = OFF_EAL + 4096;
constexpr size_t OFF_C = OFF_XB + 8448ull * 2048 * 2;
constexpr size_t OFF_PROJ = OFF_C;
constexpr size_t OFF_DT = OFF_PROJ + 8448ull * 4608 * 2;
constexpr size_t OFF_STATES = OFF_DT + 8448ull * 16 * 4;
constexpr size_t OFF_HPREV = OFF_STATES + 64ull * 16 * 8192 * 4;
constexpr size_t OFF_YD = OFF_HPREV + 64ull * 16 * 8192 * 2;
constexpr size_t OFF_CC = OFF_YD + 8192ull * 1024 * 4;
constexpr size_t OFF_EAC = OFF_CC + 8192ull * 256 * 2;
constexpr size_t OFF_BN = OFF_EAC + 8192ull * 16 * 4;
constexpr size_t OFF_BTT = OFF_BN + 8192ull * 256 * 2;
constexpr size_t OFF_FA = OFF_BTT + 64ull * 256 * 128 * 2;
constexpr size_t OFF_FD = OFF_FA + 1024ull * 128 * 4;
constexpr size_t OFF_FW = OFF_FD + 1024ull * 128 * 4;
constexpr size_t END_C1 = OFF_FW + 1024ull * 128 * 4;
constexpr size_t OFF_XT = OFF_HPREV;
constexpr size_t OFF_HB = OFF_C;
constexpr size_t OFF_ACT = OFF_HB + 8448ull * 2048 * 2;
constexpr size_t END_C2 = OFF_ACT + 8448ull * LD_DN * 2;
constexpr size_t OFF_PARTO = OFF_ACT;
constexpr size_t OFF_PARTD = OFF_WTIN;
constexpr size_t OFF_SS2 = END_C1 > END_C2 ? END_C1 : END_C2;
constexpr size_t WS_NEED = OFF_SS2 + 8448ull * 8 * 4;

constexpr size_t O_Y = 0, O_CONVP = 17039360, O_SSMP = 17057792, O_CONVS = 17582080, O_SSMS = 18171904, O_VS = 34949120;

struct Params {
    const float* xp; const float* xs; const float* sconv; const float* sssm; const float* g_mix; const float* w_in; const float* g_cv; const float* w_s; const float* b_s;
    const float* g_co; const float* conv_w; const float* conv_b; const float* dt_bias; const float* a_log; const float* dvec; const float* g_sn; const float* w_out;
    const float* g_ffn; const float* w_gate; const float* w_up; const float* w_down; const float* g_fin;
    float* out; unsigned char* ws; int ph_lo, ph_hi; int repmask, pad;
};

__device__ __forceinline__ float bf2f(unsigned v) { return __uint_as_float(v << 16); }
__device__ __forceinline__ bf16_t f2bf(float x) { return (bf16_t)(cvt_pk_bf16(x, x) & 0xffffu); }
__device__ __forceinline__ float sigmoid_f(float x) { return __builtin_amdgcn_rcpf(1.0f + __expf(-x)); }
__device__ __forceinline__ float silu_f(float x) { return x * sigmoid_f(x); }
__device__ __forceinline__ float gelu_f(float x) { return x * sigmoid_f(1.5957691216f * (x + 0.044715f * x * x * x)); }
__device__ __forceinline__ float softplus_f(float x) { return x > 20.f ? x : log1pf(expf(x)); }
__device__ __forceinline__ f32x4 mfma16(bf16x8 a, bf16x8 b, f32x4 c) { return __builtin_amdgcn_mfma_f32_16x16x32_bf16(a, b, c, 0, 0, 0); }
__device__ __forceinline__ u32x4 pack8(const float* v) { u32x4 o; o.x = cvt_pk_bf16(v[0], v[1]); o.y = cvt_pk_bf16(v[2], v[3]); o.z = cvt_pk_bf16(v[4], v[5]); o.w = cvt_pk_bf16(v[6], v[7]); return o; }

struct EpiProj {
    static constexpr bool PERM = true, AFTER_DRAIN = false;
    bf16_t* proj; float* dt; const float* xss; float* vss;
    __device__ __forceinline__ void prefetch(const pg8::Unit& u, int wr, int fr, float (&pre)[8]) const {
#pragma unroll
        for (int q = 0; q < 8; ++q) pre[q] = xss[u.pm * 256 + wr * 64 + fr + (q >> 2) * 128 + (q & 3) * 16]; }
    __device__ __forceinline__ void operator()(const f32x4 (&acc)[2][2][4][2], const pg8::Unit& u, int wr, int wc, int fr, int fq, const float (&pre)[8]) const {
        const int row0 = u.pm * 256 + wr * 64 + fr, pn = u.pn;
        float rs8[2][4];
#pragma unroll
        for (int ai = 0; ai < 2; ++ai)
#pragma unroll
            for (int m = 0; m < 4; ++m) rs8[ai][m] = rsqrtf(pre[ai * 4 + m] * (1.0f / 2048.0f) + EPS);
        if (pn == 18) {
            if (wc == 0 && fq < 2) {
#pragma unroll
                for (int ai = 0; ai < 2; ++ai)
#pragma unroll
                    for (int m = 0; m < 4; ++m) { const int row = row0 + ai * 128 + m * 16; const float rs = rs8[ai][m];
                        float* d = dt + (size_t)row * 16 + fq * 8; *(f32x4*)d = acc[ai][0][m][0] * rs; *(f32x4*)(d + 4) = acc[ai][0][m][1] * rs; }
            }
            return;
        }
        const int kind = pn < 4 ? 0 : pn < 8 ? 1 : pn < 12 ? 2 : 3;
        const int col0 = pn * 256 + wc * 32 + 8 * fq;
#pragma unroll
        for (int ai = 0; ai < 2; ++ai)
#pragma unroll
            for (int m = 0; m < 4; ++m) { const int row = row0 + ai * 128 + m * 16; const float rs = rs8[ai][m]; float ssq = 0.f;
#pragma unroll
                for (int bj = 0; bj < 2; ++bj) { float v[8];
#pragma unroll
                    for (int j = 0; j < 4; ++j) { v[j] = acc[ai][bj][m][0][j] * rs; v[4 + j] = acc[ai][bj][m][1][j] * rs; }
                    if (kind <= 1) {
#pragma unroll
                        for (int j = 0; j < 8; ++j) v[j] = gelu_f(v[j]);
                    } else if (kind == 2) {
#pragma unroll
                        for (int j = 0; j < 8; ++j) v[j] = silu_f(v[j]);
                    }
                    if (kind == 1) {
#pragma unroll
                        for (int j = 0; j < 8; ++j) ssq += v[j] * v[j];
                    }
                    *(u32x4*)(proj + (size_t)row * 4608 + col0 + bj * 128) = pack8(v); }
                if (kind == 1) { ssq += __shfl_xor(ssq, 16); ssq += __shfl_xor(ssq, 32); if (fq == 0) unsafeAtomicAdd(vss + row, ssq); }
            }
    }
};
struct EpiOut {
    static constexpr bool PERM = false, AFTER_DRAIN = false;
    const float* xp; const float* xs; float* hout; bf16_t* hb; float* hss; float* part;
    __device__ __forceinline__ void prefetch(const pg8::Unit&, int, int, float (&)[8]) const {}
    __device__ __forceinline__ void operator()(const f32x4 (&acc)[2][2][4][2], const pg8::Unit& u, int wr, int wc, int fr, int fq, const float (&pre)[8]) const {
        const int row0 = u.pm * 256 + wr * 64 + fr, col0 = u.pn * 256 + wc * 32 + 4 * fq;
        if (u.nk < 32) {
            float* pp = part + ((size_t)(u.k0 >> 2) * 128 + (wr * 64 + fr)) * 2048 + col0;
#pragma unroll
            for (int m = 0; m < 4; ++m)
#pragma unroll
                for (int bj = 0; bj < 2; ++bj)
#pragma unroll
                    for (int n = 0; n < 2; ++n) *(f32x4*)(pp + (size_t)m * 16 * 2048 + bj * 128 + n * 16) = acc[0][bj][m][n];
            return;
        }
#pragma unroll
        for (int am = 0; am < 4; ++am) { const int ai = am >> 1, mb = (am & 1) * 2;
            f32x4 xv[2][2][2];
#pragma unroll
            for (int mm = 0; mm < 2; ++mm) { const int row = row0 + ai * 128 + (mb + mm) * 16; const float* xr = xp + (size_t)row * 2048 + col0;
#pragma unroll
                for (int bj = 0; bj < 2; ++bj)
#pragma unroll
                    for (int n = 0; n < 2; ++n) xv[mm][bj][n] = *(const f32x4*)(xr + bj * 128 + n * 16); }
#pragma unroll
            for (int mm = 0; mm < 2; ++mm)
#pragma unroll
                for (int bj = 0; bj < 2; ++bj)
#pragma unroll
                    for (int n = 0; n < 2; ++n) asm volatile("" : "+v"(xv[mm][bj][n]));
#pragma unroll
            for (int mm = 0; mm < 2; ++mm) { const int m = mb + mm; const int row = row0 + ai * 128 + m * 16; float ssq = 0.f;
#pragma unroll
                for (int bj = 0; bj < 2; ++bj)
#pragma unroll
                    for (int n = 0; n < 2; ++n) { const f32x4 hv = xv[mm][bj][n] + acc[ai][bj][m][n];
                        ssq += hv[0] * hv[0] + hv[1] * hv[1] + hv[2] * hv[2] + hv[3] * hv[3];
                        u32x2 o; o.x = cvt_pk_bf16(hv[0], hv[1]); o.y = cvt_pk_bf16(hv[2], hv[3]); *(u32x2*)(hb + (size_t)row * 2048 + col0 + bj * 128 + n * 16) = o; }
                ssq += __shfl_xor(ssq, 16); ssq += __shfl_xor(ssq, 32); if (fq == 0) unsafeAtomicAdd(hss + row, ssq);
            }
        }
    }
};
struct OutOrder {
    int c;
    __device__ __forceinline__ bool next(int i, pg8::Unit& u) const {
        if (i == 0) { const int x = c & 7, j = c >> 3; u.pm = 4 * x + (j >> 3); u.pn = j & 7; u.k0 = 0; u.nk = 32; return true; }
        if (i == 1 && c < 64) { u.pm = 32; u.pn = c >> 3; u.k0 = (c & 7) * 4; u.nk = 4; return true; }
        return false;
    }
    __device__ __forceinline__ void a_ready(const pg8::Unit&) const {}
    __device__ __forceinline__ void done(const pg8::Unit&) const {}
};
struct GuDepOrder : pg8::StaticOrder {
    const unsigned* flag;
    __device__ __forceinline__ void a_ready(const pg8::Unit& u) const {
        if (u.pm == 32) {
            if (threadIdx.x < 64) { unsigned spins = 0;
                while ((unsigned)__builtin_amdgcn_readfirstlane(__hip_atomic_load(flag, __ATOMIC_RELAXED, __HIP_MEMORY_SCOPE_AGENT)) < 16u && ++spins < (1u << 20)) __builtin_amdgcn_s_sleep(2);
                __builtin_amdgcn_fence(__ATOMIC_ACQUIRE, "agent");
                asm volatile("s_waitcnt vmcnt(0)" ::: "memory"); }
            asm volatile("" ::: "memory"); __builtin_amdgcn_s_barrier(); asm volatile("" ::: "memory");
        }
    }
};
struct EpiGU {
    static constexpr bool PERM = true, AFTER_DRAIN = false;
    bf16_t* act; const float* hss;
    __device__ __forceinline__ void prefetch(const pg8::Unit& u, int wr, int fr, float (&pre)[8]) const {
#pragma unroll
        for (int q = 0; q < 8; ++q) pre[q] = hss[u.pm * 256 + wr * 64 + fr + (q >> 2) * 128 + (q & 3) * 16]; }
    __device__ __forceinline__ void operator()(const f32x4 (&acc)[2][2][4][2], const pg8::Unit& u, int wr, int wc, int fr, int fq, const float (&pre)[8]) const {
        const int row0 = u.pm * 256 + wr * 64 + fr, col0 = u.pn * 128 + wc * 32 + 8 * fq;
        float rs8[2][4];
#pragma unroll
        for (int ai = 0; ai < 2; ++ai)
#pragma unroll
            for (int m = 0; m < 4; ++m) rs8[ai][m] = rsqrtf(pre[ai * 4 + m] * (1.0f / 2048.0f) + EPS);
#pragma unroll
        for (int ai = 0; ai < 2; ++ai)
#pragma unroll
            for (int m = 0; m < 4; ++m) { const int row = row0 + ai * 128 + m * 16; const float rs = rs8[ai][m]; float v[8];
#pragma unroll
                for (int j = 0; j < 4; ++j) { v[j] = silu_f(acc[ai][0][m][0][j] * rs) * (acc[ai][1][m][0][j] * rs); v[4 + j] = silu_f(acc[ai][0][m][1][j] * rs) * (acc[ai][1][m][1][j] * rs); }
                *(u32x4*)(act + (size_t)row * LD_DN + col0) = pack8(v); }
    }
};
struct EpiDown {
    static constexpr bool PERM = false, AFTER_DRAIN = false;
    bf16_t* hb; float* hdst; float* part;
    __device__ __forceinline__ void prefetch(const pg8::Unit&, int, int, float (&)[8]) const {}
    __device__ __forceinline__ void operator()(const f32x4 (&acc)[2][2][4][2], const pg8::Unit& u, int wr, int wc, int fr, int fq, const float (&pre)[8]) const {
        const int row0 = u.pm * 256 + wr * 64 + fr, col0 = u.pn * 256 + wc * 32 + 4 * fq;
        if (u.nk < 88) {
            float* pp = part + ((size_t)(u.k0 >> 3) * 128 + (wr * 64 + fr)) * 2048 + col0;
#pragma unroll
            for (int m = 0; m < 4; ++m)
#pragma unroll
                for (int bj = 0; bj < 2; ++bj)
#pragma unroll
                    for (int n = 0; n < 2; ++n) *(f32x4*)(pp + (size_t)m * 16 * 2048 + bj * 128 + n * 16) = acc[0][bj][m][n];
            return;
        }
#pragma unroll
        for (int ai = 0; ai < 2; ++ai) {
            u32x2 hv[4][2][2];
#pragma unroll
            for (int m = 0; m < 4; ++m) { const bf16_t* hr = hb + (size_t)(row0 + ai * 128 + m * 16) * 2048 + col0;
#pragma unroll
                for (int bj = 0; bj < 2; ++bj)
#pragma unroll
                    for (int n = 0; n < 2; ++n) hv[m][bj][n] = *(const u32x2*)(hr + bj * 128 + n * 16); }
#pragma unroll
            for (int m = 0; m < 4; ++m)
#pragma unroll
                for (int bj = 0; bj < 2; ++bj)
#pragma unroll
                    for (int n = 0; n < 2; ++n) asm volatile("" : "+v"(hv[m][bj][n]));
#pragma unroll
            for (int m = 0; m < 4; ++m) { bf16_t* hw = hb + (size_t)(row0 + ai * 128 + m * 16) * 2048 + col0;
#pragma unroll
                for (int bj = 0; bj < 2; ++bj)
#pragma unroll
                    for (int n = 0; n < 2; ++n) { const u32x2 q = hv[m][bj][n]; f32x4 hf; hf[0] = __uint_as_float(q.x << 16); hf[1] = __uint_as_float(q.x & 0xffff0000u); hf[2] = __uint_as_float(q.y << 16); hf[3] = __uint_as_float(q.y & 0xffff0000u);
                        const f32x4 o = hf + acc[ai][bj][m][n]; u32x2 ob; ob.x = cvt_pk_bf16(o[0], o[1]); ob.y = cvt_pk_bf16(o[2], o[3]); *(u32x2*)(hw + bj * 128 + n * 16) = ob; } }
        }
    }
};
struct DownOrder {
    int c;
    __device__ __forceinline__ bool next(int i, pg8::Unit& u) const {
        if (i == 0) { const int x = c & 7, j = c >> 3; u.pm = 4 * x + (j >> 3); u.pn = j & 7; u.k0 = 0; u.nk = 88; return true; }
        if (i == 1 && c < 88) { u.pm = 32; u.pn = c / 11; u.k0 = (c % 11) * 8; u.nk = 8; return true; }
        return false;
    }
    __device__ __forceinline__ void a_ready(const pg8::Unit&) const {}
    __device__ __forceinline__ void done(const pg8::Unit&) const {}
};

struct WTile { const float* W; bf16_t* dst; int N, ldt, k0, n0, drow0, gsel; };
__device__ __forceinline__ void wt_decode(const Params& p, int tt, WTile& w) {
    unsigned char* ws = p.ws; int kt, nt;
    if (tt < 1184) { kt = tt & 31; nt = tt >> 5; w.W = p.w_in; w.N = 4624; w.ldt = 2048; w.dst = (bf16_t*)(ws + OFF_WTIN); w.drow0 = nt * 128; w.gsel = 0; }
    else if (tt < 1696) { const int q = tt - 1184; kt = q & 31; nt = q >> 5; w.W = p.w_out; w.N = 2048; w.ldt = 2048; w.dst = (bf16_t*)(ws + OFF_WTOUT); w.drow0 = nt * 128; w.gsel = 1; }
    else if (tt < 3104) { const int q = tt - 1696; kt = q & 31; nt = q >> 5; w.W = p.w_gate; w.N = 5632; w.ldt = 2048; w.dst = (bf16_t*)(ws + OFF_WTGU); w.drow0 = 256 * nt; w.gsel = 2; }
    else if (tt < 4512) { const int q = tt - 3104; kt = q & 31; nt = q >> 5; w.W = p.w_up; w.N = 5632; w.ldt = 2048; w.dst = (bf16_t*)(ws + OFF_WTGU); w.drow0 = 256 * nt + 128; w.gsel = 2; }
    else { const int q = tt - 4512; kt = q % 88; nt = q / 88; w.W = p.w_down; w.N = 2048; w.ldt = LD_DN; w.dst = (bf16_t*)(ws + OFF_WTDN); w.drow0 = nt * 128; w.gsel = 3; }
    w.k0 = kt * 64; w.n0 = nt * 128;
}
__device__ __forceinline__ void wt_load(const Params& p, const WTile& w, int r, int c4, f32x4 (&v)[4], float (&gk)[4]) {
    const bool ok = w.n0 + c4 < w.N; const float* wp = w.W + (ok ? w.n0 + c4 : 0);
#pragma unroll
    for (int q = 0; q < 4; ++q) { const int k = w.k0 + r + 16 * q;
        gk[q] = w.gsel == 0 ? p.g_mix[k] : w.gsel == 1 ? (k < 1024 ? p.g_co[k] : p.g_sn[k - 1024]) : w.gsel == 2 ? p.g_ffn[k] : 1.0f; if (!ok) gk[q] = 0.f;
        v[q] = *(const f32x4*)(wp + (size_t)k * w.N); }
}
__device__ __forceinline__ void wt_convert(const Params& p, LAS unsigned char* lds, int t_begin, int t_end, int worker, int G) {
    const int tid = threadIdx.x;
    {
        LAS float* tile = (LAS float*)lds;
        const int r = tid >> 5, c4 = (tid & 31) * 4;
        WTile ta, tb; f32x4 va[4], vb[4]; float ga[4], gb[4];
        int t = t_begin + worker;
        bool ha = t < t_end, hb = t + G < t_end;
        if (ha) { wt_decode(p, t, ta); wt_load(p, ta, r, c4, va, ga); }
        if (hb) { wt_decode(p, t + G, tb); wt_load(p, tb, r, c4, vb, gb); }
        while (ha) {
            {
#pragma unroll
                for (int q = 0; q < 4; ++q) { LAS float* tp = tile + (r + 16 * q) * 129 + c4; tp[0] = va[q][0] * ga[q]; tp[1] = va[q][1] * ga[q]; tp[2] = va[q][2] * ga[q]; tp[3] = va[q][3] * ga[q]; }
                __syncthreads();
                bf16_t* cdst = ta.dst + (size_t)(ta.drow0 + (tid >> 2)) * ta.ldt + ta.k0 + (tid & 3) * 16;
                const int tn = t + 2 * G; ha = tn < t_end;
                if (ha) { wt_decode(p, tn, ta); wt_load(p, ta, r, c4, va, ga); }
                const int n = tid >> 2, kq = tid & 3; float o[16];
#pragma unroll
                for (int i = 0; i < 16; ++i) o[i] = tile[(kq * 16 + i) * 129 + n];
                *(u32x4*)cdst = pack8(o); *(u32x4*)(cdst + 8) = pack8(o + 8);
                __syncthreads();
            }
            if (hb) {
#pragma unroll
                for (int q = 0; q < 4; ++q) { LAS float* tp = tile + (r + 16 * q) * 129 + c4; tp[0] = vb[q][0] * gb[q]; tp[1] = vb[q][1] * gb[q]; tp[2] = vb[q][2] * gb[q]; tp[3] = vb[q][3] * gb[q]; }
                __syncthreads();
                bf16_t* cdst = tb.dst + (size_t)(tb.drow0 + (tid >> 2)) * tb.ldt + tb.k0 + (tid & 3) * 16;
                const int tn = t + 3 * G; hb = tn < t_end;
                if (hb) { wt_decode(p, tn, tb); wt_load(p, tb, r, c4, vb, gb); }
                const int n = tid >> 2, kq = tid & 3; float o[16];
#pragma unroll
                for (int i = 0; i < 16; ++i) o[i] = tile[(kq * 16 + i) * 129 + n];
                *(u32x4*)cdst = pack8(o); *(u32x4*)(cdst + 8) = pack8(o + 8);
                __syncthreads();
            }
            t += 2 * G;
        }
    }
}
__device__ __forceinline__ void phase_prep(const Params& p, LAS unsigned char* lds) {
    const int tid = threadIdx.x, lane = tid & 63, wv = tid >> 6, G = gridDim.x;
    unsigned char* ws = p.ws;
    float* ss = (float*)(ws + OFF_SS);
    for (int i = blockIdx.x * 512 + tid; i < 8448 * 7; i += G * 512) ss[8448 + i] = 0.f;
    if (blockIdx.x == 0 && tid < 128) ss[MROWS + tid] = 2048.f;
    bf16_t* XB = (bf16_t*)(ws + OFF_XB);
    for (int row = blockIdx.x * 8 + wv; row < MROWS; row += G * 8) {
        const float* src = row < 8192 ? p.xp + (size_t)row * 2048 : p.xs + (size_t)(row - 8192) * 2048;
        float s = 0.f; f32x4 xv[8];
#pragma unroll
        for (int j = 0; j < 8; ++j) xv[j] = *(const f32x4*)(src + j * 256 + lane * 4);
#pragma unroll
        for (int j = 0; j < 8; ++j) { const f32x4 v = xv[j]; s += v[0] * v[0] + v[1] * v[1] + v[2] * v[2] + v[3] * v[3];
            u32x2 o; o.x = cvt_pk_bf16(v[0], v[1]); o.y = cvt_pk_bf16(v[2], v[3]); *(u32x2*)(XB + (size_t)row * 2048 + j * 256 + lane * 4) = o; }
#pragma unroll
        for (int o = 32; o >= 1; o >>= 1) s += __shfl_xor(s, o);
        if (lane == 0) ss[row] = s;
    }
    wt_convert(p, lds, 0, 1184, (int)blockIdx.x, G);
    { u32x4* z = (u32x4*)(ws + OFF_WTIN + 4736ull * 2048 * 2); for (int i = blockIdx.x * 512 + tid; i < 32768; i += G * 512) z[i] = (u32x4){0u, 0u, 0u, 0u}; }
}

__device__ __forceinline__ void phase_conv(const Params& p, LAS unsigned char* lds) {
    const int tid = threadIdx.x, G = gridDim.x;
    unsigned char* ws = p.ws;
    const bf16_t* PROJ = (const bf16_t*)(ws + OFF_PROJ);
    bf16_t* XT = (bf16_t*)(ws + OFF_XT); bf16_t* BN = (bf16_t*)(ws + OFF_BN); bf16_t* BTT = (bf16_t*)(ws + OFF_BTT); bf16_t* CC = (bf16_t*)(ws + OFF_CC);
    for (int tsk = blockIdx.x * 512 + tid; tsk < 98304; tsk += G * 512) {
        const int cgi = tsk % 192, rest = tsk / 192, tt0 = (rest & 7) * 16, bc = rest >> 3;
        const int R0 = (bc >> 4) * 2048 + (bc & 15) * 128; const bool first = (bc & 15) == 0;
        const int ch0 = cgi * 8, kind = ch0 < 1024 ? 0 : (ch0 < 1280 ? 1 : 2);
        u32x4 in[19];
#pragma unroll
        for (int j = 0; j < 19; ++j) { const bool ok = !(first && tt0 - 3 + j < 0); const int rr = ok ? (R0 + tt0 - 3 + j) : R0;
            in[j] = *(const u32x4*)(PROJ + (size_t)rr * 4608 + 3072 + ch0); if (!ok) in[j] = (u32x4){0u, 0u, 0u, 0u}; }
        unsigned nat[16][4];
#pragma unroll
        for (int e2 = 0; e2 < 4; ++e2) {
            const int ea = 2 * e2, eb = 2 * e2 + 1; float oa[16], ob[16];
            typedef float f32x2v __attribute__((ext_vector_type(2)));
            const f32x2v q0 = *(const f32x2v*)(p.conv_w + ch0 + ea), q1 = *(const f32x2v*)(p.conv_w + 1536 + ch0 + ea), q2 = *(const f32x2v*)(p.conv_w + 3072 + ch0 + ea), q3 = *(const f32x2v*)(p.conv_w + 4608 + ch0 + ea), qb = *(const f32x2v*)(p.conv_b + ch0 + ea);
            const float w0a = q0.x, w1a = q1.x, w2a = q2.x, w3a = q3.x, cba = qb.x, w0b = q0.y, w1b = q1.y, w2b = q2.y, w3b = q3.y, cbb = qb.y;
#pragma unroll
            for (int t = 0; t < 16; ++t) {
                oa[t] = silu_f(cba + w0a * __uint_as_float(in[t][e2] << 16) + w1a * __uint_as_float(in[t + 1][e2] << 16) + w2a * __uint_as_float(in[t + 2][e2] << 16) + w3a * __uint_as_float(in[t + 3][e2] << 16));
                ob[t] = silu_f(cbb + w0b * __uint_as_float(in[t][e2] & 0xffff0000u) + w1b * __uint_as_float(in[t + 1][e2] & 0xffff0000u) + w2b * __uint_as_float(in[t + 2][e2] & 0xffff0000u) + w3b * __uint_as_float(in[t + 3][e2] & 0xffff0000u));
                nat[t][e2] = cvt_pk_bf16(oa[t], ob[t]); }
            if (kind <= 1) { bf16_t* tp = kind == 0 ? XT + ((size_t)(bc * 1024 + ch0 + ea) * 128 + tt0) : BTT + ((size_t)(bc * 256 + (ch0 - 1024) + ea) * 128 + tt0);
                *(u32x4*)tp = pack8(oa); *(u32x4*)(tp + 8) = pack8(oa + 8); *(u32x4*)(tp + 128) = pack8(ob); *(u32x4*)(tp + 136) = pack8(ob + 8); }
        }
        if (kind >= 1) { bf16_t* np = (kind == 1 ? BN + (ch0 - 1024) : CC + (ch0 - 1280)) + (size_t)(R0 + tt0) * 256;
#pragma unroll
            for (int t = 0; t < 16; ++t) { u32x4 o; o.x = nat[t][0]; o.y = nat[t][1]; o.z = nat[t][2]; o.w = nat[t][3]; *(u32x4*)(np + (size_t)t * 256) = o; } }
    }
    const float* DT = (const float*)(ws + OFF_DT); float* EAC = (float*)(ws + OFF_EAC); float* EAL = (float*)(ws + OFF_EAL);
    float* FA = (float*)(ws + OFF_FA); float* FD = (float*)(ws + OFF_FD); float* FW = (float*)(ws + OFF_FW);
    LAS float* ftot = (LAS float*)lds;
    const int lane = tid & 63, wv8 = tid >> 6;
    for (int s0 = blockIdx.x * 4; s0 < 1024; s0 += G * 4) {
        const int q = tid >> 7, t = tid & 127, seq = s0 + q, bc = seq >> 4, h = seq & 15, R0 = (bc >> 4) * 2048 + (bc & 15) * 128;
        const float dtv = softplus_f(DT[(size_t)(R0 + t) * 16 + h] + p.dt_bias[h]);
        float xa = dtv * (-expf(p.a_log[h]));
#pragma unroll
        for (int o = 1; o < 64; o <<= 1) { const float u = __shfl_up(xa, o); if (lane >= o) xa += u; }
        if (lane == 63) ftot[wv8] = xa;
        __syncthreads();
        if (wv8 & 1) xa += ftot[wv8 - 1];
        if (t == 127) ftot[8 + q] = xa;
        __syncthreads();
        const float a_last = ftot[8 + q];
        FA[seq * 128 + t] = xa; FD[seq * 128 + t] = dtv; FW[seq * 128 + t] = expf(a_last - xa) * dtv; EAC[(size_t)(R0 + t) * 16 + h] = expf(xa);
        if (t == 127) EAL[seq] = expf(a_last);
        __syncthreads();
    }
}

__device__ __forceinline__ void conv16(const Params& p, const bf16_t* PROJ, int R0, int t0, bool first, int ch, float (&o)[16]) {
    float in[19];
    const bf16_t* src = PROJ + (size_t)(R0 + t0) * 4608 + 3072 + ch;
#pragma unroll
    for (int j = 0; j < 19; ++j) { in[j] = 0.f; if (!(first && t0 - 3 + j < 0)) in[j] = bf2f(src[(ptrdiff_t)(j - 3) * 4608]); }
    const float w0 = p.conv_w[ch], w1 = p.conv_w[1536 + ch], w2 = p.conv_w[3072 + ch], w3 = p.conv_w[4608 + ch], cb = p.conv_b[ch];
#pragma unroll
    for (int t = 0; t < 16; ++t) o[t] = silu_f(cb + w0 * in[t] + w1 * in[t + 1] + w2 * in[t + 2] + w3 * in[t + 3]);
}

__device__ __forceinline__ void ssd_local(const Params& p, LAS unsigned char* lds, int b, int c, int h) {
    const int tid = threadIdx.x, lane = tid & 63, w = __builtin_amdgcn_readfirstlane(tid >> 6), g = h >> 3, fr = lane & 15, fq = lane >> 4;
    const int R0 = b * 2048 + c * 128, t0 = w * 16;
    unsigned char* ws = p.ws;
    const bf16_t* PROJ = (const bf16_t*)(ws + OFF_PROJ);
    const float* DT = (const float*)(ws + OFF_DT);
    float* EAC = (float*)(ws + OFF_EAC); float* EAL = (float*)(ws + OFF_EAL);
    LAS unsigned char* CcL = lds; LAS unsigned char* BcL = lds + 34816; LAS unsigned char* BTL = lds + 69632; LAS unsigned char* xTL = lds + 104448;
    LAS unsigned char* ML = lds + 121856;
    LAS float* fa = (LAS float*)(lds + 156672); LAS float* fd = fa + 128;
    {
        const int bc = b * 16 + c, seq = bc * 16 + h;
        const bf16_t* CC = (const bf16_t*)(ws + OFF_CC); const bf16_t* BN = (const bf16_t*)(ws + OFF_BN); const bf16_t* BTT = (const bf16_t*)(ws + OFF_BTT); const bf16_t* XT = (const bf16_t*)(ws + OFF_XT);
        if (tid < 128) { fa[tid] = ((const float*)(ws + OFF_FA))[seq * 128 + tid]; fd[tid] = ((const float*)(ws + OFF_FD))[seq * 128 + tid]; }
        const f32x4 fw0 = *(const f32x4*)((const float*)(ws + OFF_FW) + seq * 128 + (tid & 15) * 8), fw1 = *(const f32x4*)((const float*)(ws + OFF_FW) + seq * 128 + (tid & 15) * 8 + 4);
        u32x4 cv[4], bv[4], tv[4], xv[2];
#pragma unroll
        for (int i = 0; i < 4; ++i) { const int q = tid + 512 * i, row = q >> 4, c16 = q & 15;
            cv[i] = *(const u32x4*)(CC + (size_t)(R0 + row) * 256 + g * 128 + c16 * 8); bv[i] = *(const u32x4*)(BN + (size_t)(R0 + row) * 256 + g * 128 + c16 * 8);
            tv[i] = *(const u32x4*)(BTT + ((size_t)(bc * 256 + g * 128 + row) * 128 + c16 * 8)); }
#pragma unroll
        for (int i = 0; i < 2; ++i) { const int q = tid + 512 * i, row = q >> 4, c16 = q & 15; xv[i] = *(const u32x4*)(XT + ((size_t)(bc * 1024 + h * 64 + row) * 128 + c16 * 8)); }
#pragma unroll
        for (int i = 0; i < 4; ++i) { const int q = tid + 512 * i, row = q >> 4, c16 = q & 15; *(LAS u32x4*)(CcL + row * 272 + c16 * 16) = cv[i]; *(LAS u32x4*)(BcL + row * 272 + c16 * 16) = bv[i]; }
#pragma unroll
        for (int i = 0; i < 2; ++i) { const int q = tid + 512 * i, row = q >> 4, c16 = q & 15; *(LAS u32x4*)(xTL + row * 272 + c16 * 16) = xv[i]; }
#pragma unroll
        for (int i = 0; i < 4; ++i) { const int q = tid + 512 * i, row = q >> 4, c16 = q & 15; float f[8];
#pragma unroll
            for (int e = 0; e < 4; ++e) { const float wa = (2 * e < 4) ? fw0[(2 * e) & 3] : fw1[(2 * e) & 3], wb = (2 * e + 1 < 4) ? fw0[(2 * e + 1) & 3] : fw1[(2 * e + 1) & 3];
                f[2 * e] = __uint_as_float(tv[i][e] << 16) * wa; f[2 * e + 1] = __uint_as_float(tv[i][e] & 0xffff0000u) * wb; }
            *(LAS u32x4*)(BTL + row * 272 + c16 * 16) = pack8(f); }
        __syncthreads();
    }
    f32x4 cbt[8];
#pragma unroll
    for (int j = 0; j < 8; ++j) cbt[j] = (f32x4){0.f, 0.f, 0.f, 0.f};
#pragma unroll
    for (int ks = 0; ks < 4; ++ks) { const bf16x8 a = *(LAS bf16x8*)(CcL + (t0 + fr) * 272 + (ks * 32 + fq * 8) * 2);
#pragma unroll
        for (int j = 0; j < 8; ++j) if (j <= w) { const bf16x8 bb = *(LAS bf16x8*)(BcL + (j * 16 + fr) * 272 + (ks * 32 + fq * 8) * 2); cbt[j] = mfma16(a, bb, cbt[j]); } }
#pragma unroll
    for (int j = 0; j < 8; ++j) if (j <= (w | 1)) {
#pragma unroll
        for (int i = 0; i < 4; ++i) { const int t = t0 + fq * 4 + i, s = j * 16 + fr; float v = 0.f; if (j <= w && s <= t) v = cbt[j][i] * __expf(fa[t] - fa[s]) * fd[s];
            *(LAS bf16_t*)(ML + t * 272 + s * 2) = f2bf(v); } }
    const int nks = (w >> 1) + 1;
    f32x4 yd[4];
#pragma unroll
    for (int j = 0; j < 4; ++j) yd[j] = (f32x4){0.f, 0.f, 0.f, 0.f};
#pragma unroll
    for (int ks = 0; ks < 4; ++ks) if (ks < nks) { const bf16x8 a = *(LAS bf16x8*)(ML + (t0 + fr) * 272 + (ks * 32 + fq * 8) * 2);
#pragma unroll
        for (int pj = 0; pj < 4; ++pj) { const bf16x8 bb = *(LAS bf16x8*)(xTL + (pj * 16 + fr) * 272 + (ks * 32 + fq * 8) * 2); yd[pj] = mfma16(a, bb, yd[pj]); } }
    { float* YD = (float*)(ws + OFF_YD); const float Dh = p.dvec[h];
#pragma unroll
        for (int pj = 0; pj < 4; ++pj)
#pragma unroll
            for (int i = 0; i < 4; ++i) { const int t = t0 + fq * 4 + i, pc = pj * 16 + fr; const float xv = bf2f(*(LAS bf16_t*)(xTL + pc * 272 + t * 2));
                YD[(size_t)(R0 + t) * 1024 + h * 64 + pc] = yd[pj][i] + Dh * xv; } }
    f32x4 st[4];
#pragma unroll
    for (int j = 0; j < 4; ++j) st[j] = (f32x4){0.f, 0.f, 0.f, 0.f};
#pragma unroll
    for (int ks = 0; ks < 4; ++ks) { const bf16x8 bb = *(LAS bf16x8*)(BTL + (t0 + fr) * 272 + (ks * 32 + fq * 8) * 2);
#pragma unroll
        for (int pi = 0; pi < 4; ++pi) { const bf16x8 a = *(LAS bf16x8*)(xTL + (pi * 16 + fr) * 272 + (ks * 32 + fq * 8) * 2); st[pi] = mfma16(a, bb, st[pi]); } }
    { float* S = (float*)(ws + OFF_STATES) + (size_t)((b * 16 + c) * 16 + h) * 8192;
#pragma unroll
        for (int pi = 0; pi < 4; ++pi)
#pragma unroll
            for (int i = 0; i < 4; ++i) S[(pi * 16 + fq * 4 + i) * 128 + t0 + fr] = st[pi][i]; }
    __syncthreads();
}

__device__ __forceinline__ void ssd_group(const Params& p, LAS unsigned char* lds, int b, int c, int g) {
    const int tid = threadIdx.x, lane = tid & 63, w = __builtin_amdgcn_readfirstlane(tid >> 6), fr = lane & 15, fq = lane >> 4;
    const int R0 = b * 2048 + c * 128, t0 = w * 16, bc = b * 16 + c;
    unsigned char* ws = p.ws;
    const bf16_t* CC = (const bf16_t*)(ws + OFF_CC); const bf16_t* BN = (const bf16_t*)(ws + OFF_BN); const bf16_t* BTT = (const bf16_t*)(ws + OFF_BTT); const bf16_t* XT = (const bf16_t*)(ws + OFF_XT);
    const float* FA = (const float*)(ws + OFF_FA); const float* FD = (const float*)(ws + OFF_FD); const float* FW = (const float*)(ws + OFF_FW);
    LAS unsigned char* CcL = lds; LAS unsigned char* BcL = lds + 34816; LAS unsigned char* BTL = lds + 69632;
    LAS unsigned char* ML = lds;
    LAS float* faL = (LAS float*)(lds + 104448); LAS float* fdL = faL + 1024;
    {
        u32x4 cv[4], bv[4], tv[4];
#pragma unroll
        for (int i = 0; i < 4; ++i) { const int q = tid + 512 * i, row = q >> 4, c16 = q & 15;
            cv[i] = *(const u32x4*)(CC + (size_t)(R0 + row) * 256 + g * 128 + c16 * 8); bv[i] = *(const u32x4*)(BN + (size_t)(R0 + row) * 256 + g * 128 + c16 * 8);
            tv[i] = *(const u32x4*)(BTT + ((size_t)(bc * 256 + g * 128 + row) * 128 + c16 * 8)); }
        float fav[2], fdv[2];
#pragma unroll
        for (int k = 0; k < 2; ++k) { const int q = tid + 512 * k; fav[k] = FA[(size_t)(bc * 16 + g * 8) * 128 + q]; fdv[k] = FD[(size_t)(bc * 16 + g * 8) * 128 + q]; }
#pragma unroll
        for (int i = 0; i < 4; ++i) { const int q = tid + 512 * i, row = q >> 4, c16 = q & 15; *(LAS u32x4*)(CcL + row * 272 + c16 * 16) = cv[i]; *(LAS u32x4*)(BcL + row * 272 + c16 * 16) = bv[i]; *(LAS u32x4*)(BTL + row * 272 + c16 * 16) = tv[i]; }
#pragma unroll
        for (int k = 0; k < 2; ++k) { faL[tid + 512 * k] = fav[k]; fdL[tid + 512 * k] = fdv[k]; }
    }
    __syncthreads();
    f32x4 cbt[8];
#pragma unroll
    for (int j = 0; j < 8; ++j) cbt[j] = (f32x4){0.f, 0.f, 0.f, 0.f};
#pragma unroll
    for (int ks = 0; ks < 4; ++ks) { const bf16x8 a = *(LAS bf16x8*)(CcL + (t0 + fr) * 272 + (ks * 32 + fq * 8) * 2);
#pragma unroll
        for (int j = 0; j < 8; ++j) if (j <= w) { const bf16x8 bb = *(LAS bf16x8*)(BcL + (j * 16 + fr) * 272 + (ks * 32 + fq * 8) * 2); cbt[j] = mfma16(a, bb, cbt[j]); } }
    u32x4 xv[2]; f32x4 fw0, fw1;
    { const int seq = bc * 16 + g * 8;
#pragma unroll
        for (int i = 0; i < 2; ++i) { const int q = tid + 512 * i, row = q >> 4, c16 = q & 15; xv[i] = *(const u32x4*)(XT + ((size_t)(bc * 1024 + g * 512 + row) * 128 + c16 * 8)); }
        fw0 = *(const f32x4*)(FW + (size_t)seq * 128 + (tid & 15) * 8); fw1 = *(const f32x4*)(FW + (size_t)seq * 128 + (tid & 15) * 8 + 4); }
    __syncthreads();
    const int nks = (w >> 1) + 1;
    for (int hh = 0; hh < 8; ++hh) {
        const int h = g * 8 + hh;
        LAS float* fa = faL + hh * 128; LAS float* fd = fdL + hh * 128;
        LAS unsigned char* xTL = lds + ((hh & 1) ? 112640 : 34816); LAS unsigned char* xTsL = xTL + 17408;
#pragma unroll
        for (int i = 0; i < 2; ++i) { const int q = tid + 512 * i, row = q >> 4, c16 = q & 15; float f[8];
#pragma unroll
            for (int e = 0; e < 4; ++e) { const float wa = (2 * e < 4) ? fw0[(2 * e) & 3] : fw1[(2 * e) & 3], wb = (2 * e + 1 < 4) ? fw0[(2 * e + 1) & 3] : fw1[(2 * e + 1) & 3];
                f[2 * e] = __uint_as_float(xv[i][e] << 16) * wa; f[2 * e + 1] = __uint_as_float(xv[i][e] & 0xffff0000u) * wb; }
            *(LAS u32x4*)(xTL + row * 272 + c16 * 16) = xv[i]; *(LAS u32x4*)(xTsL + row * 272 + c16 * 16) = pack8(f); }
        if (hh < 7) { const int seq = bc * 16 + h + 1;
#pragma unroll
            for (int i = 0; i < 2; ++i) { const int q = tid + 512 * i, row = q >> 4, c16 = q & 15; xv[i] = *(const u32x4*)(XT + ((size_t)(bc * 1024 + (h + 1) * 64 + row) * 128 + c16 * 8)); }
            fw0 = *(const f32x4*)(FW + (size_t)seq * 128 + (tid & 15) * 8); fw1 = *(const f32x4*)(FW + (size_t)seq * 128 + (tid & 15) * 8 + 4); }
#pragma unroll
        for (int j = 0; j < 8; ++j) if (j <= (w | 1)) {
#pragma unroll
            for (int i = 0; i < 4; ++i) { const int t = t0 + fq * 4 + i, s = j * 16 + fr; float v = 0.f; if (j <= w && s <= t) v = cbt[j][i] * __expf(fa[t] - fa[s]) * fd[s];
                *(LAS bf16_t*)(ML + t * 272 + s * 2) = f2bf(v); } }
        __syncthreads();
        f32x4 yd[4];
#pragma unroll
        for (int j = 0; j < 4; ++j) yd[j] = (f32x4){0.f, 0.f, 0.f, 0.f};
#pragma unroll
        for (int ks = 0; ks < 4; ++ks) if (ks < nks) { const bf16x8 a = *(LAS bf16x8*)(ML + (t0 + fr) * 272 + (ks * 32 + fq * 8) * 2);
#pragma unroll
            for (int pj = 0; pj < 4; ++pj) { const bf16x8 bb = *(LAS bf16x8*)(xTL + (pj * 16 + fr) * 272 + (ks * 32 + fq * 8) * 2); yd[pj] = mfma16(a, bb, yd[pj]); } }
        { float* YD = (float*)(ws + OFF_YD); const float Dh = p.dvec[h];
#pragma unroll
            for (int pj = 0; pj < 4; ++pj)
#pragma unroll
                for (int i = 0; i < 4; ++i) { const int t = t0 + fq * 4 + i, pc = pj * 16 + fr; const float xx = bf2f(*(LAS bf16_t*)(xTL + pc * 272 + t * 2));
                    YD[(size_t)(R0 + t) * 1024 + h * 64 + pc] = yd[pj][i] + Dh * xx; } }
        f32x4 st[4];
#pragma unroll
        for (int j = 0; j < 4; ++j) st[j] = (f32x4){0.f, 0.f, 0.f, 0.f};
#pragma unroll
        for (int ks = 0; ks < 4; ++ks) { const bf16x8 bb = *(LAS bf16x8*)(BTL + (t0 + fr) * 272 + (ks * 32 + fq * 8) * 2);
#pragma unroll
            for (int pi = 0; pi < 4; ++pi) { const bf16x8 a = *(LAS bf16x8*)(xTsL + (pi * 16 + fr) * 272 + (ks * 32 + fq * 8) * 2); st[pi] = mfma16(a, bb, st[pi]); } }
        { float* S = (float*)(ws + OFF_STATES) + (size_t)(bc * 16 + h) * 8192;
#pragma unroll
            for (int pi = 0; pi < 4; ++pi)
#pragma unroll
                for (int i = 0; i < 4; ++i) S[(pi * 16 + fq * 4 + i) * 128 + t0 + fr] = st[pi][i]; }
    }
    __syncthreads();
}

__device__ __forceinline__ void chunk_mlp(const Params& p, LAS unsigned char* lds, int b, int c, int h, bool dry) {
    const int tid = threadIdx.x, lane = tid & 63, w = __builtin_amdgcn_readfirstlane(tid >> 6), fr = lane & 15, fq = lane >> 4;
    const int R0 = b * 2048 + c * 128, t0 = w * 16;
    unsigned char* ws = p.ws;
    const bf16_t* PROJ = (const bf16_t*)(ws + OFF_PROJ);
    float* ss = (float*)(ws + OFF_SS); const float* vss = ss + 8448; float* yss = (float*)(ws + (dry ? OFF_SS2 : OFF_SS)) + 2 * 8448;
    bf16_t* Y = (bf16_t*)(ws + OFF_XB);
    LAS unsigned char* gvT = lds;
    const int nks = (w >> 1) + 1, trow = t0 + fr;
    f32x4 wq[4][2];
#pragma unroll
    for (int ks = 0; ks < 4; ++ks) if (ks < nks) { const float* wp = p.w_s + (size_t)h * 16384 + trow * 128 + ks * 32 + fq * 8; wq[ks][0] = *(const f32x4*)wp; wq[ks][1] = *(const f32x4*)(wp + 4); }
    float uu[4][8], bias4[4];
#pragma unroll
    for (int i = 0; i < 4; ++i) { const int t = t0 + fq * 4 + i; bias4[i] = p.b_s[h * 128 + t];
#pragma unroll
        for (int dj = 0; dj < 8; ++dj) uu[i][dj] = bf2f(PROJ[(size_t)(R0 + t) * 4608 + h * 128 + dj * 16 + fr]); }
    if (tid < 256) { const int d0 = (tid & 15) * 8, tt0 = (tid >> 4) * 8;
        u32x4 in[8]; float rv[8];
#pragma unroll
        for (int j = 0; j < 8; ++j) { in[j] = *(const u32x4*)(PROJ + (size_t)(R0 + tt0 + j) * 4608 + 1024 + h * 128 + d0); rv[j] = vss[R0 + tt0 + j]; }
        f32x4 gq[2]; gq[0] = *(const f32x4*)(p.g_cv + h * 128 + d0); gq[1] = *(const f32x4*)(p.g_cv + h * 128 + d0 + 4);
#pragma unroll
        for (int j = 0; j < 8; ++j) rv[j] = rsqrtf(rv[j] * (1.0f / 1024.0f) + EPS);
#pragma unroll
        for (int e2 = 0; e2 < 4; ++e2) { const int ea = 2 * e2, eb = 2 * e2 + 1; const float ga = gq[ea >> 2][ea & 3], gb = gq[eb >> 2][eb & 3]; float oa[8], ob[8];
#pragma unroll
            for (int j = 0; j < 8; ++j) { oa[j] = __uint_as_float(in[j][e2] << 16) * rv[j] * ga; ob[j] = __uint_as_float(in[j][e2] & 0xffff0000u) * rv[j] * gb; }
            *(LAS u32x4*)(gvT + (d0 + ea) * 272 + tt0 * 2) = pack8(oa); *(LAS u32x4*)(gvT + (d0 + eb) * 272 + tt0 * 2) = pack8(ob); } }
    __syncthreads();
    f32x4 acc[8];
#pragma unroll
    for (int j = 0; j < 8; ++j) acc[j] = (f32x4){0.f, 0.f, 0.f, 0.f};
#pragma unroll
    for (int ks = 0; ks < 4; ++ks) if (ks < nks) { const int s0 = ks * 32 + fq * 8; float wv[8];
#pragma unroll
        for (int e = 0; e < 4; ++e) { wv[e] = (s0 + e <= trow) ? wq[ks][0][e] : 0.f; wv[4 + e] = (s0 + 4 + e <= trow) ? wq[ks][1][e] : 0.f; }
        const bf16x8 a = __builtin_bit_cast(bf16x8, pack8(wv));
#pragma unroll
        for (int dj = 0; dj < 8; ++dj) { const bf16x8 bb = *(LAS bf16x8*)(gvT + (dj * 16 + fr) * 272 + s0 * 2); acc[dj] = mfma16(a, bb, acc[dj]); } }
#pragma unroll
    for (int i = 0; i < 4; ++i) { const int t = t0 + fq * 4 + i; const float bias = bias4[i]; float ssq = 0.f;
#pragma unroll
        for (int dj = 0; dj < 8; ++dj) { const int d = dj * 16 + fr; const float v = uu[i][dj] * (acc[dj][i] + bias);
            ssq += v * v; Y[(size_t)(R0 + t) * 2048 + h * 128 + d] = f2bf(v); }
        ssq += __shfl_xor(ssq, 1); ssq += __shfl_xor(ssq, 2); ssq += __shfl_xor(ssq, 4); ssq += __shfl_xor(ssq, 8);
        if (fr == 0) unsafeAtomicAdd(yss + (size_t)(R0 + t) * 4, ssq); }
    __syncthreads();
}

__device__ __forceinline__ void sample_item(const Params& p, LAS unsigned char* lds, int b, int g, bool dry) {
    const int tid = threadIdx.x, lane = tid & 63, w = __builtin_amdgcn_readfirstlane(tid >> 6), h = g * 8 + w, row = 8192 + b;
    unsigned char* ws = p.ws;
    const bf16_t* PROJ = (const bf16_t*)(ws + OFF_PROJ);
    const float* DT = (const float*)(ws + OFF_DT);
    float* ss = (float*)(ws + OFF_SS); const float* vss = ss + 8448; float* yss = (float*)(ws + (dry ? OFF_SS2 : OFF_SS)) + 2 * 8448;
    bf16_t* Y = (bf16_t*)(ws + OFF_XB);
    LAS float* wl = (LAS float*)(lds + w * 2048);
    const float* sc = p.sconv + (size_t)b * 3 * 1536; float* ocs = p.out + O_CONVS + (size_t)b * 3 * 1536;
    int chs[5]; chs[0] = h * 64 + lane; chs[1] = 1024 + g * 128 + lane; chs[2] = 1024 + g * 128 + 64 + lane; chs[3] = 1280 + g * 128 + lane; chs[4] = 1280 + g * 128 + 64 + lane;
    float s0[5], s1[5], s2[5], xn[5], cv[5];
#pragma unroll
    for (int k = 0; k < 5; ++k) { const int ch = chs[k]; xn[k] = bf2f(PROJ[(size_t)row * 4608 + 3072 + ch]); s0[k] = sc[ch]; s1[k] = sc[1536 + ch]; s2[k] = sc[3072 + ch];
        cv[k] = p.conv_b[ch] + p.conv_w[ch] * s0[k] + p.conv_w[1536 + ch] * s1[k] + p.conv_w[3072 + ch] * s2[k] + p.conv_w[4608 + ch] * xn[k]; }
#pragma unroll
    for (int k = 0; k < 5; ++k) { cv[k] = silu_f(cv[k]); if (k == 0 || w == 0) { const int ch = chs[k]; ocs[ch] = s1[k]; ocs[1536 + ch] = s2[k]; ocs[3072 + ch] = xn[k]; } }
    const float xv = cv[0], B0 = cv[1], B1 = cv[2], C0 = cv[3], C1 = cv[4];
    const float dt = softplus_f(DT[(size_t)row * 16 + h] + p.dt_bias[h]); const float dA = expf(-expf(p.a_log[h]) * dt);
    wl[lane] = B0; wl[64 + lane] = B1; wl[128 + lane] = C0; wl[192 + lane] = C1; wl[256 + lane] = xv * dt; wl[320 + lane] = xv;
    const int nn = (lane & 31) * 4, ph = lane >> 5;
    const f32x4 B4 = *(LAS f32x4*)(wl + nn), C4 = *(LAS f32x4*)(wl + 128 + nn);
    const float* h0 = p.sssm + (size_t)(b * 16 + h) * 8192; float* hn = p.out + O_SSMS + (size_t)(b * 16 + h) * 8192;
    {
        f32x4 hv[2][8];
#pragma unroll
        for (int k = 0; k < 8; ++k) hv[0][k] = *(const f32x4*)(h0 + (k * 2 + ph) * 128 + nn);
#pragma unroll
        for (int bt = 0; bt < 4; ++bt) {
            if (bt < 3) {
#pragma unroll
                for (int k = 0; k < 8; ++k) hv[(bt + 1) & 1][k] = *(const f32x4*)(h0 + (((bt + 1) * 8 + k) * 2 + ph) * 128 + nn);
            }
#pragma unroll
            for (int k = 0; k < 8; ++k) { const int pp = ((bt * 8 + k) * 2) + ph; const float xd = wl[256 + pp];
                const f32x4 r = hv[bt & 1][k] * dA + B4 * xd; *(f32x4*)(hn + pp * 128 + nn) = r;
                float part = r[0] * C4[0] + r[1] * C4[1] + r[2] * C4[2] + r[3] * C4[3];
                part += __shfl_xor(part, 1); part += __shfl_xor(part, 2); part += __shfl_xor(part, 4); part += __shfl_xor(part, 8); part += __shfl_xor(part, 16);
                if ((lane & 31) == 0) wl[384 + pp] = part; }
        }
    }
    float y = wl[384 + lane] + p.dvec[h] * xv;
    y *= bf2f(PROJ[(size_t)row * 4608 + 2048 + h * 64 + lane]);
    float ssq = y * y;
#pragma unroll
    for (int o = 32; o >= 1; o >>= 1) ssq += __shfl_xor(ssq, o);
    if (lane == 0) unsafeAtomicAdd(yss + (size_t)row * 4 + 1 + g, ssq);
    Y[(size_t)row * 2048 + 1024 + h * 64 + lane] = f2bf(y);
    { const int cidx = g * 512 + tid, hh = cidx >> 7; const float gv = bf2f(PROJ[(size_t)row * 4608 + 1024 + cidx]); const float rs = rsqrtf(vss[row] * (1.0f / 1024.0f) + EPS);
        const float vrow = gv * rs * p.g_cv[cidx]; p.out[O_VS + (size_t)b * 1024 + cidx] = vrow;
        const float mixed = p.w_s[(size_t)hh * 16384] * vrow + p.b_s[hh * 128]; const float ya = bf2f(PROJ[(size_t)row * 4608 + cidx]) * mixed;
        Y[(size_t)row * 2048 + cidx] = f2bf(ya); float s2 = ya * ya;
#pragma unroll
        for (int o = 32; o >= 1; o >>= 1) s2 += __shfl_xor(s2, o);
        if (lane == 0) unsafeAtomicAdd(yss + (size_t)row * 4, s2); }
    __syncthreads();
}

__device__ __forceinline__ void phase_mixer(const Params& p, LAS unsigned char* lds, bool dry) {
#ifndef PROBE_SSD
#define PROBE_SSD 0
#define PROBE_CHUNK 0
#define PROBE_SAMPLE 0
#endif
    const int G = gridDim.x, bx = blockIdx.x, half = G >> 1;
    if (bx < half) {
        for (int it = bx; it < 128; it += half) ssd_group(p, lds, it >> 5, (it >> 1) & 15, it & 1);
        for (int j = bx; j < 128; j += half) chunk_mlp(p, lds, j >> 7, (j >> 3) & 15, j & 7, dry);
    } else {
        const int k = bx - half, nk2 = G - half;
        for (int j = k; j < 256; j += nk2) sample_item(p, lds, j >> 1, j & 1, dry);
        for (int j = 128 + k; j < 512; j += nk2) chunk_mlp(p, lds, j >> 7, (j >> 3) & 15, j & 7, dry);
    }
    if (blockIdx.x < 4) { const int b = blockIdx.x; const bf16_t* PROJ = (const bf16_t*)(p.ws + OFF_PROJ);
        for (int i = threadIdx.x; i < 4608; i += 512) { const int k = i / 1536, ch = i - k * 1536;
            p.out[O_CONVP + (size_t)(b * 3 + k) * 1536 + ch] = bf2f(PROJ[(size_t)(b * 2048 + 2045 + k) * 4608 + 3072 + ch]); } }
}

__device__ __forceinline__ void phase_scan(const Params& p, bool dry) {
    const float* STATES = (const float*)(p.ws + OFF_STATES); const float* EAL = (const float*)(p.ws + OFF_EAL); bf16_t* HPREV = (bf16_t*)(p.ws + OFF_HPREV);
    for (int i = blockIdx.x * 512 + threadIdx.x; i < 131072; i += gridDim.x * 512) {
        const int b = i >> 15, e = (i & 32767) * 4, h = e >> 13;
        f32x4 run = (f32x4){0.f, 0.f, 0.f, 0.f}; f32x4 stv[16]; float ealv[16];
#pragma unroll
        for (int c = 0; c < 16; ++c) { stv[c] = *(const f32x4*)(STATES + (size_t)(b * 16 + c) * 131072 + e); ealv[c] = EAL[(b * 16 + c) * 16 + h]; }
#pragma unroll
        for (int c = 0; c < 16; ++c) { u32x2 o; o.x = cvt_pk_bf16(run[0], run[1]); o.y = cvt_pk_bf16(run[2], run[3]); *(u32x2*)(HPREV + (size_t)(b * 16 + c) * 131072 + e) = o;
            run = run * ealv[c] + stv[c]; }
        *(f32x4*)(p.out + O_SSMP + (size_t)b * 131072 + e) = run;
    }
    if (!dry) {
        const float* yss = (const float*)(p.ws + OFF_SS) + 2 * 8448; bf16_t* Y = (bf16_t*)(p.ws + OFF_XB);
        for (int i = blockIdx.x * 512 + threadIdx.x; i < 128 * 256; i += gridDim.x * 512) { const int row = 8192 + (i >> 8), c8 = (i & 255) * 8, seg = c8 < 1024 ? 0 : (c8 < 1536 ? 1 : 2);
            const float rs = rsqrtf(yss[(size_t)row * 4 + seg] * (seg ? (1.0f / 512.0f) : (1.0f / 1024.0f)) + EPS);
            const u32x4 v = *(const u32x4*)(Y + (size_t)row * 2048 + c8); float f[8];
#pragma unroll
            for (int e = 0; e < 4; ++e) { f[2 * e] = __uint_as_float(v[e] << 16) * rs; f[2 * e + 1] = __uint_as_float(v[e] & 0xffff0000u) * rs; }
            *(u32x4*)(Y + (size_t)row * 2048 + c8) = pack8(f); }
    }
}

__device__ __forceinline__ void phase_combine(const Params& p, LAS unsigned char* lds, bool dry) {
    const int tid = threadIdx.x, lane = tid & 63, w = tid >> 6, fr = lane & 15, fq = lane >> 4;
    unsigned char* ws = p.ws;
    const bf16_t* PROJ = (const bf16_t*)(ws + OFF_PROJ); const bf16_t* CC = (const bf16_t*)(ws + OFF_CC); const bf16_t* HPREV = (const bf16_t*)(ws + OFF_HPREV);
    const float* YD = (const float*)(ws + OFF_YD); const float* EAC = (const float*)(ws + OFF_EAC);
    const float* yss = (const float*)(ws + OFF_SS) + 2 * 8448; bf16_t* Y = (bf16_t*)(ws + OFF_XB);
    LAS float* part = (LAS float*)lds;
    for (int it = blockIdx.x; it < 512; it += gridDim.x) {
        const int b = it >> 7, c = (it >> 3) & 15, g = (it >> 2) & 1, rb = it & 3, h = g * 8 + w, Rb = b * 2048 + c * 128 + rb * 32;
        u32x4 ya[4]; float rsa[4];
#pragma unroll
        for (int k = 0; k < 4; ++k) { const int q = tid + 512 * k, row = Rb + (q >> 6), c8 = (q & 63) * 8;
            ya[k] = *(const u32x4*)(Y + (size_t)row * 2048 + g * 512 + c8); rsa[k] = yss[(size_t)row * 4]; }
        f32x4 acc[2][4];
#pragma unroll
        for (int u = 0; u < 2; ++u)
#pragma unroll
            for (int j = 0; j < 4; ++j) acc[u][j] = (f32x4){0.f, 0.f, 0.f, 0.f};
        const bf16_t* ccp = CC + (size_t)(Rb + fr) * 256 + g * 128 + fq * 8;
        const bf16_t* hp = HPREV + (size_t)((b * 16 + c) * 16 + h) * 8192 + fr * 128 + fq * 8;
#pragma unroll
        for (int ks = 0; ks < 4; ++ks) { const bf16x8 a0 = *(const bf16x8*)(ccp + ks * 32), a1 = *(const bf16x8*)(ccp + 16 * 256 + ks * 32);
#pragma unroll
            for (int pj = 0; pj < 4; ++pj) { const bf16x8 bb = *(const bf16x8*)(hp + pj * 2048 + ks * 32); acc[0][pj] = mfma16(a0, bb, acc[0][pj]); acc[1][pj] = mfma16(a1, bb, acc[1][pj]); } }
        float yv[2][4][4], zv[2][4][4], ea[2][4];
#pragma unroll
        for (int u = 0; u < 2; ++u)
#pragma unroll
            for (int i = 0; i < 4; ++i) { const int r = Rb + u * 16 + fq * 4 + i; ea[u][i] = EAC[(size_t)r * 16 + h];
#pragma unroll
                for (int pj = 0; pj < 4; ++pj) { const int pc = pj * 16 + fr; yv[u][i][pj] = YD[(size_t)r * 1024 + h * 64 + pc]; zv[u][i][pj] = bf2f(PROJ[(size_t)r * 4608 + 2048 + h * 64 + pc]); } }
#pragma unroll
        for (int u = 0; u < 2; ++u)
#pragma unroll
            for (int i = 0; i < 4; ++i) { float ssq = 0.f;
#pragma unroll
                for (int pj = 0; pj < 4; ++pj) { const float y = (yv[u][i][pj] + ea[u][i] * acc[u][pj][i]) * zv[u][i][pj]; yv[u][i][pj] = y; ssq += y * y; }
                ssq += __shfl_xor(ssq, 1); ssq += __shfl_xor(ssq, 2); ssq += __shfl_xor(ssq, 4); ssq += __shfl_xor(ssq, 8);
                if (fr == 0) part[(u * 8 + w) * 16 + fq * 4 + i] = ssq; }
        if (!dry) {
#pragma unroll
            for (int k = 0; k < 4; ++k) { const int q = tid + 512 * k, row = Rb + (q >> 6), c8 = (q & 63) * 8; float f[8]; const float rs = rsqrtf(rsa[k] * (1.0f / 1024.0f) + EPS);
#pragma unroll
                for (int e = 0; e < 4; ++e) { f[2 * e] = __uint_as_float(ya[k][e] << 16) * rs; f[2 * e + 1] = __uint_as_float(ya[k][e] & 0xffff0000u) * rs; }
                *(u32x4*)(Y + (size_t)row * 2048 + g * 512 + c8) = pack8(f); } }
        __syncthreads();
#pragma unroll
        for (int u = 0; u < 2; ++u)
#pragma unroll
            for (int i = 0; i < 4; ++i) { float tot = 0.f;
#pragma unroll
                for (int hh = 0; hh < 8; ++hh) tot += part[(u * 8 + hh) * 16 + fq * 4 + i];
                const float rs = rsqrtf(tot * (1.0f / 512.0f) + EPS); const int r = Rb + u * 16 + fq * 4 + i;
#pragma unroll
                for (int pj = 0; pj < 4; ++pj) Y[(size_t)r * 2048 + 1024 + h * 64 + pj * 16 + fr] = f2bf(yv[u][i][pj] * rs); }
        __syncthreads();
    }
}

__device__ __forceinline__ void phase_ynorm(const Params& p, bool dry) {
    const float* yss = (const float*)(p.ws + OFF_SS) + 2 * 8448; bf16_t* Y = (bf16_t*)(p.ws + OFF_XB); bf16_t* Yd = dry ? (bf16_t*)(p.ws + OFF_ACT) : Y;
    const int total = MROWS * 256, stride = gridDim.x * 512;
    for (int base = blockIdx.x * 512 + threadIdx.x; base < total; base += 4 * stride) {
        u32x4 v[4]; float rs[4];
#pragma unroll
        for (int j = 0; j < 4; ++j) { const int i = min(base + j * stride, total - 1); const int row = i >> 8, c8 = (i & 255) * 8, seg = c8 < 1024 ? 0 : (c8 < 1536 ? 1 : 2);
            v[j] = *(const u32x4*)(Y + (size_t)row * 2048 + c8); rs[j] = rsqrtf(yss[(size_t)row * 4 + seg] * (seg ? (1.0f / 512.0f) : (1.0f / 1024.0f)) + EPS); }
#pragma unroll
        for (int j = 0; j < 4; ++j) { const int i = base + j * stride; if (i < total) { const int row = i >> 8, c8 = (i & 255) * 8; float f[8];
            f[0] = bf2f(v[j].x & 0xffffu); f[1] = bf2f(v[j].x >> 16); f[2] = bf2f(v[j].y & 0xffffu); f[3] = bf2f(v[j].y >> 16); f[4] = bf2f(v[j].z & 0xffffu); f[5] = bf2f(v[j].z >> 16); f[6] = bf2f(v[j].w & 0xffffu); f[7] = bf2f(v[j].w >> 16);
#pragma unroll
            for (int e = 0; e < 8; ++e) f[e] *= rs[j];
            *(u32x4*)(Yd + (size_t)row * 2048 + c8) = pack8(f); } }
    }
}
__device__ __forceinline__ void phase_final(const Params& p, LAS unsigned char* lds, bool dry) {
    float* dst = dry ? (float*)(p.ws + OFF_WTIN) : p.out;
    const int tid = threadIdx.x, lane = tid & 63, wv = tid >> 6, G = gridDim.x;
    f32x4 gf[8];
#pragma unroll
    for (int j = 0; j < 8; ++j) gf[j] = *(const f32x4*)(p.g_fin + j * 256 + lane * 4);
    {
        const bf16_t* hb = (const bf16_t*)(p.ws + OFF_HB);
        const int nw = G * 8; int row = blockIdx.x * 8 + wv;
        u32x2 v[8], vn[8];
        if (row < 8192) {
#pragma unroll
            for (int j = 0; j < 8; ++j) v[j] = *(const u32x2*)(hb + (size_t)row * 2048 + j * 256 + lane * 4); }
        while (row < 8192) {
            const int rn = row + nw;
            if (rn < 8192) {
#pragma unroll
                for (int j = 0; j < 8; ++j) vn[j] = *(const u32x2*)(hb + (size_t)rn * 2048 + j * 256 + lane * 4); }
            float s = 0.f; f32x4 f[8];
#pragma unroll
            for (int j = 0; j < 8; ++j) { f[j][0] = __uint_as_float(v[j].x << 16); f[j][1] = __uint_as_float(v[j].x & 0xffff0000u); f[j][2] = __uint_as_float(v[j].y << 16); f[j][3] = __uint_as_float(v[j].y & 0xffff0000u);
                s += f[j][0] * f[j][0] + f[j][1] * f[j][1] + f[j][2] * f[j][2] + f[j][3] * f[j][3]; }
#pragma unroll
            for (int o = 32; o >= 1; o >>= 1) s += __shfl_xor(s, o);
            const float rs = rsqrtf(s * (1.0f / 2048.0f) + EPS);
#pragma unroll
            for (int j = 0; j < 8; ++j) *(f32x4*)(dst + (size_t)row * 2048 + j * 256 + lane * 4) = f[j] * rs * gf[j];
#pragma unroll
            for (int j = 0; j < 8; ++j) v[j] = vn[j];
            row = rn;
        }
    }
    LAS float* red = (LAS float*)lds;
    for (int i = blockIdx.x; i < 128; i += G) { const float* part = (const float*)(p.ws + OFF_PARTD);
        f32x4 v = *(const f32x4*)(p.out + (size_t)(8192 + i) * 2048 + tid * 4);
#pragma unroll
        for (int sg = 0; sg < 11; ++sg) v += *(const f32x4*)(part + ((size_t)sg * 128 + i) * 2048 + tid * 4);
        float s = v[0] * v[0] + v[1] * v[1] + v[2] * v[2] + v[3] * v[3];
#pragma unroll
        for (int o = 32; o >= 1; o >>= 1) s += __shfl_xor(s, o);
        if (lane == 0) red[wv] = s;
        __syncthreads();
        float tot = 0.f;
#pragma unroll
        for (int k = 0; k < 8; ++k) tot += red[k];
        const float rs = rsqrtf(tot * (1.0f / 2048.0f) + EPS);
        const f32x4 g4 = *(const f32x4*)(p.g_fin + tid * 4);
        *(f32x4*)(dst + (size_t)(8192 + i) * 2048 + tid * 4) = v * rs * g4;
        __syncthreads();
    }
}

__device__ __forceinline__ void phase_hfix(const Params& p, bool dry, int blk) {
    const int lane = threadIdx.x & 63, wv = threadIdx.x >> 6, i = blk * 8 + wv;
    if (i < 128) { const int row = 8192 + i; bf16_t* hb = (bf16_t*)(p.ws + OFF_HB); float* hss = (float*)(p.ws + (dry ? OFF_SS2 : OFF_SS)) + 6 * 8448; const float* part = (const float*)(p.ws + OFF_PARTO); float s = 0.f;
        f32x4 hv[8];
#pragma unroll
        for (int j = 0; j < 8; ++j) { hv[j] = *(const f32x4*)(p.xs + (size_t)i * 2048 + j * 256 + lane * 4);
#pragma unroll
            for (int sg = 0; sg < 8; ++sg) hv[j] += *(const f32x4*)(part + ((size_t)sg * 128 + i) * 2048 + j * 256 + lane * 4); }
#pragma unroll
        for (int j = 0; j < 8; ++j) { const f32x4 v = hv[j]; s += v[0] * v[0] + v[1] * v[1] + v[2] * v[2] + v[3] * v[3];
            *(f32x4*)(p.out + (size_t)row * 2048 + j * 256 + lane * 4) = v;
            u32x2 o; o.x = cvt_pk_bf16(v[0], v[1]); o.y = cvt_pk_bf16(v[2], v[3]); *(u32x2*)(hb + (size_t)row * 2048 + j * 256 + lane * 4) = o; }
#pragma unroll
        for (int o = 32; o >= 1; o >>= 1) s += __shfl_xor(s, o);
        if (lane == 0) hss[row] = s; }
}

#define XB_TMO      128
#define XB_XCNT(j)  (256  + 64 * (j))
#define XB_XSUB(j)  (1280 + 64 * (j))
#define XB_XGEN(j)  (2304 + 64 * (j))
#define XB_TOP      3328
#define XB_TOPGEN   3392
#define XCD_BAR_WORDS 3456
#define XB_SPIN_CAP (1u << 18)

__device__ __forceinline__ unsigned xb_ld(unsigned* p)              { return __hip_atomic_load(p, __ATOMIC_RELAXED, __HIP_MEMORY_SCOPE_AGENT); }
__device__ __forceinline__ unsigned xb_add(unsigned* p, unsigned v) { return __hip_atomic_fetch_add(p, v, __ATOMIC_RELAXED, __HIP_MEMORY_SCOPE_AGENT); }
__device__ __forceinline__ unsigned xb_xcc_id() { return (unsigned)__builtin_amdgcn_s_getreg((3 << 11) | 20) & 0xFu; }
#define XB_SPIN(cond, bar) do { unsigned _sp = 0; while (cond) { __builtin_amdgcn_s_sleep(1); \
    if ((++_sp & 255u) == 0u) { if (xb_ld(&(bar)[XB_TMO])) break; if (_sp > XB_SPIN_CAP) { atomicAdd(&(bar)[XB_TMO], 1u); break; } } } } while (0)

struct XcdBarrier {
    unsigned* bar; unsigned x;
    volatile __attribute__((address_space(3))) unsigned* st;
};

__device__ __forceinline__ XcdBarrier xcd_barrier_post(unsigned* bar, volatile __attribute__((address_space(3))) unsigned* st) {
    XcdBarrier b; b.bar = bar; b.x = xb_xcc_id(); b.st = st;
    if (threadIdx.x == 0) (void)xb_add(&bar[XB_XCNT(b.x)], 1u);
    return b;
}
__device__ __forceinline__ void xcd_barrier_complete(unsigned* bar, unsigned x, unsigned& nloc, unsigned& nx) {
    const unsigned G = gridDim.x * gridDim.y * gridDim.z;
    unsigned sum, cnt, mine, sp = 0u;
    for (;;) {
        sum = 0u; cnt = 0u; mine = 0u;
#pragma unroll
        for (unsigned j = 0; j < 16; ++j) { const unsigned c = xb_ld(&bar[XB_XCNT(j)]); sum += c; cnt += (c > 0u) ? 1u : 0u; mine = (j == x) ? c : mine; }
        if (sum == G) break;
        __builtin_amdgcn_s_sleep(1);
        if ((++sp & 255u) == 0u) { if (xb_ld(&bar[XB_TMO])) break; if (sp > XB_SPIN_CAP) { atomicAdd(&bar[XB_TMO], 1u); break; } }
    }
    nloc = mine > 0u ? mine : 1u; nx = cnt > 0u ? cnt : 1u;
}

__device__ __forceinline__ void xcd_barrier(const XcdBarrier& b) {
    asm volatile("s_waitcnt vmcnt(0)" ::: "memory");
    __syncthreads();
    if (threadIdx.x == 0) {
        unsigned* bar = b.bar;
        __builtin_amdgcn_s_waitcnt(0);
        unsigned nloc = b.st[0], nx = b.st[1];
        if (nloc == 0u) { xcd_barrier_complete(bar, b.x, nloc, nx); b.st[0] = nloc; b.st[1] = nx; }
        const unsigned old = xb_add(&bar[XB_XSUB(b.x)], 1u);
        const unsigned gen = old / nloc;
        if (old + 1u == (gen + 1u) * nloc) {
            __builtin_amdgcn_fence(__ATOMIC_RELEASE, "agent");
            asm volatile("s_waitcnt vmcnt(0)" ::: "memory");
            const unsigned og = xb_add(&bar[XB_TOP], 1u);
            const unsigned tg = og / nx;
            if (og + 1u == (tg + 1u) * nx) xb_add(&bar[XB_TOPGEN], 1u);
            else XB_SPIN(xb_ld(&bar[XB_TOPGEN]) == tg, bar);
            __builtin_amdgcn_fence(__ATOMIC_ACQUIRE, "agent");
            xb_add(&bar[XB_XGEN(b.x)], 1u);
            asm volatile("s_waitcnt vmcnt(0)" ::: "memory");
        } else {
            XB_SPIN(xb_ld(&bar[XB_XGEN(b.x)]) == gen, bar);
            __builtin_amdgcn_fence(__ATOMIC_ACQUIRE, "agent");
            asm volatile("s_waitcnt vmcnt(0)" ::: "memory");
        }
    }
    __syncthreads();
}

__global__ void __launch_bounds__(512, 2) mega(Params p) {
    extern __shared__ __attribute__((aligned(16))) unsigned char lds_raw[];
    LAS unsigned char* lds = (LAS unsigned char*)lds_raw;
    unsigned char* ws = p.ws; float* ss = (float*)(ws + OFF_SS);
    volatile LAS unsigned* bst = (volatile LAS unsigned*)(lds + LDS_BAR_OFF);
    if (threadIdx.x < 4) bst[threadIdx.x] = 0u;
    __syncthreads();
    if (p.ph_hi > 1000) cg::this_grid().sync();
    const XcdBarrier bar = xcd_barrier_post((unsigned*)(ws + OFF_CTL), bst);
#ifndef PHMASK
#define PHMASK 0x3ff
#endif
#define PH_ON(k) ((PHMASK >> (k)) & 1) && p.ph_lo <= (k) && (k) < p.ph_hi
#define PH_SYNC(k) if (p.ph_lo <= (k) && (k) + 1 < p.ph_hi) xcd_barrier(bar);
#ifdef REPMASK
#define REPLOOP(k) for (int rep = ((REPMASK >> (k)) & 1) ? ((p.repmask >> (k)) & 1) : 0; rep >= 0; --rep)
#else
#define REPLOOP(k) for (int rep = 0; rep >= 0; --rep)
#endif
#define REPBAR if (rep) xcd_barrier(bar);
    if (PH_ON(0)) REPLOOP(0) { phase_prep(p, lds); REPBAR }
    PH_SYNC(0)
    if (PH_ON(1)) REPLOOP(1) { pg8::Gemm g; g.A = (const bf16_t*)(ws + OFF_XB); g.Bt = (const bf16_t*)(ws + OFF_WTIN); g.M = MPAD; g.N = 4864; g.K = 2048; g.ld = 2048;
        pg8::StaticOrder S; S.init(MPAD, 4864, (int)gridDim.x, (int)blockIdx.x, 2048);
        EpiProj E; E.proj = (bf16_t*)(ws + OFF_PROJ); E.dt = (float*)(ws + OFF_DT); E.xss = ss; E.vss = (float*)(ws + (rep ? OFF_SS2 : OFF_SS)) + 8448;
        pg8::gemm_phase<EpiProj, pg8::StaticOrder, false>(lds, g, S, E, nullptr);
        if (!rep && blockIdx.x >= 115) wt_convert(p, lds, 1184, 4512, (int)blockIdx.x - 115, (int)gridDim.x - 115);
        REPBAR }
    PH_SYNC(1)
    if (PH_ON(2)) REPLOOP(2) { phase_conv(p, lds); xcd_barrier(bar); phase_mixer(p, lds, rep != 0); REPBAR }
    PH_SYNC(2)
    if (PH_ON(3)) REPLOOP(3) { phase_scan(p, rep != 0); REPBAR }
    PH_SYNC(3)
    if (PH_ON(4)) REPLOOP(4) { phase_combine(p, lds, rep != 0); REPBAR }
    PH_SYNC(4)
    if (PH_ON(6)) REPLOOP(6) { pg8::Gemm g; g.A = (const bf16_t*)(ws + OFF_XB); g.Bt = (const bf16_t*)(ws + OFF_WTOUT); g.M = MPAD; g.N = 2048; g.K = 2048; g.ld = 2048;
        OutOrder S; S.c = (int)blockIdx.x;
        EpiOut E; E.xp = p.xp; E.xs = p.xs; E.hout = p.out; E.hb = (bf16_t*)(ws + OFF_HB); E.part = (float*)(ws + OFF_PARTO); E.hss = (float*)(ws + (rep ? OFF_SS2 : OFF_SS)) + 6 * 8448;
        pg8::gemm_phase<EpiOut, OutOrder, false>(lds, g, S, E, nullptr); REPBAR }
    PH_SYNC(6)
    if (PH_ON(7)) REPLOOP(7) { pg8::Gemm g; g.A = (const bf16_t*)(ws + OFF_HB); g.Bt = (const bf16_t*)(ws + OFF_WTGU); g.M = MPAD; g.N = 11264; g.K = 2048; g.ld = 2048;
        unsigned* hflag = (unsigned*)(ws + OFF_CTL + 15360);
        if ((int)blockIdx.x >= (int)gridDim.x - 16) { phase_hfix(p, false, (int)blockIdx.x - ((int)gridDim.x - 16)); __threadfence();
        __syncthreads(); if (threadIdx.x == 0) __hip_atomic_fetch_add(hflag, 1u, __ATOMIC_RELAXED, __HIP_MEMORY_SCOPE_AGENT); }
        GuDepOrder S; S.init(MPAD, 11264, (int)gridDim.x, (int)blockIdx.x, 2048); S.flag = hflag;
        EpiGU E; E.act = (bf16_t*)(ws + OFF_ACT); E.hss = ss + 6 * 8448;
        pg8::gemm_phase<EpiGU, GuDepOrder, false>(lds, g, S, E, nullptr);
        if (!rep && blockIdx.x >= 172) wt_convert(p, lds, 4512, 5920, (int)blockIdx.x - 172, (int)gridDim.x - 172);
        REPBAR }
    PH_SYNC(7)
    if (PH_ON(8)) REPLOOP(8) { pg8::Gemm g; g.A = (const bf16_t*)(ws + OFF_ACT); g.Bt = (const bf16_t*)(ws + OFF_WTDN); g.M = MPAD; g.N = 2048; g.K = 5632; g.ld = LD_DN;
        DownOrder S; S.c = (int)blockIdx.x;
        EpiDown E; E.hb = (bf16_t*)(ws + OFF_HB); E.hdst = rep ? (float*)(ws + OFF_WTIN) : p.out; E.part = (float*)(ws + OFF_PARTD);
        pg8::gemm_phase<EpiDown, DownOrder, false>(lds, g, S, E, nullptr); REPBAR }
    PH_SYNC(8)
    if (PH_ON(9)) REPLOOP(9) { phase_final(p, lds, rep != 0); REPBAR }
}

#ifndef N_LAUNCHES
#define N_LAUNCHES 1
#endif
extern "C" void kernel_launch(void* const* d_in, const int* in_sizes, int n_in, void* d_out, int out_size, void* d_ws, size_t ws_size, hipStream_t stream) {
    static int grid = 0;
    if (grid == 0) {
        if (n_in != 22 || ws_size < WS_NEED) { fprintf(stderr, "kernel_launch: bad inputs n_in %d ws %zu need %zu\n", n_in, ws_size, (size_t)WS_NEED); grid = -1; return; }
        int dev = 0, cus = 0, per_cu = 0;
        (void)hipGetDevice(&dev); (void)hipDeviceGetAttribute(&cus, hipDeviceAttributeMultiprocessorCount, dev);
        if (hipFuncSetAttribute((const void*)mega, hipFuncAttributeMaxDynamicSharedMemorySize, LDS_BYTES) != hipSuccess) { fprintf(stderr, "kernel_launch: hipFuncSetAttribute failed\n"); grid = -1; return; }
        if (hipOccupancyMaxActiveBlocksPerMultiprocessor(&per_cu, (const void*)mega, 512, LDS_BYTES) != hipSuccess || per_cu < 1) { fprintf(stderr, "kernel_launch: occupancy query says %d\n", per_cu); per_cu = 1; }
        (void)hipGetLastError();
        grid = cus > 0 ? cus : 256;
    }
    if (grid < 0) return;
    if (hipMemsetAsync((char*)d_ws + OFF_CTL, 0, 16384, stream) != hipSuccess) { fprintf(stderr, "kernel_launch: memset failed\n"); return; }
    Params p{};
    const float** pin = (const float**)&p;
    for (int i = 0; i < 22; ++i) pin[i] = (const float*)d_in[i];
    p.out = (float*)d_out; p.ws = (unsigned char*)d_ws;
#ifdef REPMASK
    p.repmask = REPMASK;
#endif
#if N_LAUNCHES == 1
    p.ph_lo = 0; p.ph_hi = NPHASE;
    void* args[] = {&p};
    hipError_t e = hipLaunchCooperativeKernel((const void*)mega, dim3(grid), dim3(512), args, LDS_BYTES, stream);
    if (e != hipSuccess) fprintf(stderr, "cooperative launch failed: %s (grid %d)\n", hipGetErrorString(e), grid);
#else
    for (int ph = 0; ph < NPHASE; ++ph) { p.ph_lo = ph; p.ph_hi = ph + 1; hipLaunchKernelGGL(mega, dim3(grid), dim3(512), LDS_BYTES, stream, p); }
#endif
}
```

```cpp
#include <hip/hip_runtime.h>
#include <hip/hip_cooperative_groups.h>
#include <cstdio>
namespace cg = cooperative_groups;
namespace pg8 {
#define PG8_LAS __attribute__((address_space(3)))
typedef unsigned short bf16_t;
typedef short bf16x8 __attribute__((ext_vector_type(8)));
typedef float f32x4 __attribute__((ext_vector_type(4)));
typedef unsigned u32x4 __attribute__((ext_vector_type(4)));
constexpr int BM = 256, BK = 64, HALF = 128, HTB = HALF * BK * 2  , STAGE_BYTES = 8 * HTB, NXCD = 8, WGM = 8;

__host__ __device__ __forceinline__ int lds_byte(int r, int c) { const int st = (r >> 4) * 2 + (c >> 5), rr = r & 15, cc = c & 31, ob = rr * 64 + cc * 2; return st * 1024 + (ob ^ (((ob >> 9) & 1) << 5)); }
__host__ __device__ __forceinline__ void stage_rc(int b, int& R, int& C) { const int st = b / 1024, sb = b % 1024, swz = sb ^ (((sb >> 9) & 1) << 5); R = (st >> 1) * 16 + swz / 64; C = (st & 1) * 32 + (swz % 64) / 2; }
__host__ __device__ __forceinline__ int perm32(int rho) { const int n = rho >> 4, i = rho & 15; return 8 * (i >> 2) + 4 * n + (i & 3); }

struct Unit { int pm, pn, k0, nk; };
struct Gemm { const bf16_t* A; const bf16_t* Bt; int M, N, K, ld; };

struct StaticOrder {
    int nM, nN, nwg, G, c, ntk;
    __host__ __device__ void init(int M, int N, int G_, int c_, int K_) { nM = M / BM; nN = N / BM; nwg = nM * nN; G = G_; c = c_; ntk = K_ / BK; }
    __host__ __device__ bool next(int i, Unit& u) const {
        const long L = (long)i * G + c; if (L >= nwg) return false;
        int wgid = (int)L; { const int q = nwg / NXCD, r = nwg % NXCD, xcd = wgid % NXCD, off = wgid / NXCD; wgid = (xcd < r ? xcd * (q + 1) : r * (q + 1) + (xcd - r) * q) + off; }
        const int nig = WGM * nN, gid = wgid / nig, fm = gid * WGM, gsz = (nM - fm) < WGM ? (nM - fm) : WGM;
        u.pm = fm + ((wgid % nig) % gsz); u.pn = (wgid % nig) / gsz; u.k0 = 0; u.nk = ntk; return true;
    }
    __device__ __forceinline__ void a_ready(const Unit&) const {}
    __device__ __forceinline__ void done(const Unit&) const {}
};
__device__ __forceinline__ unsigned cvt_pk_bf16(float lo, float hi) { unsigned r; asm volatile("v_cvt_pk_bf16_f32 %0, %1, %2" : "=v"(r) : "v"(lo), "v"(hi)); return r; }

template <class Epi, class Sched, bool STAMP = false>
__device__ __forceinline__ void gemm_phase(PG8_LAS unsigned char* lds, const Gemm g, const Sched& S, const Epi& E, unsigned long long* stamps) {
    int tid_ = threadIdx.x; asm volatile("" : "+v"(tid_));
    const int tid = tid_, wid = __builtin_amdgcn_readfirstlane(tid >> 6), lane = tid & 63, wr = wid >> 2, wc = wid & 3, fr = lane & 15, fq = lane >> 4;
    const int K = g.ld;
    int ts_lo = 0, ts_hi = 0, nts = 0; const unsigned long long rt_entry = STAMP ? (unsigned long long)wall_clock64() : 0ull;
#define PG8_STAMP() do { if (STAMP && wid == 0 && nts < 64) { const unsigned long long _c = (unsigned long long)clock64(); \
        ts_lo = (lane == nts) ? (int)(unsigned)_c : ts_lo; ts_hi = (lane == nts) ? (int)(unsigned)(_c >> 32) : ts_hi; ++nts; } } while (0)
    PG8_STAMP();
    unsigned voffA[2], voffB[2];
#pragma unroll
    for (int i = 0; i < 2; ++i) { int R, C; stage_rc(tid * 16 + i * 8192, R, C); const int Rb = Epi::PERM ? ((R & ~31) + perm32(R & 31)) : R;
        voffA[i] = (unsigned)(R * K + C) * 2u; voffB[i] = (unsigned)(Rb * K + C) * 2u; }
    const size_t kstep = (size_t)(BK * 2);
    const size_t hstep = (size_t)HALF * K * 2;
    const size_t tstep = 2 * hstep;
    const unsigned ldsw = (unsigned)wid * 1024u;
    const int aoff = lds_byte(wr * 64 + fr, fq * 8), boff = lds_byte(wc * 32 + fr, fq * 8);
#define PG8_SA(b, h) (((b) * 2 + (h)) * HTB)
#define PG8_SB(b, h) ((4 + (b) * 2 + (h)) * HTB)
#define PG8_STAGE(bufoff, gbase, voff) do { _Pragma("unroll") for (int _i = 0; _i < 2; ++_i) \
        __builtin_amdgcn_global_load_lds((const unsigned*)((const char*)(gbase) + (voff)[_i]), (PG8_LAS unsigned*)(lds + (bufoff) + ldsw + _i * 8192), 16, 0, 0); } while (0)
#define PG8_LDA(dst, b, h) do { _Pragma("unroll") for (int m = 0; m < 4; ++m) _Pragma("unroll") for (int k = 0; k < 2; ++k) dst[m][k] = *(const PG8_LAS bf16x8*)(lds + PG8_SA(b, h) + aoff + m * 2048 + k * 1024); } while (0)
#define PG8_LDB(dst, b, h) do { _Pragma("unroll") for (int n = 0; n < 2; ++n) _Pragma("unroll") for (int k = 0; k < 2; ++k) dst[n][k] = *(const PG8_LAS bf16x8*)(lds + PG8_SB(b, h) + boff + n * 2048 + k * 1024); } while (0)
#define PG8_MMA(ai, bj, At, Bt) do { __builtin_amdgcn_s_setprio(1); _Pragma("unroll") for (int m = 0; m < 4; ++m) _Pragma("unroll") for (int n = 0; n < 2; ++n) _Pragma("unroll") for (int k = 0; k < 2; ++k) \
        acc[ai][bj][m][n] = __builtin_amdgcn_mfma_f32_16x16x32_bf16(Bt[n][k], At[m][k], acc[ai][bj][m][n], 0, 0, 0); __builtin_amdgcn_s_setprio(0); } while (0)
#define PG8_WAIT_V(n) asm volatile("s_waitcnt vmcnt(" #n ")" ::: "memory")
#define PG8_WAIT_L(n) asm volatile("s_waitcnt lgkmcnt(" #n ")" ::: "memory")
#define PG8_BAR __builtin_amdgcn_s_barrier()
#define PG8_SCHED __builtin_amdgcn_sched_barrier(0)
    Unit cur, nxt; int ui = 0;
    if (!S.next(0, cur)) return;
    f32x4 acc[2][2][4][2];
#pragma unroll
    for (int a = 0; a < 2; ++a)
#pragma unroll
        for (int b = 0; b < 2; ++b)
#pragma unroll
            for (int m = 0; m < 4; ++m)
#pragma unroll
                for (int n = 0; n < 2; ++n) acc[a][b][m][n] = (f32x4){0.f, 0.f, 0.f, 0.f};
    bf16x8 At[4][2], B0[2][2], B1[2][2];
    const char* cA = (const char*)g.A + (size_t)cur.pm * tstep + (size_t)cur.k0 * kstep; const char* cB = (const char*)g.Bt + (size_t)cur.pn * tstep + (size_t)cur.k0 * kstep;
    S.a_ready(cur);
    float pre8[8]; E.prefetch(cur, wr, fr, pre8);
    PG8_STAGE(PG8_SB(0, 0), cB, voffB); PG8_STAGE(PG8_SA(0, 0), cA, voffA); PG8_STAGE(PG8_SB(0, 1), cB + hstep, voffB); PG8_STAGE(PG8_SA(0, 1), cA + hstep, voffA);
    if (wr == 1) PG8_BAR;
    PG8_WAIT_V(4); PG8_BAR;
    PG8_STAGE(PG8_SB(1, 0), cB + kstep, voffB); PG8_STAGE(PG8_SA(1, 0), cA + kstep, voffA); PG8_STAGE(PG8_SB(1, 1), cB + hstep + kstep, voffB);
    PG8_WAIT_V(6); PG8_BAR;
    PG8_STAMP();
    for (;;) {
        const bool has_next = S.next(ui + 1, nxt);
        const char* nA = has_next ? (const char*)g.A + (size_t)nxt.pm * tstep + (size_t)nxt.k0 * kstep : cA; const char* nB = has_next ? (const char*)g.Bt + (size_t)nxt.pn * tstep + (size_t)nxt.k0 * kstep : cB;
        const int nt = cur.nk;
        for (int t = 0; t < nt; t += 2) {
            const bool last = (t == nt - 2);
            const char* a1 = cA + (size_t)(t + 1) * kstep;
            const char* a2 = last ? nA : cA + (size_t)(t + 2) * kstep; const char* b2 = last ? nB : cB + (size_t)(t + 2) * kstep;
            const char* a3 = a2 + kstep; const char* b3 = b2 + kstep;
            if (last && has_next) S.a_ready(nxt);
            PG8_LDB(B0, 0, 0); PG8_SCHED; PG8_LDA(At, 0, 0); PG8_STAGE(PG8_SA(1, 1), a1 + hstep, voffA);
            PG8_WAIT_L(8); PG8_BAR; PG8_WAIT_L(0); PG8_MMA(0, 0, At, B0); PG8_BAR; PG8_SCHED;
            PG8_LDB(B1, 0, 1); PG8_STAGE(PG8_SB(0, 0), b2, voffB);
            PG8_BAR; PG8_WAIT_L(0); PG8_MMA(0, 1, At, B1); PG8_BAR;
            PG8_LDA(At, 0, 1); PG8_STAGE(PG8_SA(0, 0), a2, voffA);
            PG8_BAR; PG8_WAIT_L(0); PG8_MMA(1, 0, At, B0); PG8_BAR; PG8_SCHED;
            PG8_STAGE(PG8_SB(0, 1), b2 + hstep, voffB);
            PG8_WAIT_V(6); PG8_BAR; PG8_MMA(1, 1, At, B1); PG8_BAR;
            PG8_LDB(B0, 1, 0); PG8_SCHED; PG8_LDA(At, 1, 0); PG8_STAGE(PG8_SA(0, 1), a2 + hstep, voffA);
            PG8_WAIT_L(8); PG8_BAR; PG8_WAIT_L(0); PG8_MMA(0, 0, At, B0); PG8_BAR; PG8_SCHED;
            PG8_LDB(B1, 1, 1); PG8_STAGE(PG8_SB(1, 0), b3, voffB);
            PG8_BAR; PG8_WAIT_L(0); PG8_MMA(0, 1, At, B1); PG8_BAR;
            PG8_LDA(At, 1, 1); PG8_STAGE(PG8_SA(1, 0), a3, voffA);
            PG8_BAR; PG8_WAIT_L(0); PG8_MMA(1, 0, At, B0); PG8_BAR; PG8_SCHED;
            PG8_STAGE(PG8_SB(1, 1), b3 + hstep, voffB);
            PG8_WAIT_V(6); PG8_BAR; PG8_MMA(1, 1, At, B1); PG8_BAR;
        }
        PG8_STAMP();
        if constexpr (!Epi::AFTER_DRAIN) { E(acc, cur, wr, wc, fr, fq, pre8); S.done(cur); }
        PG8_STAMP();
        if (!has_next) break;
#pragma unroll
        for (int a = 0; a < 2; ++a)
#pragma unroll
            for (int b = 0; b < 2; ++b)
#pragma unroll
                for (int m = 0; m < 4; ++m)
#pragma unroll
                    for (int n = 0; n < 2; ++n) acc[a][b][m][n] = (f32x4){0.f, 0.f, 0.f, 0.f};
        cur = nxt; cA = nA; cB = nB; ++ui; E.prefetch(cur, wr, fr, pre8);
    }
    PG8_WAIT_V(0);
    if (wr == 0) PG8_BAR;
    PG8_BAR;
    if constexpr (Epi::AFTER_DRAIN) { E.fused(acc, cur, wr, wc, fr, fq, lds, wid, lane); S.done(cur); }
    PG8_STAMP();
    if (STAMP && wid == 0) { stamps[lane] = lane < nts ? (((unsigned long long)(unsigned)ts_hi << 32) | (unsigned)ts_lo) : 0ull;
        if (lane == 62) stamps[62] = rt_entry; if (lane == 63) stamps[63] = (unsigned long long)wall_clock64(); }
#undef PG8_STAMP
#undef PG8_SA
#undef PG8_SB
#undef PG8_STAGE
#undef PG8_LDA
#undef PG8_LDB
#undef PG8_MMA
#undef PG8_WAIT_V
#undef PG8_WAIT_L
#undef PG8_BAR
#undef PG8_SCHED
}
}

#define LAS __attribute__((address_space(3)))
using pg8::bf16_t; using pg8::bf16x8; using pg8::f32x4; using pg8::u32x4; using pg8::cvt_pk_bf16;
typedef unsigned u32x2 __attribute__((ext_vector_type(2)));

constexpr float EPS = 1e-6f;
constexpr int MROWS = 8320, MPAD = 8448;
constexpr int LDS_BAR_OFF = 157696;
constexpr int LDS_BYTES = LDS_BAR_OFF + 256;
constexpr int NPHASE = 10;
constexpr int LD_DN = 5632 + 64;

constexpr size_t OFF_WTIN = 0;
constexpr size_t OFF_WTOUT = OFF_WTIN + 4864ull * 2048 * 2;
constexpr size_t OFF_WTGU = OFF_WTOUT + 2048ull * 2048 * 2;
constexpr size_t OFF_WTDN = OFF_WTGU + 11264ull * 2048 * 2;
constexpr size_t OFF_SS = OFF_WTDN + 2048ull * LD_DN * 2;
constexpr size_t OFF_CTL = OFF_SS + 8448ull * 8 * 4;
constexpr size_t OFF_EAL = OFF_CTL + 16384;
constexpr size_t OFF_XB = OFF_EAL + 4096;
constexpr size_t OFF_C = OFF_XB + 8448ull * 2048 * 2;
constexpr size_t OFF_PROJ = OFF_C;
constexpr size_t OFF_DT = OFF_PROJ + 8448ull * 4608 * 2;
constexpr size_t OFF_STATES = OFF_DT + 8448ull * 16 * 4;
constexpr size_t OFF_HPREV = OFF_STATES + 64ull * 16 * 8192 * 4;
constexpr size_t OFF_YD = OFF_HPREV + 64ull * 16 * 8192 * 2;
constexpr size_t OFF_CC = OFF_YD + 8192ull * 1024 * 4;
constexpr size_t OFF_EAC = OFF_CC + 8192ull * 256 * 2;
constexpr size_t OFF_BN = OFF_EAC + 8192ull * 16 * 4;
constexpr size_t OFF_BTT = OFF_BN + 8192ull * 256 * 2;
constexpr size_t OFF_FA = OFF_BTT + 64ull * 256 * 128 * 2;
constexpr size_t OFF_FD = OFF_FA + 1024ull * 128 * 4;
constexpr size_t OFF_FW = OFF_FD + 1024ull * 128 * 4;
constexpr size_t END_C1 = OFF_FW + 1024ull * 128 * 4;
constexpr size_t OFF_XT = OFF_HPREV;
constexpr size_t OFF_HB = OFF_C;
constexpr size_t OFF_ACT = OFF_HB + 8448ull * 2048 * 2;
constexpr size_t END_C2 = OFF_ACT + 8448ull * LD_DN * 2;
constexpr size_t OFF_PARTO = OFF_ACT;
constexpr size_t OFF_PARTD = OFF_WTIN;
constexpr size_t OFF_SS2 = END_C1 > END_C2 ? END_C1 : END_C2;
constexpr size_t WS_NEED = OFF_SS2 + 8448ull * 8 * 4;

constexpr size_t O_Y = 0, O_CONVP = 17039360, O_SSMP = 17057792, O_CONVS = 17582080, O_SSMS = 18171904, O_VS = 34949120;

struct Params {
    const float* xp; const float* xs; const float* sconv; const float* sssm; const float* g_mix; const float* w_in; const float* g_cv; const float* w_s; const float* b_s;
    const float* g_co; const float* conv_w; const float* conv_b; const float* dt_bias; const float* a_log; const float* dvec; const float* g_sn; const float* w_out;
    const float* g_ffn; const float* w_gate; const float* w_up; const float* w_down; const float* g_fin;
    float* out; unsigned char* ws; int ph_lo, ph_hi; int repmask, pad;
};

__device__ __forceinline__ float bf2f(unsigned v) { return __uint_as_float(v << 16); }
__device__ __forceinline__ bf16_t f2bf(float x) { return (bf16_t)(cvt_pk_bf16(x, x) & 0xffffu); }
__device__ __forceinline__ float sigmoid_f(float x) { return __builtin_amdgcn_rcpf(1.0f + __expf(-x)); }
__device__ __forceinline__ float silu_f(float x) { return x * sigmoid_f(x); }
__device__ __forceinline__ float gelu_f(float x) { return x * sigmoid_f(1.5957691216f * (x + 0.044715f * x * x * x)); }
__device__ __forceinline__ float softplus_f(float x) { return x > 20.f ? x : log1pf(expf(x)); }
__device__ __forceinline__ f32x4 mfma16(bf16x8 a, bf16x8 b, f32x4 c) { return __builtin_amdgcn_mfma_f32_16x16x32_bf16(a, b, c, 0, 0, 0); }
__device__ __forceinline__ u32x4 pack8(const float* v) { u32x4 o; o.x = cvt_pk_bf16(v[0], v[1]); o.y = cvt_pk_bf16(v[2], v[3]); o.z = cvt_pk_bf16(v[4], v[5]); o.w = cvt_pk_bf16(v[6], v[7]); return o; }

struct EpiProj {
    static constexpr bool PERM = true, AFTER_DRAIN = false;
    bf16_t* proj; float* dt; const float* xss; float* vss;
    __device__ __forceinline__ void prefetch(const pg8::Unit& u, int wr, int fr, float (&pre)[8]) const {
#pragma unroll
        for (int q = 0; q < 8; ++q) pre[q] = xss[u.pm * 256 + wr * 64 + fr + (q >> 2) * 128 + (q & 3) * 16]; }
    __device__ __forceinline__ void operator()(const f32x4 (&acc)[2][2][4][2], const pg8::Unit& u, int wr, int wc, int fr, int fq, const float (&pre)[8]) const {
        const int row0 = u.pm * 256 + wr * 64 + fr, pn = u.pn;
        float rs8[2][4];
#pragma unroll
        for (int ai = 0; ai < 2; ++ai)
#pragma unroll
            for (int m = 0; m < 4; ++m) rs8[ai][m] = rsqrtf(pre[ai * 4 + m] * (1.0f / 2048.0f) + EPS);
        if (pn == 18) {
            if (wc == 0 && fq < 2) {
#pragma unroll
                for (int ai = 0; ai < 2; ++ai)
#pragma unroll
                    for (int m = 0; m < 4; ++m) { const int row = row0 + ai * 128 + m * 16; const float rs = rs8[ai][m];
                        float* d = dt + (size_t)row * 16 + fq * 8; *(f32x4*)d = acc[ai][0][m][0] * rs; *(f32x4*)(d + 4) = acc[ai][0][m][1] * rs; }
            }
            return;
        }
        const int kind = pn < 4 ? 0 : pn < 8 ? 1 : pn < 12 ? 2 : 3;
        const int col0 = pn * 256 + wc * 32 + 8 * fq;
#pragma unroll
        for (int ai = 0; ai < 2; ++ai)
#pragma unroll
            for (int m = 0; m < 4; ++m) { const int row = row0 + ai * 128 + m * 16; const float rs = rs8[ai][m]; float ssq = 0.f;
#pragma unroll
                for (int bj = 0; bj < 2; ++bj) { float v[8];
#pragma unroll
                    for (int j = 0; j < 4; ++j) { v[j] = acc[ai][bj][m][0][j] * rs; v[4 + j] = acc[ai][bj][m][1][j] * rs; }
                    if (kind <= 1) {
#pragma unroll
                        for (int j = 0; j < 8; ++j) v[j] = gelu_f(v[j]);
                    } else if (kind == 2) {
#pragma unroll
                        for (int j = 0; j < 8; ++j) v[j] = silu_f(v[j]);
                    }
                    if (kind == 1) {
#pragma unroll
                        for (int j = 0; j < 8; ++j) ssq += v[j] * v[j];
                    }
                    *(u32x4*)(proj + (size_t)row * 4608 + col0 + bj * 128) = pack8(v); }
                if (kind == 1) { ssq += __shfl_xor(ssq, 16); ssq += __shfl_xor(ssq, 32); if (fq == 0) unsafeAtomicAdd(vss + row, ssq); }
            }
    }
};
struct EpiOut {
    static constexpr bool PERM = false, AFTER_DRAIN = false;
    const float* xp; const float* xs; float* hout; bf16_t* hb; float* hss; float* part;
    __device__ __forceinline__ void prefetch(const pg8::Unit&, int, int, float (&)[8]) const {}
    __device__ __forceinline__ void operator()(const f32x4 (&acc)[2][2][4][2], const pg8::Unit& u, int wr, int wc, int fr, int fq, const float (&pre)[8]) const {
        const int row0 = u.pm * 256 + wr * 64 + fr, col0 = u.pn * 256 + wc * 32 + 4 * fq;
        if (u.nk < 32) {
            float* pp = part + ((size_t)(u.k0 >> 2) * 128 + (wr * 64 + fr)) * 2048 + col0;
#pragma unroll
            for (int m = 0; m < 4; ++m)
#pragma unroll
                for (int bj = 0; bj < 2; ++bj)
#pragma unroll
                    for (int n = 0; n < 2; ++n) *(f32x4*)(pp + (size_t)m * 16 * 2048 + bj * 128 + n * 16) = acc[0][bj][m][n];
            return;
        }
#pragma unroll
        for (int am = 0; am < 4; ++am) { const int ai = am >> 1, mb = (am & 1) * 2;
            f32x4 xv[2][2][2];
#pragma unroll
            for (int mm = 0; mm < 2; ++mm) { const int row = row0 + ai * 128 + (mb + mm) * 16; const float* xr = xp + (size_t)row * 2048 + col0;
#pragma unroll
                for (int bj = 0; bj < 2; ++bj)
#pragma unroll
                    for (int n = 0; n < 2; ++n) xv[mm][bj][n] = *(const f32x4*)(xr + bj * 128 + n * 16); }
#pragma unroll
            for (int mm = 0; mm < 2; ++mm)
#pragma unroll
                for (int bj = 0; bj < 2; ++bj)
#pragma unroll
                    for (int n = 0; n < 2; ++n) asm volatile("" : "+v"(xv[mm][bj][n]));
#pragma unroll
            for (int mm = 0; mm < 2; ++mm) { const int m = mb + mm; const int row = row0 + ai * 128 + m * 16; float ssq = 0.f;
#pragma unroll
                for (int bj = 0; bj < 2; ++bj)
#pragma unroll
                    for (int n = 0; n < 2; ++n) { const f32x4 hv = xv[mm][bj][n] + acc[ai][bj][m][n];
                        ssq += hv[0] * hv[0] + hv[1] * hv[1] + hv[2] * hv[2] + hv[3] * hv[3];
                        u32x2 o; o.x = cvt_pk_bf16(hv[0], hv[1]); o.y = cvt_pk_bf16(hv[2], hv[3]); *(u32x2*)(hb + (size_t)row * 2048 + col0 + bj * 128 + n * 16) = o; }
                ssq += __shfl_xor(ssq, 16); ssq += __shfl_xor(ssq, 32); if (fq == 0) unsafeAtomicAdd(hss + row, ssq);
            }
        }
    }
};
struct OutOrder {
    int c;
    __device__ __forceinline__ bool next(int i, pg8::Unit& u) const {
        if (i == 0) { const int x = c & 7, j = c >> 3; u.pm = 4 * x + (j >> 3); u.pn = j & 7; u.k0 = 0; u.nk = 32; return true; }
        if (i == 1 && c < 64) { u.pm = 32; u.pn = c >> 3; u.k0 = (c & 7) * 4; u.nk = 4; return true; }
        return false;
    }
    __device__ __forceinline__ void a_ready(const pg8::Unit&) const {}
    __device__ __forceinline__ void done(const pg8::Unit&) const {}
};
struct GuDepOrder : pg8::StaticOrder {
    const unsigned* flag;
    __device__ __forceinline__ void a_ready(const pg8::Unit& u) const {
        if (u.pm == 32) {
            if (threadIdx.x < 64) { unsigned spins = 0;
                while ((unsigned)__builtin_amdgcn_readfirstlane(__hip_atomic_load(flag, __ATOMIC_RELAXED, __HIP_MEMORY_SCOPE_AGENT)) < 16u && ++spins < (1u << 20)) __builtin_amdgcn_s_sleep(2);
                __builtin_amdgcn_fence(__ATOMIC_ACQUIRE, "agent");
                asm volatile("s_waitcnt vmcnt(0)" ::: "memory"); }
            asm volatile("" ::: "memory"); __builtin_amdgcn_s_barrier(); asm volatile("" ::: "memory");
        }
    }
};
struct EpiGU {
    static constexpr bool PERM = true, AFTER_DRAIN = false;
    bf16_t* act; const float* hss;
    __device__ __forceinline__ void prefetch(const pg8::Unit& u, int wr, int fr, float (&pre)[8]) const {
#pragma unroll
        for (int q = 0; q < 8; ++q) pre[q] = hss[u.pm * 256 + wr * 64 + fr + (q >> 2) * 128 + (q & 3) * 16]; }
    __device__ __forceinline__ void operator()(const f32x4 (&acc)[2][2][4][2], const pg8::Unit& u, int wr, int wc, int fr, int fq, const float (&pre)[8]) const {
        const int row0 = u.pm * 256 + wr * 64 + fr, col0 = u.pn * 128 + wc * 32 + 8 * fq;
        float rs8[2][4];
#pragma unroll
        for (int ai = 0; ai < 2; ++ai)
#pragma unroll
            for (int m = 0; m < 4; ++m) rs8[ai][m] = rsqrtf(pre[ai * 4 + m] * (1.0f / 2048.0f) + EPS);
#pragma unroll
        for (int ai = 0; ai < 2; ++ai)
#pragma unroll
            for (int m = 0; m < 4; ++m) { const int row = row0 + ai * 128 + m * 16; const float rs = rs8[ai][m]; float v[8];
#pragma unroll
                for (int q = 0; q < 4; ++q) { const int n = q >> 1, j0 = (q & 1) * 2;
                    typedef float f32x2v __attribute__((ext_vector_type(2)));
                    f32x2v g, u; g.x = acc[ai][0][m][n][j0]; g.y = acc[ai][0][m][n][j0 + 1]; u.x = acc[ai][1][m][n][j0]; u.y = acc[ai][1][m][n][j0 + 1];
                    g = g * rs; u = u * rs;
                    const f32x2v a = g * (-1.44269504f);
                    f32x2v e; e.x = __builtin_amdgcn_exp2f(a.x); e.y = __builtin_amdgcn_exp2f(a.y);
                    const f32x2v d = e + 1.0f;
                    f32x2v r; r.x = __builtin_amdgcn_rcpf(d.x); r.y = __builtin_amdgcn_rcpf(d.y);
                    const f32x2v o = (g * u) * r;
                    v[n * 4 + j0] = o.x; v[n * 4 + j0 + 1] = o.y; }
                *(u32x4*)(act + (size_t)row * LD_DN + col0) = pack8(v); }
    }
};
struct EpiDown {
    static constexpr bool PERM = false, AFTER_DRAIN = false;
    bf16_t* hb; float* hdst; float* part;
    __device__ __forceinline__ void prefetch(const pg8::Unit&, int, int, float (&)[8]) const {}
    __device__ __forceinline__ void operator()(const f32x4 (&acc)[2][2][4][2], const pg8::Unit& u, int wr, int wc, int fr, int fq, const float (&pre)[8]) const {
        const int row0 = u.pm * 256 + wr * 64 + fr, col0 = u.pn * 256 + wc * 32 + 4 * fq;
        if (u.nk < 88) {
            float* pp = part + ((size_t)(u.k0 >> 3) * 128 + (wr * 64 + fr)) * 2048 + col0;
#pragma unroll
            for (int m = 0; m < 4; ++m)
#pragma unroll
                for (int bj = 0; bj < 2; ++bj)
#pragma unroll
                    for (int n = 0; n < 2; ++n) *(f32x4*)(pp + (size_t)m * 16 * 2048 + bj * 128 + n * 16) = acc[0][bj][m][n];
            return;
        }
#pragma unroll
        for (int ai = 0; ai < 2; ++ai) {
            u32x2 hv[4][2][2];
#pragma unroll
            for (int m = 0; m < 4; ++m) { const bf16_t* hr = hb + (size_t)(row0 + ai * 128 + m * 16) * 2048 + col0;
#pragma unroll
                for (int bj = 0; bj < 2; ++bj)
#pragma unroll
                    for (int n = 0; n < 2; ++n) hv[m][bj][n] = *(const u32x2*)(hr + bj * 128 + n * 16); }
#pragma unroll
            for (int m = 0; m < 4; ++m)
#pragma unroll
                for (int bj = 0; bj < 2; ++bj)
#pragma unroll
                    for (int n = 0; n < 2; ++n) asm volatile("" : "+v"(hv[m][bj][n]));
#pragma unroll
            for (int m = 0; m < 4; ++m) { bf16_t* hw = hb + (size_t)(row0 + ai * 128 + m * 16) * 2048 + col0;
#pragma unroll
                for (int bj = 0; bj < 2; ++bj)
#pragma unroll
                    for (int n = 0; n < 2; ++n) { const u32x2 q = hv[m][bj][n]; f32x4 hf; hf[0] = __uint_as_float(q.x << 16); hf[1] = __uint_as_float(q.x & 0xffff0000u); hf[2] = __uint_as_float(q.y << 16); hf[3] = __uint_as_float(q.y & 0xffff0000u);
                        const f32x4 o = hf + acc[ai][bj][m][n]; u32x2 ob; ob.x = cvt_pk_bf16(o[0], o[1]); ob.y = cvt_pk_bf16(o[2], o[3]); *(u32x2*)(hw + bj * 128 + n * 16) = ob; } }
        }
    }
};
struct DownOrder {
    int c;
    __device__ __forceinline__ bool next(int i, pg8::Unit& u) const {
        if (i == 0) { const int x = c & 7, j = c >> 3; u.pm = 4 * x + (j >> 3); u.pn = j & 7; u.k0 = 0; u.nk = 88; return true; }
        if (i == 1 && c < 88) { u.pm = 32; u.pn = c / 11; u.k0 = (c % 11) * 8; u.nk = 8; return true; }
        return false;
    }
    __device__ __forceinline__ void a_ready(const pg8::Unit&) const {}
    __device__ __forceinline__ void done(const pg8::Unit&) const {}
};

struct WTile { const float* W; bf16_t* dst; int N, ldt, k0, n0, drow0, gsel; };
__device__ __forceinline__ void wt_decode(const Params& p, int tt, WTile& w) {
    unsigned char* ws = p.ws; int kt, nt;
    if (tt < 1184) { kt = tt & 31; nt = tt >> 5; w.W = p.w_in; w.N = 4624; w.ldt = 2048; w.dst = (bf16_t*)(ws + OFF_WTIN); w.drow0 = nt * 128; w.gsel = 0; }
    else if (tt < 1696) { const int q = tt - 1184; kt = q & 31; nt = q >> 5; w.W = p.w_out; w.N = 2048; w.ldt = 2048; w.dst = (bf16_t*)(ws + OFF_WTOUT); w.drow0 = nt * 128; w.gsel = 1; }
    else if (tt < 3104) { const int q = tt - 1696; kt = q & 31; nt = q >> 5; w.W = p.w_gate; w.N = 5632; w.ldt = 2048; w.dst = (bf16_t*)(ws + OFF_WTGU); w.drow0 = 256 * nt; w.gsel = 2; }
    else if (tt < 4512) { const int q = tt - 3104; kt = q & 31; nt = q >> 5; w.W = p.w_up; w.N = 5632; w.ldt = 2048; w.dst = (bf16_t*)(ws + OFF_WTGU); w.drow0 = 256 * nt + 128; w.gsel = 2; }
    else { const int q = tt - 4512; kt = q % 88; nt = q / 88; w.W = p.w_down; w.N = 2048; w.ldt = LD_DN; w.dst = (bf16_t*)(ws + OFF_WTDN); w.drow0 = nt * 128; w.gsel = 3; }
    w.k0 = kt * 64; w.n0 = nt * 128;
}
__device__ __forceinline__ void wt_load(const Params& p, const WTile& w, int r, int c4, f32x4 (&v)[4], float (&gk)[4]) {
    const bool ok = w.n0 + c4 < w.N; const float* wp = w.W + (ok ? w.n0 + c4 : 0);
#pragma unroll
    for (int q = 0; q < 4; ++q) { const int k = w.k0 + r + 16 * q;
        gk[q] = w.gsel == 0 ? p.g_mix[k] : w.gsel == 1 ? (k < 1024 ? p.g_co[k] : p.g_sn[k - 1024]) : w.gsel == 2 ? p.g_ffn[k] : 1.0f; if (!ok) gk[q] = 0.f;
        v[q] = *(const f32x4*)(wp + (size_t)k * w.N); }
}
__device__ __forceinline__ void wt_convert(const Params& p, LAS unsigned char* lds, int t_begin, int t_end, int worker, int G) {
    const int tid = threadIdx.x;
    {
        LAS float* tile = (LAS float*)lds;
        const int r = tid >> 5, c4 = (tid & 31) * 4;
        WTile ta, tb; f32x4 va[4], vb[4]; float ga[4], gb[4];
        int t = t_begin + worker;
        bool ha = t < t_end, hb = t + G < t_end;
        if (ha) { wt_decode(p, t, ta); wt_load(p, ta, r, c4, va, ga); }
        if (hb) { wt_decode(p, t + G, tb); wt_load(p, tb, r, c4, vb, gb); }
        while (ha) {
            {
#pragma unroll
                for (int q = 0; q < 4; ++q) { LAS float* tp = tile + (r + 16 * q) * 129 + c4; tp[0] = va[q][0] * ga[q]; tp[1] = va[q][1] * ga[q]; tp[2] = va[q][2] * ga[q]; tp[3] = va[q][3] * ga[q]; }
                __syncthreads();
                bf16_t* cdst = ta.dst + (size_t)(ta.drow0 + (tid >> 2)) * ta.ldt + ta.k0 + (tid & 3) * 16;
                const int tn = t + 2 * G; ha = tn < t_end;
                if (ha) { wt_decode(p, tn, ta); wt_load(p, ta, r, c4, va, ga); }
                const int n = tid >> 2, kq = tid & 3; float o[16];
#pragma unroll
                for (int i = 0; i < 16; ++i) o[i] = tile[(kq * 16 + i) * 129 + n];
                *(u32x4*)cdst = pack8(o); *(u32x4*)(cdst + 8) = pack8(o + 8);
                __syncthreads();
            }
            if (hb) {
#pragma unroll
                for (int q = 0; q < 4; ++q) { LAS float* tp = tile + (r + 16 * q) * 129 + c4; tp[0] = vb[q][0] * gb[q]; tp[1] = vb[q][1] * gb[q]; tp[2] = vb[q][2] * gb[q]; tp[3] = vb[q][3] * gb[q]; }
                __syncthreads();
                bf16_t* cdst = tb.dst + (size_t)(tb.drow0 + (tid >> 2)) * tb.ldt + tb.k0 + (tid & 3) * 16;
                const int tn = t + 3 * G; hb = tn < t_end;
                if (hb) { wt_decode(p, tn, tb); wt_load(p, tb, r, c4, vb, gb); }
                const int n = tid >> 2, kq = tid & 3; float o[16];
#pragma unroll
                for (int i = 0; i < 16; ++i) o[i] = tile[(kq * 16 + i) * 129 + n];
                *(u32x4*)cdst = pack8(o); *(u32x4*)(cdst + 8) = pack8(o + 8);
                __syncthreads();
            }
            t += 2 * G;
        }
    }
}
__device__ __forceinline__ void phase_prep(const Params& p, LAS unsigned char* lds) {
    const int tid = threadIdx.x, lane = tid & 63, wv = tid >> 6, G = gridDim.x;
    unsigned char* ws = p.ws;
    float* ss = (float*)(ws + OFF_SS);
    for (int i = blockIdx.x * 512 + tid; i < 8448 * 7; i += G * 512) ss[8448 + i] = 0.f;
    if (blockIdx.x == 0 && tid < 128) ss[MROWS + tid] = 2048.f;
    bf16_t* XB = (bf16_t*)(ws + OFF_XB);
    for (int row = blockIdx.x * 8 + wv; row < MROWS; row += G * 8) {
        const float* src = row < 8192 ? p.xp + (size_t)row * 2048 : p.xs + (size_t)(row - 8192) * 2048;
        float s = 0.f; f32x4 xv[8];
#pragma unroll
        for (int j = 0; j < 8; ++j) xv[j] = *(const f32x4*)(src + j * 256 + lane * 4);
#pragma unroll
        for (int j = 0; j < 8; ++j) { const f32x4 v = xv[j]; s += v[0] * v[0] + v[1] * v[1] + v[2] * v[2] + v[3] * v[3];
            u32x2 o; o.x = cvt_pk_bf16(v[0], v[1]); o.y = cvt_pk_bf16(v[2], v[3]); *(u32x2*)(XB + (size_t)row * 2048 + j * 256 + lane * 4) = o; }
#pragma unroll
        for (int o = 32; o >= 1; o >>= 1) s += __shfl_xor(s, o);
        if (lane == 0) ss[row] = s;
    }
    wt_convert(p, lds, 0, 1184, (int)blockIdx.x, G);
    { u32x4* z = (u32x4*)(ws + OFF_WTIN + 4736ull * 2048 * 2); for (int i = blockIdx.x * 512 + tid; i < 32768; i += G * 512) z[i] = (u32x4){0u, 0u, 0u, 0u}; }
}

__device__ __forceinline__ void phase_conv(const Params& p, LAS unsigned char* lds) {
    const int tid = threadIdx.x, G = gridDim.x;
    unsigned char* ws = p.ws;
    const bf16_t* PROJ = (const bf16_t*)(ws + OFF_PROJ);
    bf16_t* XT = (bf16_t*)(ws + OFF_XT); bf16_t* BN = (bf16_t*)(ws + OFF_BN); bf16_t* BTT = (bf16_t*)(ws + OFF_BTT); bf16_t* CC = (bf16_t*)(ws + OFF_CC);
    for (int tsk = blockIdx.x * 512 + tid; tsk < 98304; tsk += G * 512) {
        const int cgi = tsk % 192, rest = tsk / 192, tt0 = (rest & 7) * 16, bc = rest >> 3;
        const int R0 = (bc >> 4) * 2048 + (bc & 15) * 128; const bool first = (bc & 15) == 0;
        const int ch0 = cgi * 8, kind = ch0 < 1024 ? 0 : (ch0 < 1280 ? 1 : 2);
        u32x4 in[19];
#pragma unroll
        for (int j = 0; j < 19; ++j) { const bool ok = !(first && tt0 - 3 + j < 0); const int rr = ok ? (R0 + tt0 - 3 + j) : R0;
            in[j] = *(const u32x4*)(PROJ + (size_t)rr * 4608 + 3072 + ch0); if (!ok) in[j] = (u32x4){0u, 0u, 0u, 0u}; }
        unsigned nat[16][4];
#pragma unroll
        for (int e2 = 0; e2 < 4; ++e2) {
            const int ea = 2 * e2, eb = 2 * e2 + 1; float oa[16], ob[16];
            typedef float f32x2v __attribute__((ext_vector_type(2)));
            const f32x2v q0 = *(const f32x2v*)(p.conv_w + ch0 + ea), q1 = *(const f32x2v*)(p.conv_w + 1536 + ch0 + ea), q2 = *(const f32x2v*)(p.conv_w + 3072 + ch0 + ea), q3 = *(const f32x2v*)(p.conv_w + 4608 + ch0 + ea), qb = *(const f32x2v*)(p.conv_b + ch0 + ea);
            const float w0a = q0.x, w1a = q1.x, w2a = q2.x, w3a = q3.x, cba = qb.x, w0b = q0.y, w1b = q1.y, w2b = q2.y, w3b = q3.y, cbb = qb.y;
#pragma unroll
            for (int t = 0; t < 16; ++t) {
                oa[t] = silu_f(cba + w0a * __uint_as_float(in[t][e2] << 16) + w1a * __uint_as_float(in[t + 1][e2] << 16) + w2a * __uint_as_float(in[t + 2][e2] << 16) + w3a * __uint_as_float(in[t + 3][e2] << 16));
                ob[t] = silu_f(cbb + w0b * __uint_as_float(in[t][e2] & 0xffff0000u) + w1b * __uint_as_float(in[t + 1][e2] & 0xffff0000u) + w2b * __uint_as_float(in[t + 2][e2] & 0xffff0000u) + w3b * __uint_as_float(in[t + 3][e2] & 0xffff0000u));
                nat[t][e2] = cvt_pk_bf16(oa[t], ob[t]); }
            if (kind <= 1) { bf16_t* tp = kind == 0 ? XT + ((size_t)(bc * 1024 + ch0 + ea) * 128 + tt0) : BTT + ((size_t)(bc * 256 + (ch0 - 1024) + ea) * 128 + tt0);
                *(u32x4*)tp = pack8(oa); *(u32x4*)(tp + 8) = pack8(oa + 8); *(u32x4*)(tp + 128) = pack8(ob); *(u32x4*)(tp + 136) = pack8(ob + 8); }
        }
        if (kind >= 1) { bf16_t* np = (kind == 1 ? BN + (ch0 - 1024) : CC + (ch0 - 1280)) + (size_t)(R0 + tt0) * 256;
#pragma unroll
            for (int t = 0; t < 16; ++t) { u32x4 o; o.x = nat[t][0]; o.y = nat[t][1]; o.z = nat[t][2]; o.w = nat[t][3]; *(u32x4*)(np + (size_t)t * 256) = o; } }
    }
    const float* DT = (const float*)(ws + OFF_DT); float* EAC = (float*)(ws + OFF_EAC); float* EAL = (float*)(ws + OFF_EAL);
    float* FA = (float*)(ws + OFF_FA); float* FD = (float*)(ws + OFF_FD); float* FW = (float*)(ws + OFF_FW);
    LAS float* ftot = (LAS float*)lds;
    const int lane = tid & 63, wv8 = tid >> 6;
    for (int s0 = blockIdx.x * 4; s0 < 1024; s0 += G * 4) {
        const int q = tid >> 7, t = tid & 127, seq = s0 + q, bc = seq >> 4, h = seq & 15, R0 = (bc >> 4) * 2048 + (bc & 15) * 128;
        const float dtv = softplus_f(DT[(size_t)(R0 + t) * 16 + h] + p.dt_bias[h]);
        float xa = dtv * (-expf(p.a_log[h]));
#pragma unroll
        for (int o = 1; o < 64; o <<= 1) { const float u = __shfl_up(xa, o); if (lane >= o) xa += u; }
        if (lane == 63) ftot[wv8] = xa;
        __syncthreads();
        if (wv8 & 1) xa += ftot[wv8 - 1];
        if (t == 127) ftot[8 + q] = xa;
        __syncthreads();
        const float a_last = ftot[8 + q];
        FA[seq * 128 + t] = xa; FD[seq * 128 + t] = dtv; FW[seq * 128 + t] = expf(a_last - xa) * dtv; EAC[(size_t)(R0 + t) * 16 + h] = expf(xa);
        if (t == 127) EAL[seq] = expf(a_last);
        __syncthreads();
    }
}

__device__ __forceinline__ void conv16(const Params& p, const bf16_t* PROJ, int R0, int t0, bool first, int ch, float (&o)[16]) {
    float in[19];
    const bf16_t* src = PROJ + (size_t)(R0 + t0) * 4608 + 3072 + ch;
#pragma unroll
    for (int j = 0; j < 19; ++j) { in[j] = 0.f; if (!(first && t0 - 3 + j < 0)) in[j] = bf2f(src[(ptrdiff_t)(j - 3) * 4608]); }
    const float w0 = p.conv_w[ch], w1 = p.conv_w[1536 + ch], w2 = p.conv_w[3072 + ch], w3 = p.conv_w[4608 + ch], cb = p.conv_b[ch];
#pragma unroll
    for (int t = 0; t < 16; ++t) o[t] = silu_f(cb + w0 * in[t] + w1 * in[t + 1] + w2 * in[t + 2] + w3 * in[t + 3]);
}

__device__ __forceinline__ void ssd_local(const Params& p, LAS unsigned char* lds, int b, int c, int h) {
    const int tid = threadIdx.x, lane = tid & 63, w = __builtin_amdgcn_readfirstlane(tid >> 6), g = h >> 3, fr = lane & 15, fq = lane >> 4;
    const int R0 = b * 2048 + c * 128, t0 = w * 16;
    unsigned char* ws = p.ws;
    const bf16_t* PROJ = (const bf16_t*)(ws + OFF_PROJ);
    const float* DT = (const float*)(ws + OFF_DT);
    float* EAC = (float*)(ws + OFF_EAC); float* EAL = (float*)(ws + OFF_EAL);
    LAS unsigned char* CcL = lds; LAS unsigned char* BcL = lds + 34816; LAS unsigned char* BTL = lds + 69632; LAS unsigned char* xTL = lds + 104448;
    LAS unsigned char* ML = lds + 121856;
    LAS float* fa = (LAS float*)(lds + 156672); LAS float* fd = fa + 128;
    {
        const int bc = b * 16 + c, seq = bc * 16 + h;
        const bf16_t* CC = (const bf16_t*)(ws + OFF_CC); const bf16_t* BN = (const bf16_t*)(ws + OFF_BN); const bf16_t* BTT = (const bf16_t*)(ws + OFF_BTT); const bf16_t* XT = (const bf16_t*)(ws + OFF_XT);
        if (tid < 128) { fa[tid] = ((const float*)(ws + OFF_FA))[seq * 128 + tid]; fd[tid] = ((const float*)(ws + OFF_FD))[seq * 128 + tid]; }
        const f32x4 fw0 = *(const f32x4*)((const float*)(ws + OFF_FW) + seq * 128 + (tid & 15) * 8), fw1 = *(const f32x4*)((const float*)(ws + OFF_FW) + seq * 128 + (tid & 15) * 8 + 4);
        u32x4 cv[4], bv[4], tv[4], xv[2];
#pragma unroll
        for (int i = 0; i < 4; ++i) { const int q = tid + 512 * i, row = q >> 4, c16 = q & 15;
            cv[i] = *(const u32x4*)(CC + (size_t)(R0 + row) * 256 + g * 128 + c16 * 8); bv[i] = *(const u32x4*)(BN + (size_t)(R0 + row) * 256 + g * 128 + c16 * 8);
            tv[i] = *(const u32x4*)(BTT + ((size_t)(bc * 256 + g * 128 + row) * 128 + c16 * 8)); }
#pragma unroll
        for (int i = 0; i < 2; ++i) { const int q = tid + 512 * i, row = q >> 4, c16 = q & 15; xv[i] = *(const u32x4*)(XT + ((size_t)(bc * 1024 + h * 64 + row) * 128 + c16 * 8)); }
#pragma unroll
        for (int i = 0; i < 4; ++i) { const int q = tid + 512 * i, row = q >> 4, c16 = q & 15; *(LAS u32x4*)(CcL + row * 272 + c16 * 16) = cv[i]; *(LAS u32x4*)(BcL + row * 272 + c16 * 16) = bv[i]; }
#pragma unroll
        for (int i = 0; i < 2; ++i) { const int q = tid + 512 * i, row = q >> 4, c16 = q & 15; *(LAS u32x4*)(xTL + row * 272 + c16 * 16) = xv[i]; }
#pragma unroll
        for (int i = 0; i < 4; ++i) { const int q = tid + 512 * i, row = q >> 4, c16 = q & 15; float f[8];
#pragma unroll
            for (int e = 0; e < 4; ++e) { const float wa = (2 * e < 4) ? fw0[(2 * e) & 3] : fw1[(2 * e) & 3], wb = (2 * e + 1 < 4) ? fw0[(2 * e + 1) & 3] : fw1[(2 * e + 1) & 3];
                f[2 * e] = __uint_as_float(tv[i][e] << 16) * wa; f[2 * e + 1] = __uint_as_float(tv[i][e] & 0xffff0000u) * wb; }
            *(LAS u32x4*)(BTL + row * 272 + c16 * 16) = pack8(f); }
        __syncthreads();
    }
    f32x4 cbt[8];
#pragma unroll
    for (int j = 0; j < 8; ++j) cbt[j] = (f32x4){0.f, 0.f, 0.f, 0.f};
#pragma unroll
    for (int ks = 0; ks < 4; ++ks) { const bf16x8 a = *(LAS bf16x8*)(CcL + (t0 + fr) * 272 + (ks * 32 + fq * 8) * 2);
#pragma unroll
        for (int j = 0; j < 8; ++j) if (j <= w) { const bf16x8 bb = *(LAS bf16x8*)(BcL + (j * 16 + fr) * 272 + (ks * 32 + fq * 8) * 2); cbt[j] = mfma16(a, bb, cbt[j]); } }
#pragma unroll
    for (int j = 0; j < 8; ++j) if (j <= (w | 1)) {
#pragma unroll
        for (int i = 0; i < 4; ++i) { const int t = t0 + fq * 4 + i, s = j * 16 + fr; float v = 0.f; if (j <= w && s <= t) v = cbt[j][i] * __expf(fa[t] - fa[s]) * fd[s];
            *(LAS bf16_t*)(ML + t * 272 + s * 2) = f2bf(v); } }
    const int nks = (w >> 1) + 1;
    f32x4 yd[4];
#pragma unroll
    for (int j = 0; j < 4; ++j) yd[j] = (f32x4){0.f, 0.f, 0.f, 0.f};
#pragma unroll
    for (int ks = 0; ks < 4; ++ks) if (ks < nks) { const bf16x8 a = *(LAS bf16x8*)(ML + (t0 + fr) * 272 + (ks * 32 + fq * 8) * 2);
#pragma unroll
        for (int pj = 0; pj < 4; ++pj) { const bf16x8 bb = *(LAS bf16x8*)(xTL + (pj * 16 + fr) * 272 + (ks * 32 + fq * 8) * 2); yd[pj] = mfma16(a, bb, yd[pj]); } }
    { float* YD = (float*)(ws + OFF_YD); const float Dh = p.dvec[h];
#pragma unroll
        for (int pj = 0; pj < 4; ++pj)
#pragma unroll
            for (int i = 0; i < 4; ++i) { const int t = t0 + fq * 4 + i, pc = pj * 16 + fr; const float xv = bf2f(*(LAS bf16_t*)(xTL + pc * 272 + t * 2));
                YD[(size_t)(R0 + t) * 1024 + h * 64 + pc] = yd[pj][i] + Dh * xv; } }
    f32x4 st[4];
#pragma unroll
    for (int j = 0; j < 4; ++j) st[j] = (f32x4){0.f, 0.f, 0.f, 0.f};
#pragma unroll
    for (int ks = 0; ks < 4; ++ks) { const bf16x8 bb = *(LAS bf16x8*)(BTL + (t0 + fr) * 272 + (ks * 32 + fq * 8) * 2);
#pragma unroll
        for (int pi = 0; pi < 4; ++pi) { const bf16x8 a = *(LAS bf16x8*)(xTL + (pi * 16 + fr) * 272 + (ks * 32 + fq * 8) * 2); st[pi] = mfma16(a, bb, st[pi]); } }
    { float* S = (float*)(ws + OFF_STATES) + (size_t)((b * 16 + c) * 16 + h) * 8192;
#pragma unroll
        for (int pi = 0; pi < 4; ++pi)
#pragma unroll
            for (int i = 0; i < 4; ++i) S[(pi * 16 + fq * 4 + i) * 128 + t0 + fr] = st[pi][i]; }
    __syncthreads();
}

__device__ __forceinline__ void ssd_group(const Params& p, LAS unsigned char* lds, int b, int c, int g) {
    const int tid = threadIdx.x, lane = tid & 63, w = __builtin_amdgcn_readfirstlane(tid >> 6), fr = lane & 15, fq = lane >> 4;
    const int R0 = b * 2048 + c * 128, t0 = w * 16, bc = b * 16 + c;
    unsigned char* ws = p.ws;
    const bf16_t* CC = (const bf16_t*)(ws + OFF_CC); const bf16_t* BN = (const bf16_t*)(ws + OFF_BN); const bf16_t* BTT = (const bf16_t*)(ws + OFF_BTT); const bf16_t* XT = (const bf16_t*)(ws + OFF_XT);
    const float* FA = (const float*)(ws + OFF_FA); const float* FD = (const float*)(ws + OFF_FD); const float* FW = (const float*)(ws + OFF_FW);
    LAS unsigned char* CcL = lds; LAS unsigned char* BcL = lds + 34816; LAS unsigned char* BTL = lds + 69632;
    LAS unsigned char* ML = lds;
    LAS float* faL = (LAS float*)(lds + 104448); LAS float* fdL = faL + 1024;
    {
        u32x4 cv[4], bv[4], tv[4];
#pragma unroll
        for (int i = 0; i < 4; ++i) { const int q = tid + 512 * i, row = q >> 4, c16 = q & 15;
            cv[i] = *(const u32x4*)(CC + (size_t)(R0 + row) * 256 + g * 128 + c16 * 8); bv[i] = *(const u32x4*)(BN + (size_t)(R0 + row) * 256 + g * 128 + c16 * 8);
            tv[i] = *(const u32x4*)(BTT + ((size_t)(bc * 256 + g * 128 + row) * 128 + c16 * 8)); }
        float fav[2], fdv[2];
#pragma unroll
        for (int k = 0; k < 2; ++k) { const int q = tid + 512 * k; fav[k] = FA[(size_t)(bc * 16 + g * 8) * 128 + q]; fdv[k] = FD[(size_t)(bc * 16 + g * 8) * 128 + q]; }
#pragma unroll
        for (int i = 0; i < 4; ++i) { const int q = tid + 512 * i, row = q >> 4, c16 = q & 15; *(LAS u32x4*)(CcL + row * 272 + c16 * 16) = cv[i]; *(LAS u32x4*)(BcL + row * 272 + c16 * 16) = bv[i]; *(LAS u32x4*)(BTL + row * 272 + c16 * 16) = tv[i]; }
#pragma unroll
        for (int k = 0; k < 2; ++k) { faL[tid + 512 * k] = fav[k]; fdL[tid + 512 * k] = fdv[k]; }
    }
    __syncthreads();
    f32x4 cbt[8];
#pragma unroll
    for (int j = 0; j < 8; ++j) cbt[j] = (f32x4){0.f, 0.f, 0.f, 0.f};
#pragma unroll
    for (int ks = 0; ks < 4; ++ks) { const bf16x8 a = *(LAS bf16x8*)(CcL + (t0 + fr) * 272 + (ks * 32 + fq * 8) * 2);
#pragma unroll
        for (int j = 0; j < 8; ++j) if (j <= w) { const bf16x8 bb = *(LAS bf16x8*)(BcL + (j * 16 + fr) * 272 + (ks * 32 + fq * 8) * 2); cbt[j] = mfma16(a, bb, cbt[j]); } }
    u32x4 xv[2]; f32x4 fw0, fw1;
    { const int seq = bc * 16 + g * 8;
#pragma unroll
        for (int i = 0; i < 2; ++i) { const int q = tid + 512 * i, row = q >> 4, c16 = q & 15; xv[i] = *(const u32x4*)(XT + ((size_t)(bc * 1024 + g * 512 + row) * 128 + c16 * 8)); }
        fw0 = *(const f32x4*)(FW + (size_t)seq * 128 + (tid & 15) * 8); fw1 = *(const f32x4*)(FW + (size_t)seq * 128 + (tid & 15) * 8 + 4); }
    __syncthreads();
    const int nks = (w >> 1) + 1;
    for (int hh = 0; hh < 8; ++hh) {
        const int h = g * 8 + hh;
        LAS float* fa = faL + hh * 128; LAS float* fd = fdL + hh * 128;
        LAS unsigned char* xTL = lds + ((hh & 1) ? 112640 : 34816); LAS unsigned char* xTsL = xTL + 17408;
#pragma unroll
        for (int i = 0; i < 2; ++i) { const int q = tid + 512 * i, row = q >> 4, c16 = q & 15; float f[8];
#pragma unroll
            for (int e = 0; e < 4; ++e) { const float wa = (2 * e < 4) ? fw0[(2 * e) & 3] : fw1[(2 * e) & 3], wb = (2 * e + 1 < 4) ? fw0[(2 * e + 1) & 3] : fw1[(2 * e + 1) & 3];
                f[2 * e] = __uint_as_float(xv[i][e] << 16) * wa; f[2 * e + 1] = __uint_as_float(xv[i][e] & 0xffff0000u) * wb; }
            *(LAS u32x4*)(xTL + row * 272 + c16 * 16) = xv[i]; *(LAS u32x4*)(xTsL + row * 272 + c16 * 16) = pack8(f); }
        if (hh < 7) { const int seq = bc * 16 + h + 1;
#pragma unroll
            for (int i = 0; i < 2; ++i) { const int q = tid + 512 * i, row = q >> 4, c16 = q & 15; xv[i] = *(const u32x4*)(XT + ((size_t)(bc * 1024 + (h + 1) * 64 + row) * 128 + c16 * 8)); }
            fw0 = *(const f32x4*)(FW + (size_t)seq * 128 + (tid & 15) * 8); fw1 = *(const f32x4*)(FW + (size_t)seq * 128 + (tid & 15) * 8 + 4); }
#pragma unroll
        for (int j = 0; j < 8; ++j) if (j <= (w | 1)) {
#pragma unroll
            for (int i = 0; i < 4; ++i) { const int t = t0 + fq * 4 + i, s = j * 16 + fr; float v = 0.f; if (j <= w && s <= t) v = cbt[j][i] * __expf(fa[t] - fa[s]) * fd[s];
                *(LAS bf16_t*)(ML + t * 272 + s * 2) = f2bf(v); } }
        __syncthreads();
        f32x4 yd[4];
#pragma unroll
        for (int j = 0; j < 4; ++j) yd[j] = (f32x4){0.f, 0.f, 0.f, 0.f};
#pragma unroll
        for (int ks = 0; ks < 4; ++ks) if (ks < nks) { const bf16x8 a = *(LAS bf16x8*)(ML + (t0 + fr) * 272 + (ks * 32 + fq * 8) * 2);
#pragma unroll
            for (int pj = 0; pj < 4; ++pj) { const bf16x8 bb = *(LAS bf16x8*)(xTL + (pj * 16 + fr) * 272 + (ks * 32 + fq * 8) * 2); yd[pj] = mfma16(a, bb, yd[pj]); } }
        { float* YD = (float*)(ws + OFF_YD); const float Dh = p.dvec[h];
#pragma unroll
            for (int pj = 0; pj < 4; ++pj)
#pragma unroll
                for (int i = 0; i < 4; ++i) { const int t = t0 + fq * 4 + i, pc = pj * 16 + fr; const float xx = bf2f(*(LAS bf16_t*)(xTL + pc * 272 + t * 2));
                    YD[(size_t)(R0 + t) * 1024 + h * 64 + pc] = yd[pj][i] + Dh * xx; } }
        f32x4 st[4];
#pragma unroll
        for (int j = 0; j < 4; ++j) st[j] = (f32x4){0.f, 0.f, 0.f, 0.f};
#pragma unroll
        for (int ks = 0; ks < 4; ++ks) { const bf16x8 bb = *(LAS bf16x8*)(BTL + (t0 + fr) * 272 + (ks * 32 + fq * 8) * 2);
#pragma unroll
            for (int pi = 0; pi < 4; ++pi) { const bf16x8 a = *(LAS bf16x8*)(xTsL + (pi * 16 + fr) * 272 + (ks * 32 + fq * 8) * 2); st[pi] = mfma16(a, bb, st[pi]); } }
        { float* S = (float*)(ws + OFF_STATES) + (size_t)(bc * 16 + h) * 8192;
#pragma unroll
            for (int pi = 0; pi < 4; ++pi)
#pragma unroll
                for (int i = 0; i < 4; ++i) S[(pi * 16 + fq * 4 + i) * 128 + t0 + fr] = st[pi][i]; }
    }
    __syncthreads();
}

__device__ __forceinline__ void chunk_mlp(const Params& p, LAS unsigned char* lds, int b, int c, int h, bool dry) {
    const int tid = threadIdx.x, lane = tid & 63, w = __builtin_amdgcn_readfirstlane(tid >> 6), fr = lane & 15, fq = lane >> 4;
    const int R0 = b * 2048 + c * 128, t0 = w * 16;
    unsigned char* ws = p.ws;
    const bf16_t* PROJ = (const bf16_t*)(ws + OFF_PROJ);
    float* ss = (float*)(ws + OFF_SS); const float* vss = ss + 8448; float* yss = (float*)(ws + (dry ? OFF_SS2 : OFF_SS)) + 2 * 8448;
    bf16_t* Y = (bf16_t*)(ws + OFF_XB);
    LAS unsigned char* gvT = lds;
    const int nks = (w >> 1) + 1, trow = t0 + fr;
    f32x4 wq[4][2];
#pragma unroll
    for (int ks = 0; ks < 4; ++ks) if (ks < nks) { const float* wp = p.w_s + (size_t)h * 16384 + trow * 128 + ks * 32 + fq * 8; wq[ks][0] = *(const f32x4*)wp; wq[ks][1] = *(const f32x4*)(wp + 4); }
    float uu[4][8], bias4[4];
#pragma unroll
    for (int i = 0; i < 4; ++i) { const int t = t0 + fq * 4 + i; bias4[i] = p.b_s[h * 128 + t];
#pragma unroll
        for (int dj = 0; dj < 8; ++dj) uu[i][dj] = bf2f(PROJ[(size_t)(R0 + t) * 4608 + h * 128 + dj * 16 + fr]); }
    if (tid < 256) { const int d0 = (tid & 15) * 8, tt0 = (tid >> 4) * 8;
        u32x4 in[8]; float rv[8];
#pragma unroll
        for (int j = 0; j < 8; ++j) { in[j] = *(const u32x4*)(PROJ + (size_t)(R0 + tt0 + j) * 4608 + 1024 + h * 128 + d0); rv[j] = vss[R0 + tt0 + j]; }
        f32x4 gq[2]; gq[0] = *(const f32x4*)(p.g_cv + h * 128 + d0); gq[1] = *(const f32x4*)(p.g_cv + h * 128 + d0 + 4);
#pragma unroll
        for (int j = 0; j < 8; ++j) rv[j] = rsqrtf(rv[j] * (1.0f / 1024.0f) + EPS);
#pragma unroll
        for (int e2 = 0; e2 < 4; ++e2) { const int ea = 2 * e2, eb = 2 * e2 + 1; const float ga = gq[ea >> 2][ea & 3], gb = gq[eb >> 2][eb & 3]; float oa[8], ob[8];
#pragma unroll
            for (int j = 0; j < 8; ++j) { oa[j] = __uint_as_float(in[j][e2] << 16) * rv[j] * ga; ob[j] = __uint_as_float(in[j][e2] & 0xffff0000u) * rv[j] * gb; }
            *(LAS u32x4*)(gvT + (d0 + ea) * 272 + tt0 * 2) = pack8(oa); *(LAS u32x4*)(gvT + (d0 + eb) * 272 + tt0 * 2) = pack8(ob); } }
    __syncthreads();
    f32x4 acc[8];
#pragma unroll
    for (int j = 0; j < 8; ++j) acc[j] = (f32x4){0.f, 0.f, 0.f, 0.f};
#pragma unroll
    for (int ks = 0; ks < 4; ++ks) if (ks < nks) { const int s0 = ks * 32 + fq * 8; float wv[8];
#pragma unroll
        for (int e = 0; e < 4; ++e) { wv[e] = (s0 + e <= trow) ? wq[ks][0][e] : 0.f; wv[4 + e] = (s0 + 4 + e <= trow) ? wq[ks][1][e] : 0.f; }
        const bf16x8 a = __builtin_bit_cast(bf16x8, pack8(wv));
#pragma unroll
        for (int dj = 0; dj < 8; ++dj) { const bf16x8 bb = *(LAS bf16x8*)(gvT + (dj * 16 + fr) * 272 + s0 * 2); acc[dj] = mfma16(a, bb, acc[dj]); } }
#pragma unroll
    for (int i = 0; i < 4; ++i) { const int t = t0 + fq * 4 + i; const float bias = bias4[i]; float ssq = 0.f;
#pragma unroll
        for (int dj = 0; dj < 8; ++dj) { const int d = dj * 16 + fr; const float v = uu[i][dj] * (acc[dj][i] + bias);
            ssq += v * v; Y[(size_t)(R0 + t) * 2048 + h * 128 + d] = f2bf(v); }
        ssq += __shfl_xor(ssq, 1); ssq += __shfl_xor(ssq, 2); ssq += __shfl_xor(ssq, 4); ssq += __shfl_xor(ssq, 8);
        if (fr == 0) unsafeAtomicAdd(yss + (size_t)(R0 + t) * 4, ssq); }
    __syncthreads();
}

__device__ __forceinline__ void sample_item(const Params& p, LAS unsigned char* lds, int b, int g, bool dry) {
    const int tid = threadIdx.x, lane = tid & 63, w = __builtin_amdgcn_readfirstlane(tid >> 6), h = g * 8 + w, row = 8192 + b;
    unsigned char* ws = p.ws;
    const bf16_t* PROJ = (const bf16_t*)(ws + OFF_PROJ);
    const float* DT = (const float*)(ws + OFF_DT);
    float* ss = (float*)(ws + OFF_SS); const float* vss = ss + 8448; float* yss = (float*)(ws + (dry ? OFF_SS2 : OFF_SS)) + 2 * 8448;
    bf16_t* Y = (bf16_t*)(ws + OFF_XB);
    LAS float* wl = (LAS float*)(lds + w * 2048);
    const float* sc = p.sconv + (size_t)b * 3 * 1536; float* ocs = p.out + O_CONVS + (size_t)b * 3 * 1536;
    int chs[5]; chs[0] = h * 64 + lane; chs[1] = 1024 + g * 128 + lane; chs[2] = 1024 + g * 128 + 64 + lane; chs[3] = 1280 + g * 128 + lane; chs[4] = 1280 + g * 128 + 64 + lane;
    float s0[5], s1[5], s2[5], xn[5], cv[5];
#pragma unroll
    for (int k = 0; k < 5; ++k) { const int ch = chs[k]; xn[k] = bf2f(PROJ[(size_t)row * 4608 + 3072 + ch]); s0[k] = sc[ch]; s1[k] = sc[1536 + ch]; s2[k] = sc[3072 + ch];
        cv[k] = p.conv_b[ch] + p.conv_w[ch] * s0[k] + p.conv_w[1536 + ch] * s1[k] + p.conv_w[3072 + ch] * s2[k] + p.conv_w[4608 + ch] * xn[k]; }
#pragma unroll
    for (int k = 0; k < 5; ++k) { cv[k] = silu_f(cv[k]); if (k == 0 || w == 0) { const int ch = chs[k]; ocs[ch] = s1[k]; ocs[1536 + ch] = s2[k]; ocs[3072 + ch] = xn[k]; } }
    const float xv = cv[0], B0 = cv[1], B1 = cv[2], C0 = cv[3], C1 = cv[4];
    const float dt = softplus_f(DT[(size_t)row * 16 + h] + p.dt_bias[h]); const float dA = expf(-expf(p.a_log[h]) * dt);
    wl[lane] = B0; wl[64 + lane] = B1; wl[128 + lane] = C0; wl[192 + lane] = C1; wl[256 + lane] = xv * dt; wl[320 + lane] = xv;
    const int nn = (lane & 31) * 4, ph = lane >> 5;
    const f32x4 B4 = *(LAS f32x4*)(wl + nn), C4 = *(LAS f32x4*)(wl + 128 + nn);
    const float* h0 = p.sssm + (size_t)(b * 16 + h) * 8192; float* hn = p.out + O_SSMS + (size_t)(b * 16 + h) * 8192;
    {
        f32x4 hv[2][8];
#pragma unroll
        for (int k = 0; k < 8; ++k) hv[0][k] = *(const f32x4*)(h0 + (k * 2 + ph) * 128 + nn);
#pragma unroll
        for (int bt = 0; bt < 4; ++bt) {
            if (bt < 3) {
#pragma unroll
                for (int k = 0; k < 8; ++k) hv[(bt + 1) & 1][k] = *(const f32x4*)(h0 + (((bt + 1) * 8 + k) * 2 + ph) * 128 + nn);
            }
#pragma unroll
            for (int k = 0; k < 8; ++k) { const int pp = ((bt * 8 + k) * 2) + ph; const float xd = wl[256 + pp];
                const f32x4 r = hv[bt & 1][k] * dA + B4 * xd; *(f32x4*)(hn + pp * 128 + nn) = r;
                float part = r[0] * C4[0] + r[1] * C4[1] + r[2] * C4[2] + r[3] * C4[3];
                part += __shfl_xor(part, 1); part += __shfl_xor(part, 2); part += __shfl_xor(part, 4); part += __shfl_xor(part, 8); part += __shfl_xor(part, 16);
                if ((lane & 31) == 0) wl[384 + pp] = part; }
        }
    }
    float y = wl[384 + lane] + p.dvec[h] * xv;
    y *= bf2f(PROJ[(size_t)row * 4608 + 2048 + h * 64 + lane]);
    float ssq = y * y;
#pragma unroll
    for (int o = 32; o >= 1; o >>= 1) ssq += __shfl_xor(ssq, o);
    if (lane == 0) unsafeAtomicAdd(yss + (size_t)row * 4 + 1 + g, ssq);
    Y[(size_t)row * 2048 + 1024 + h * 64 + lane] = f2bf(y);
    { const int cidx = g * 512 + tid, hh = cidx >> 7; const float gv = bf2f(PROJ[(size_t)row * 4608 + 1024 + cidx]); const float rs = rsqrtf(vss[row] * (1.0f / 1024.0f) + EPS);
        const float vrow = gv * rs * p.g_cv[cidx]; p.out[O_VS + (size_t)b * 1024 + cidx] = vrow;
        const float mixed = p.w_s[(size_t)hh * 16384] * vrow + p.b_s[hh * 128]; const float ya = bf2f(PROJ[(size_t)row * 4608 + cidx]) * mixed;
        Y[(size_t)row * 2048 + cidx] = f2bf(ya); float s2 = ya * ya;
#pragma unroll
        for (int o = 32; o >= 1; o >>= 1) s2 += __shfl_xor(s2, o);
        if (lane == 0) unsafeAtomicAdd(yss + (size_t)row * 4, s2); }
    __syncthreads();
}

__device__ __forceinline__ void phase_mixer(const Params& p, LAS unsigned char* lds, bool dry) {
#ifndef PROBE_SSD
#define PROBE_SSD 0
#define PROBE_CHUNK 0
#define PROBE_SAMPLE 0
#endif
    const int G = gridDim.x, bx = blockIdx.x, half = G >> 1;
    if (bx < half) {
        for (int it = bx; it < 128; it += half) ssd_group(p, lds, it >> 5, (it >> 1) & 15, it & 1);
        for (int j = bx; j < 128; j += half) chunk_mlp(p, lds, j >> 7, (j >> 3) & 15, j & 7, dry);
    } else {
        const int k = bx - half, nk2 = G - half;
        for (int j = k; j < 256; j += nk2) sample_item(p, lds, j >> 1, j & 1, dry);
        for (int j = 128 + k; j < 512; j += nk2) chunk_mlp(p, lds, j >> 7, (j >> 3) & 15, j & 7, dry);
    }
    if (blockIdx.x < 4) { const int b = blockIdx.x; const bf16_t* PROJ = (const bf16_t*)(p.ws + OFF_PROJ);
        for (int i = threadIdx.x; i < 4608; i += 512) { const int k = i / 1536, ch = i - k * 1536;
            p.out[O_CONVP + (size_t)(b * 3 + k) * 1536 + ch] = bf2f(PROJ[(size_t)(b * 2048 + 2045 + k) * 4608 + 3072 + ch]); } }
}

__device__ __forceinline__ void phase_scan(const Params& p, bool dry) {
    const float* STATES = (const float*)(p.ws + OFF_STATES); const float* EAL = (const float*)(p.ws + OFF_EAL); bf16_t* HPREV = (bf16_t*)(p.ws + OFF_HPREV);
    for (int i = blockIdx.x * 512 + threadIdx.x; i < 131072; i += gridDim.x * 512) {
        const int b = i >> 15, e = (i & 32767) * 4, h = e >> 13;
        f32x4 run = (f32x4){0.f, 0.f, 0.f, 0.f}; f32x4 stv[16]; float ealv[16];
#pragma unroll
        for (int c = 0; c < 16; ++c) { stv[c] = *(const f32x4*)(STATES + (size_t)(b * 16 + c) * 131072 + e); ealv[c] = EAL[(b * 16 + c) * 16 + h]; }
#pragma unroll
        for (int c = 0; c < 16; ++c) { u32x2 o; o.x = cvt_pk_bf16(run[0], run[1]); o.y = cvt_pk_bf16(run[2], run[3]); *(u32x2*)(HPREV + (size_t)(b * 16 + c) * 131072 + e) = o;
            run = run * ealv[c] + stv[c]; }
        *(f32x4*)(p.out + O_SSMP + (size_t)b * 131072 + e) = run;
    }
    if (!dry) {
        const float* yss = (const float*)(p.ws + OFF_SS) + 2 * 8448; bf16_t* Y = (bf16_t*)(p.ws + OFF_XB);
        for (int i = blockIdx.x * 512 + threadIdx.x; i < 128 * 256; i += gridDim.x * 512) { const int row = 8192 + (i >> 8), c8 = (i & 255) * 8, seg = c8 < 1024 ? 0 : (c8 < 1536 ? 1 : 2);
            const float rs = rsqrtf(yss[(size_t)row * 4 + seg] * (seg ? (1.0f / 512.0f) : (1.0f / 1024.0f)) + EPS);
            const u32x4 v = *(const u32x4*)(Y + (size_t)row * 2048 + c8); float f[8];
#pragma unroll
            for (int e = 0; e < 4; ++e) { f[2 * e] = __uint_as_float(v[e] << 16) * rs; f[2 * e + 1] = __uint_as_float(v[e] & 0xffff0000u) * rs; }
            *(u32x4*)(Y + (size_t)row * 2048 + c8) = pack8(f); }
    }
}

__device__ __forceinline__ void phase_combine(const Params& p, LAS unsigned char* lds, bool dry) {
    const int tid = threadIdx.x, lane = tid & 63, w = tid >> 6, fr = lane & 15, fq = lane >> 4;
    unsigned char* ws = p.ws;
    const bf16_t* PROJ = (const bf16_t*)(ws + OFF_PROJ); const bf16_t* CC = (const bf16_t*)(ws + OFF_CC); const bf16_t* HPREV = (const bf16_t*)(ws + OFF_HPREV);
    const float* YD = (const float*)(ws + OFF_YD); const float* EAC = (const float*)(ws + OFF_EAC);
    const float* yss = (const float*)(ws + OFF_SS) + 2 * 8448; bf16_t* Y = (bf16_t*)(ws + OFF_XB);
    LAS float* part = (LAS float*)lds;
    for (int it = blockIdx.x; it < 512; it += gridDim.x) {
        const int b = it >> 7, c = (it >> 3) & 15, g = (it >> 2) & 1, rb = it & 3, h = g * 8 + w, Rb = b * 2048 + c * 128 + rb * 32;
        u32x4 ya[4]; float rsa[4];
#pragma unroll
        for (int k = 0; k < 4; ++k) { const int q = tid + 512 * k, row = Rb + (q >> 6), c8 = (q & 63) * 8;
            ya[k] = *(const u32x4*)(Y + (size_t)row * 2048 + g * 512 + c8); rsa[k] = yss[(size_t)row * 4]; }
        f32x4 acc[2][4];
#pragma unroll
        for (int u = 0; u < 2; ++u)
#pragma unroll
            for (int j = 0; j < 4; ++j) acc[u][j] = (f32x4){0.f, 0.f, 0.f, 0.f};
        const bf16_t* ccp = CC + (size_t)(Rb + fr) * 256 + g * 128 + fq * 8;
        const bf16_t* hp = HPREV + (size_t)((b * 16 + c) * 16 + h) * 8192 + fr * 128 + fq * 8;
#pragma unroll
        for (int ks = 0; ks < 4; ++ks) { const bf16x8 a0 = *(const bf16x8*)(ccp + ks * 32), a1 = *(const bf16x8*)(ccp + 16 * 256 + ks * 32);
#pragma unroll
            for (int pj = 0; pj < 4; ++pj) { const bf16x8 bb = *(const bf16x8*)(hp + pj * 2048 + ks * 32); acc[0][pj] = mfma16(a0, bb, acc[0][pj]); acc[1][pj] = mfma16(a1, bb, acc[1][pj]); } }
        float yv[2][4][4], zv[2][4][4], ea[2][4];
#pragma unroll
        for (int u = 0; u < 2; ++u)
#pragma unroll
            for (int i = 0; i < 4; ++i) { const int r = Rb + u * 16 + fq * 4 + i; ea[u][i] = EAC[(size_t)r * 16 + h];
#pragma unroll
                for (int pj = 0; pj < 4; ++pj) { const int pc = pj * 16 + fr; yv[u][i][pj] = YD[(size_t)r * 1024 + h * 64 + pc]; zv[u][i][pj] = bf2f(PROJ[(size_t)r * 4608 + 2048 + h * 64 + pc]); } }
#pragma unroll
        for (int u = 0; u < 2; ++u)
#pragma unroll
            for (int i = 0; i < 4; ++i) { float ssq = 0.f;
#pragma unroll
                for (int pj = 0; pj < 4; ++pj) { const float y = (yv[u][i][pj] + ea[u][i] * acc[u][pj][i]) * zv[u][i][pj]; yv[u][i][pj] = y; ssq += y * y; }
                ssq += __shfl_xor(ssq, 1); ssq += __shfl_xor(ssq, 2); ssq += __shfl_xor(ssq, 4); ssq += __shfl_xor(ssq, 8);
                if (fr == 0) part[(u * 8 + w) * 16 + fq * 4 + i] = ssq; }
        if (!dry) {
#pragma unroll
            for (int k = 0; k < 4; ++k) { const int q = tid + 512 * k, row = Rb + (q >> 6), c8 = (q & 63) * 8; float f[8]; const float rs = rsqrtf(rsa[k] * (1.0f / 1024.0f) + EPS);
#pragma unroll
                for (int e = 0; e < 4; ++e) { f[2 * e] = __uint_as_float(ya[k][e] << 16) * rs; f[2 * e + 1] = __uint_as_float(ya[k][e] & 0xffff0000u) * rs; }
                *(u32x4*)(Y + (size_t)row * 2048 + g * 512 + c8) = pack8(f); } }
        __syncthreads();
#pragma unroll
        for (int u = 0; u < 2; ++u)
#pragma unroll
            for (int i = 0; i < 4; ++i) { float tot = 0.f;
#pragma unroll
                for (int hh = 0; hh < 8; ++hh) tot += part[(u * 8 + hh) * 16 + fq * 4 + i];
                const float rs = rsqrtf(tot * (1.0f / 512.0f) + EPS); const int r = Rb + u * 16 + fq * 4 + i;
#pragma unroll
                for (int pj = 0; pj < 4; ++pj) Y[(size_t)r * 2048 + 1024 + h * 64 + pj * 16 + fr] = f2bf(yv[u][i][pj] * rs); }
        __syncthreads();
    }
}

__device__ __forceinline__ void phase_ynorm(const Params& p, bool dry) {
    const float* yss = (const float*)(p.ws + OFF_SS) + 2 * 8448; bf16_t* Y = (bf16_t*)(p.ws + OFF_XB); bf16_t* Yd = dry ? (bf16_t*)(p.ws + OFF_ACT) : Y;
    const int total = MROWS * 256, stride = gridDim.x * 512;
    for (int base = blockIdx.x * 512 + threadIdx.x; base < total; base += 4 * stride) {
        u32x4 v[4]; float rs[4];
#pragma unroll
        for (int j = 0; j < 4; ++j) { const int i = min(base + j * stride, total - 1); const int row = i >> 8, c8 = (i & 255) * 8, seg = c8 < 1024 ? 0 : (c8 < 1536 ? 1 : 2);
            v[j] = *(const u32x4*)(Y + (size_t)row * 2048 + c8); rs[j] = rsqrtf(yss[(size_t)row * 4 + seg] * (seg ? (1.0f / 512.0f) : (1.0f / 1024.0f)) + EPS); }
#pragma unroll
        for (int j = 0; j < 4; ++j) { const int i = base + j * stride; if (i < total) { const int row = i >> 8, c8 = (i & 255) * 8; float f[8];
            f[0] = bf2f(v[j].x & 0xffffu); f[1] = bf2f(v[j].x >> 16); f[2] = bf2f(v[j].y & 0xffffu); f[3] = bf2f(v[j].y >> 16); f[4] = bf2f(v[j].z & 0xffffu); f[5] = bf2f(v[j].z >> 16); f[6] = bf2f(v[j].w & 0xffffu); f[7] = bf2f(v[j].w >> 16);
#pragma unroll
            for (int e = 0; e < 8; ++e) f[e] *= rs[j];
            *(u32x4*)(Yd + (size_t)row * 2048 + c8) = pack8(f); } }
    }
}
__device__ __forceinline__ void phase_final(const Params& p, LAS unsigned char* lds, bool dry) {
    float* dst = dry ? (float*)(p.ws + OFF_WTIN) : p.out;
    const int tid = threadIdx.x, lane = tid & 63, wv = tid >> 6, G = gridDim.x;
    f32x4 gf[8];
#pragma unroll
    for (int j = 0; j < 8; ++j) gf[j] = *(const f32x4*)(p.g_fin + j * 256 + lane * 4);
    {
        const bf16_t* hb = (const bf16_t*)(p.ws + OFF_HB);
        const int nw = G * 8; int row = blockIdx.x * 8 + wv;
        u32x2 v[8], vn[8];
        if (row < 8192) {
#pragma unroll
            for (int j = 0; j < 8; ++j) v[j] = *(const u32x2*)(hb + (size_t)row * 2048 + j * 256 + lane * 4); }
        while (row < 8192) {
            const int rn = row + nw;
            if (rn < 8192) {
#pragma unroll
                for (int j = 0; j < 8; ++j) vn[j] = *(const u32x2*)(hb + (size_t)rn * 2048 + j * 256 + lane * 4); }
            float s = 0.f; f32x4 f[8];
#pragma unroll
            for (int j = 0; j < 8; ++j) { f[j][0] = __uint_as_float(v[j].x << 16); f[j][1] = __uint_as_float(v[j].x & 0xffff0000u); f[j][2] = __uint_as_float(v[j].y << 16); f[j][3] = __uint_as_float(v[j].y & 0xffff0000u);
                s += f[j][0] * f[j][0] + f[j][1] * f[j][1] + f[j][2] * f[j][2] + f[j][3] * f[j][3]; }
#pragma unroll
            for (int o = 32; o >= 1; o >>= 1) s += __shfl_xor(s, o);
            const float rs = rsqrtf(s * (1.0f / 2048.0f) + EPS);
#pragma unroll
            for (int j = 0; j < 8; ++j) *(f32x4*)(dst + (size_t)row * 2048 + j * 256 + lane * 4) = f[j] * rs * gf[j];
#pragma unroll
            for (int j = 0; j < 8; ++j) v[j] = vn[j];
            row = rn;
        }
    }
    LAS float* red = (LAS float*)lds;
    for (int i = blockIdx.x; i < 128; i += G) { const float* part = (const float*)(p.ws + OFF_PARTD);
        f32x4 v = *(const f32x4*)(p.out + (size_t)(8192 + i) * 2048 + tid * 4);
#pragma unroll
        for (int sg = 0; sg < 11; ++sg) v += *(const f32x4*)(part + ((size_t)sg * 128 + i) * 2048 + tid * 4);
        float s = v[0] * v[0] + v[1] * v[1] + v[2] * v[2] + v[3] * v[3];
#pragma unroll
        for (int o = 32; o >= 1; o >>= 1) s += __shfl_xor(s, o);
        if (lane == 0) red[wv] = s;
        __syncthreads();
        float tot = 0.f;
#pragma unroll
        for (int k = 0; k < 8; ++k) tot += red[k];
        const float rs = rsqrtf(tot * (1.0f / 2048.0f) + EPS);
        const f32x4 g4 = *(const f32x4*)(p.g_fin + tid * 4);
        *(f32x4*)(dst + (size_t)(8192 + i) * 2048 + tid * 4) = v * rs * g4;
        __syncthreads();
    }
}

__device__ __forceinline__ void phase_hfix(const Params& p, bool dry) {
    const int lane = threadIdx.x & 63, wv = threadIdx.x >> 6, i = blockIdx.x * 8 + wv;
    if (i < 128) { const int row = 8192 + i; bf16_t* hb = (bf16_t*)(p.ws + OFF_HB); float* hss = (float*)(p.ws + (dry ? OFF_SS2 : OFF_SS)) + 6 * 8448; const float* part = (const float*)(p.ws + OFF_PARTO); float s = 0.f;
        f32x4 hv[8];
#pragma unroll
        for (int j = 0; j < 8; ++j) { hv[j] = *(const f32x4*)(p.xs + (size_t)i * 2048 + j * 256 + lane * 4);
#pragma unroll
            for (int sg = 0; sg < 8; ++sg) hv[j] += *(const f32x4*)(part + ((size_t)sg * 128 + i) * 2048 + j * 256 + lane * 4); }
#pragma unroll
        for (int j = 0; j < 8; ++j) { const f32x4 v = hv[j]; s += v[0] * v[0] + v[1] * v[1] + v[2] * v[2] + v[3] * v[3];
            *(f32x4*)(p.out + (size_t)row * 2048 + j * 256 + lane * 4) = v;
            u32x2 o; o.x = cvt_pk_bf16(v[0], v[1]); o.y = cvt_pk_bf16(v[2], v[3]); *(u32x2*)(hb + (size_t)row * 2048 + j * 256 + lane * 4) = o; }
#pragma unroll
        for (int o = 32; o >= 1; o >>= 1) s += __shfl_xor(s, o);
        if (lane == 0) hss[row] = s; }
}

#define XB_TMO      128
#define XB_XCNT(j)  (256  + 64 * (j))
#define XB_XSUB(j)  (1280 + 64 * (j))
#define XB_XGEN(j)  (2304 + 64 * (j))
#define XB_TOP      3328
#define XB_TOPGEN   3392
#define XCD_BAR_WORDS 3456
#define XB_SPIN_CAP (1u << 18)

__device__ __forceinline__ unsigned xb_ld(unsigned* p)              { return __hip_atomic_load(p, __ATOMIC_RELAXED, __HIP_MEMORY_SCOPE_AGENT); }
__device__ __forceinline__ unsigned xb_add(unsigned* p, unsigned v) { return __hip_atomic_fetch_add(p, v, __ATOMIC_RELAXED, __HIP_MEMORY_SCOPE_AGENT); }
__device__ __forceinline__ unsigned xb_xcc_id() { return (unsigned)__builtin_amdgcn_s_getreg((3 << 11) | 20) & 0xFu; }
#define XB_SPIN(cond, bar) do { unsigned _sp = 0; while (cond) { __builtin_amdgcn_s_sleep(1); \
    if ((++_sp & 255u) == 0u) { if (xb_ld(&(bar)[XB_TMO])) break; if (_sp > XB_SPIN_CAP) { atomicAdd(&(bar)[XB_TMO], 1u); break; } } } } while (0)

struct XcdBarrier {
    unsigned* bar; unsigned x;
    volatile __attribute__((address_space(3))) unsigned* st;
};

__device__ __forceinline__ XcdBarrier xcd_barrier_post(unsigned* bar, volatile __attribute__((address_space(3))) unsigned* st) {
    XcdBarrier b; b.bar = bar; b.x = xb_xcc_id(); b.st = st;
    if (threadIdx.x == 0) (void)xb_add(&bar[XB_XCNT(b.x)], 1u);
    return b;
}
__device__ __forceinline__ void xcd_barrier_complete(unsigned* bar, unsigned x, unsigned& nloc, unsigned& nx) {
    const unsigned G = gridDim.x * gridDim.y * gridDim.z;
    unsigned sum, cnt, mine, sp = 0u;
    for (;;) {
        sum = 0u; cnt = 0u; mine = 0u;
#pragma unroll
        for (unsigned j = 0; j < 16; ++j) { const unsigned c = xb_ld(&bar[XB_XCNT(j)]); sum += c; cnt += (c > 0u) ? 1u : 0u; mine = (j == x) ? c : mine; }
        if (sum == G) break;
        __builtin_amdgcn_s_sleep(1);
        if ((++sp & 255u) == 0u) { if (xb_ld(&bar[XB_TMO])) break; if (sp > XB_SPIN_CAP) { atomicAdd(&bar[XB_TMO], 1u); break; } }
    }
    nloc = mine > 0u ? mine : 1u; nx = cnt > 0u ? cnt : 1u;
}

__device__ __forceinline__ void xcd_barrier(const XcdBarrier& b) {
    asm volatile("s_waitcnt vmcnt(0)" ::: "memory");
    __syncthreads();
    if (threadIdx.x == 0) {
        unsigned* bar = b.bar;
        __builtin_amdgcn_s_waitcnt(0);
        unsigned nloc = b.st[0], nx = b.st[1];
        if (nloc == 0u) { xcd_barrier_complete(bar, b.x, nloc, nx); b.st[0] = nloc; b.st[1] = nx; }
        const unsigned old = xb_add(&bar[XB_XSUB(b.x)], 1u);
        const unsigned gen = old / nloc;
        if (old + 1u == (gen + 1u) * nloc) {
            __builtin_amdgcn_fence(__ATOMIC_RELEASE, "agent");
            asm volatile("s_waitcnt vmcnt(0)" ::: "memory");
            const unsigned og = xb_add(&bar[XB_TOP], 1u);
            const unsigned tg = og / nx;
            if (og + 1u == (tg + 1u) * nx) xb_add(&bar[XB_TOPGEN], 1u);
            else XB_SPIN(xb_ld(&bar[XB_TOPGEN]) == tg, bar);
            __builtin_amdgcn_fence(__ATOMIC_ACQUIRE, "agent");
            xb_add(&bar[XB_XGEN(b.x)], 1u);
            asm volatile("s_waitcnt vmcnt(0)" ::: "memory");
        } else {
            XB_SPIN(xb_ld(&bar[XB_XGEN(b.x)]) == gen, bar);
            __builtin_amdgcn_fence(__ATOMIC_ACQUIRE, "agent");
            asm volatile("s_waitcnt vmcnt(0)" ::: "memory");
        }
    }
    __syncthreads();
}

__global__ void __launch_bounds__(512, 2) mega(Params p) {
    extern __shared__ __attribute__((aligned(16))) unsigned char lds_raw[];
    LAS unsigned char* lds = (LAS unsigned char*)lds_raw;
    unsigned char* ws = p.ws; float* ss = (float*)(ws + OFF_SS);
    volatile LAS unsigned* bst = (volatile LAS unsigned*)(lds + LDS_BAR_OFF);
    if (threadIdx.x < 4) bst[threadIdx.x] = 0u;
    __syncthreads();
    if (p.ph_hi > 1000) cg::this_grid().sync();
    const XcdBarrier bar = xcd_barrier_post((unsigned*)(ws + OFF_CTL), bst);
#ifndef PHMASK
#define PHMASK 0x3ff
#endif
#define PH_ON(k) ((PHMASK >> (k)) & 1) && p.ph_lo <= (k) && (k) < p.ph_hi
#define PH_SYNC(k) if (p.ph_lo <= (k) && (k) + 1 < p.ph_hi) xcd_barrier(bar);
#ifdef REPMASK
#define REPLOOP(k) for (int rep = ((REPMASK >> (k)) & 1) ? ((p.repmask >> (k)) & 1) : 0; rep >= 0; --rep)
#else
#define REPLOOP(k) for (int rep = 0; rep >= 0; --rep)
#endif
#define REPBAR if (rep) xcd_barrier(bar);
    if (PH_ON(0)) REPLOOP(0) { phase_prep(p, lds); REPBAR }
    PH_SYNC(0)
    if (PH_ON(1)) REPLOOP(1) { pg8::Gemm g; g.A = (const bf16_t*)(ws + OFF_XB); g.Bt = (const bf16_t*)(ws + OFF_WTIN); g.M = MPAD; g.N = 4864; g.K = 2048; g.ld = 2048;
        pg8::StaticOrder S; S.init(MPAD, 4864, (int)gridDim.x, (int)blockIdx.x, 2048);
        EpiProj E; E.proj = (bf16_t*)(ws + OFF_PROJ); E.dt = (float*)(ws + OFF_DT); E.xss = ss; E.vss = (float*)(ws + (rep ? OFF_SS2 : OFF_SS)) + 8448;
        pg8::gemm_phase<EpiProj, pg8::StaticOrder, false>(lds, g, S, E, nullptr);
        if (!rep && blockIdx.x >= 115) wt_convert(p, lds, 1184, 4512, (int)blockIdx.x - 115, (int)gridDim.x - 115);
        REPBAR }
    PH_SYNC(1)
    if (PH_ON(2)) REPLOOP(2) { phase_conv(p, lds); xcd_barrier(bar); phase_mixer(p, lds, rep != 0); REPBAR }
    PH_SYNC(2)
    if (PH_ON(3)) REPLOOP(3) { phase_scan(p, rep != 0); REPBAR }
    PH_SYNC(3)
    if (PH_ON(4)) REPLOOP(4) { phase_combine(p, lds, rep != 0); REPBAR }
    PH_SYNC(4)
    if (PH_ON(6)) REPLOOP(6) { pg8::Gemm g; g.A = (const bf16_t*)(ws + OFF_XB); g.Bt = (const bf16_t*)(ws + OFF_WTOUT); g.M = MPAD; g.N = 2048; g.K = 2048; g.ld = 2048;
        OutOrder S; S.c = (int)blockIdx.x;
        EpiOut E; E.xp = p.xp; E.xs = p.xs; E.hout = p.out; E.hb = (bf16_t*)(ws + OFF_HB); E.part = (float*)(ws + OFF_PARTO); E.hss = (float*)(ws + (rep ? OFF_SS2 : OFF_SS)) + 6 * 8448;
        pg8::gemm_phase<EpiOut, OutOrder, false>(lds, g, S, E, nullptr); REPBAR }
    PH_SYNC(6)
    if (PH_ON(7)) REPLOOP(7) { pg8::Gemm g; g.A = (const bf16_t*)(ws + OFF_HB); g.Bt = (const bf16_t*)(ws + OFF_WTGU); g.M = MPAD; g.N = 11264; g.K = 2048; g.ld = 2048;
        unsigned* hflag = (unsigned*)(ws + OFF_CTL + 15360);
        if (blockIdx.x < 16) { phase_hfix(p, false); __threadfence(); __syncthreads(); if (threadIdx.x == 0) __hip_atomic_fetch_add(hflag, 1u, __ATOMIC_RELAXED, __HIP_MEMORY_SCOPE_AGENT); }
        GuDepOrder S; S.init(MPAD, 11264, (int)gridDim.x, (int)blockIdx.x, 2048); S.flag = hflag;
        EpiGU E; E.act = (bf16_t*)(ws + OFF_ACT); E.hss = ss + 6 * 8448;
        pg8::gemm_phase<EpiGU, GuDepOrder, false>(lds, g, S, E, nullptr);
        if (!rep && blockIdx.x >= 172) wt_convert(p, lds, 4512, 5920, (int)blockIdx.x - 172, (int)gridDim.x - 172);
        REPBAR }
    PH_SYNC(7)
    if (PH_ON(8)) REPLOOP(8) { pg8::Gemm g; g.A = (const bf16_t*)(ws + OFF_ACT); g.Bt = (const bf16_t*)(ws + OFF_WTDN); g.M = MPAD; g.N = 2048; g.K = 5632; g.ld = LD_DN;
        DownOrder S; S.c = (int)blockIdx.x;
        EpiDown E; E.hb = (bf16_t*)(ws + OFF_HB); E.hdst = rep ? (float*)(ws + OFF_WTIN) : p.out; E.part = (float*)(ws + OFF_PARTD);
        pg8::gemm_phase<EpiDown, DownOrder, false>(lds, g, S, E, nullptr); REPBAR }
    PH_SYNC(8)
    if (PH_ON(9)) REPLOOP(9) { phase_final(p, lds, rep != 0); REPBAR }
}

#ifndef N_LAUNCHES
#define N_LAUNCHES 1
#endif
extern "C" void kernel_launch(void* const* d_in, const int* in_sizes, int n_in, void* d_out, int out_size, void* d_ws, size_t ws_size, hipStream_t stream) {
    static int grid = 0;
    if (grid == 0) {
        if (n_in != 22 || ws_size < WS_NEED) { fprintf(stderr, "kernel_launch: bad inputs n_in %d ws %zu need %zu\n", n_in, ws_size, (size_t)WS_NEED); grid = -1; return; }
        int dev = 0, cus = 0, per_cu = 0;
        (void)hipGetDevice(&dev); (void)hipDeviceGetAttribute(&cus, hipDeviceAttributeMultiprocessorCount, dev);
        if (hipFuncSetAttribute((const void*)mega, hipFuncAttributeMaxDynamicSharedMemorySize, LDS_BYTES) != hipSuccess) { fprintf(stderr, "kernel_launch: hipFuncSetAttribute failed\n"); grid = -1; return; }
        if (hipOccupancyMaxActiveBlocksPerMultiprocessor(&per_cu, (const void*)mega, 512, LDS_BYTES) != hipSuccess || per_cu < 1) { fprintf(stderr, "kernel_launch: occupancy query says %d\n", per_cu); per_cu = 1; }
        (void)hipGetLastError();
        grid = cus > 0 ? cus : 256;
    }
    if (grid < 0) return;
    if (hipMemsetAsync((char*)d_ws + OFF_CTL, 0, 16384, stream) != hipSuccess) { fprintf(stderr, "kernel_launch: memset failed\n"); return; }
    Params p{};
    const float** pin = (const float**)&p;
    for (int i = 0; i < 22; ++i) pin[i] = (const float*)d_in[i];
    p.out = (float*)d_out; p.ws = (unsigned char*)d_ws;
#ifdef REPMASK
    p.repmask = REPMASK;
#endif
#if N_LAUNCHES == 1
    p.ph_lo = 0; p.ph_hi = NPHASE;
    void* args[] = {&p};
    hipError_t e = hipLaunchCooperativeKernel((const void*)mega, dim3(grid), dim3(512), args, LDS_BYTES, stream);
    if (e != hipSuccess) fprintf(stderr, "cooperative launch failed: %s (grid %d)\n", hipGetErrorString(e), grid);
#else
    for (int ph = 0; ph < NPHASE; ++ph) { p.ph_lo = ph; p.ph_hi = ph + 1; hipLaunchKernelGGL(mega, dim3(grid), dim3(512), LDS_BYTES, stream, p); }
#endif
}
```

```cpp
#include <hip/hip_runtime.h>
#include <hip/hip_cooperative_groups.h>
#include <cstdio>
namespace cg = cooperative_groups;
namespace pg8 {
#define PG8_LAS __attribute__((address_space(3)))
typedef unsigned short bf16_t;
typedef short bf16x8 __attribute__((ext_vector_type(8)));
typedef float f32x4 __attribute__((ext_vector_type(4)));
typedef unsigned u32x4 __attribute__((ext_vector_type(4)));
constexpr int BM = 256, BK = 64, HALF = 128, HTB = HALF * BK * 2  , STAGE_BYTES = 8 * HTB, NXCD = 8, WGM = 8;

__host__ __device__ __forceinline__ int lds_byte(int r, int c) { const int st = (r >> 4) * 2 + (c >> 5), rr = r & 15, cc = c & 31, ob = rr * 64 + cc * 2; return st * 1024 + (ob ^ (((ob >> 9) & 1) << 5)); }
__host__ __device__ __forceinline__ void stage_rc(int b, int& R, int& C) { const int st = b / 1024, sb = b % 1024, swz = sb ^ (((sb >> 9) & 1) << 5); R = (st >> 1) * 16 + swz / 64; C = (st & 1) * 32 + (swz % 64) / 2; }
__host__ __device__ __forceinline__ int perm32(int rho) { const int n = rho >> 4, i = rho & 15; return 8 * (i >> 2) + 4 * n + (i & 3); }

struct Unit { int pm, pn, k0, nk; };
struct Gemm { const bf16_t* A; const bf16_t* Bt; int M, N, K, ld; };

struct StaticOrder {
    int nM, nN, nwg, G, c, ntk;
    __host__ __device__ void init(int M, int N, int G_, int c_, int K_) { nM = M / BM; nN = N / BM; nwg = nM * nN; G = G_; c = c_; ntk = K_ / BK; }
    __host__ __device__ bool next(int i, Unit& u) const {
        const long L = (long)i * G + c; if (L >= nwg) return false;
        int wgid = (int)L; { const int q = nwg / NXCD, r = nwg % NXCD, xcd = wgid % NXCD, off = wgid / NXCD; wgid = (xcd < r ? xcd * (q + 1) : r * (q + 1) + (xcd - r) * q) + off; }
        const int nig = WGM * nN, gid = wgid / nig, fm = gid * WGM, gsz = (nM - fm) < WGM ? (nM - fm) : WGM;
        u.pm = fm + ((wgid % nig) % gsz); u.pn = (wgid % nig) / gsz; u.k0 = 0; u.nk = ntk; return true;
    }
    __device__ __forceinline__ void a_ready(const Unit&) const {}
    __device__ __forceinline__ void done(const Unit&) const {}
};
__device__ __forceinline__ unsigned cvt_pk_bf16(float lo, float hi) { unsigned r; asm volatile("v_cvt_pk_bf16_f32 %0, %1, %2" : "=v"(r) : "v"(lo), "v"(hi)); return r; }

template <class Epi, class Sched, bool STAMP = false>
__device__ __forceinline__ void gemm_phase(PG8_LAS unsigned char* lds, const Gemm g, const Sched& S, const Epi& E, unsigned long long* stamps) {
    int tid_ = threadIdx.x; asm volatile("" : "+v"(tid_));
    const int tid = tid_, wid = __builtin_amdgcn_readfirstlane(tid >> 6), lane = tid & 63, wr = wid >> 2, wc = wid & 3, fr = lane & 15, fq = lane >> 4;
    const int K = g.ld;
    int ts_lo = 0, ts_hi = 0, nts = 0; const unsigned long long rt_entry = STAMP ? (unsigned long long)wall_clock64() : 0ull;
#define PG8_STAMP() do { if (STAMP && wid == 0 && nts < 64) { const unsigned long long _c = (unsigned long long)clock64(); \
        ts_lo = (lane == nts) ? (int)(unsigned)_c : ts_lo; ts_hi = (lane == nts) ? (int)(unsigned)(_c >> 32) : ts_hi; ++nts; } } while (0)
    PG8_STAMP();
    unsigned voffA[2], voffB[2];
#pragma unroll
    for (int i = 0; i < 2; ++i) { int R, C; stage_rc(tid * 16 + i * 8192, R, C); const int Rb = Epi::PERM ? ((R & ~31) + perm32(R & 31)) : R;
        voffA[i] = (unsigned)(R * K + C) * 2u; voffB[i] = (unsigned)(Rb * K + C) * 2u; }
    const size_t kstep = (size_t)(BK * 2);
    const size_t hstep = (size_t)HALF * K * 2;
    const size_t tstep = 2 * hstep;
    const unsigned ldsw = (unsigned)wid * 1024u;
    const int aoff = lds_byte(wr * 64 + fr, fq * 8), boff = lds_byte(wc * 32 + fr, fq * 8);
#define PG8_SA(b, h) (((b) * 2 + (h)) * HTB)
#define PG8_SB(b, h) ((4 + (b) * 2 + (h)) * HTB)
#define PG8_STAGE(bufoff, gbase, voff) do { _Pragma("unroll") for (int _i = 0; _i < 2; ++_i) \
        __builtin_amdgcn_global_load_lds((const unsigned*)((const char*)(gbase) + (voff)[_i]), (PG8_LAS unsigned*)(lds + (bufoff) + ldsw + _i * 8192), 16, 0, 0); } while (0)
#define PG8_LDA(dst, b, h) do { _Pragma("unroll") for (int m = 0; m < 4; ++m) _Pragma("unroll") for (int k = 0; k < 2; ++k) dst[m][k] = *(const PG8_LAS bf16x8*)(lds + PG8_SA(b, h) + aoff + m * 2048 + k * 1024); } while (0)
#define PG8_LDB(dst, b, h) do { _Pragma("unroll") for (int n = 0; n < 2; ++n) _Pragma("unroll") for (int k = 0; k < 2; ++k) dst[n][k] = *(const PG8_LAS bf16x8*)(lds + PG8_SB(b, h) + boff + n * 2048 + k * 1024); } while (0)
#define PG8_MMA(ai, bj, At, Bt) do { __builtin_amdgcn_s_setprio(1); _Pragma("unroll") for (int m = 0; m < 4; ++m) _Pragma("unroll") for (int n = 0; n < 2; ++n) _Pragma("unroll") for (int k = 0; k < 2; ++k) \
        acc[ai][bj][m][n] = __builtin_amdgcn_mfma_f32_16x16x32_bf16(Bt[n][k], At[m][k], acc[ai][bj][m][n], 0, 0, 0); __builtin_amdgcn_s_setprio(0); } while (0)
#define PG8_WAIT_V(n) asm volatile("s_waitcnt vmcnt(" #n ")" ::: "memory")
#define PG8_WAIT_L(n) asm volatile("s_waitcnt lgkmcnt(" #n ")" ::: "memory")
#define PG8_BAR __builtin_amdgcn_s_barrier()
#define PG8_SCHED __builtin_amdgcn_sched_barrier(0)
    Unit cur, nxt; int ui = 0;
    if (!S.next(0, cur)) return;
    f32x4 acc[2][2][4][2];
#pragma unroll
    for (int a = 0; a < 2; ++a)
#pragma unroll
        for (int b = 0; b < 2; ++b)
#pragma unroll
            for (int m = 0; m < 4; ++m)
#pragma unroll
                for (int n = 0; n < 2; ++n) acc[a][b][m][n] = (f32x4){0.f, 0.f, 0.f, 0.f};
    bf16x8 At[4][2], B0[2][2], B1[2][2];
    const char* cA = (const char*)g.A + (size_t)cur.pm * tstep + (size_t)cur.k0 * kstep; const char* cB = (const char*)g.Bt + (size_t)cur.pn * tstep + (size_t)cur.k0 * kstep;
    S.a_ready(cur);
    float pre8[8]; E.prefetch(cur, wr, fr, pre8);
    PG8_STAGE(PG8_SB(0, 0), cB, voffB); PG8_STAGE(PG8_SA(0, 0), cA, voffA); PG8_STAGE(PG8_SB(0, 1), cB + hstep, voffB); PG8_STAGE(PG8_SA(0, 1), cA + hstep, voffA);
    if (wr == 1) PG8_BAR;
    PG8_WAIT_V(4); PG8_BAR;
    PG8_STAGE(PG8_SB(1, 0), cB + kstep, voffB); PG8_STAGE(PG8_SA(1, 0), cA + kstep, voffA); PG8_STAGE(PG8_SB(1, 1), cB + hstep + kstep, voffB);
    PG8_WAIT_V(6); PG8_BAR;
    PG8_STAMP();
    for (;;) {
        const bool has_next = S.next(ui + 1, nxt);
        const char* nA = has_next ? (const char*)g.A + (size_t)nxt.pm * tstep + (size_t)nxt.k0 * kstep : cA; const char* nB = has_next ? (const char*)g.Bt + (size_t)nxt.pn * tstep + (size_t)nxt.k0 * kstep : cB;
        const int nt = cur.nk;
        for (int t = 0; t < nt; t += 2) {
            const bool last = (t == nt - 2);
            const char* a1 = cA + (size_t)(t + 1) * kstep;
            const char* a2 = last ? nA : cA + (size_t)(t + 2) * kstep; const char* b2 = last ? nB : cB + (size_t)(t + 2) * kstep;
            const char* a3 = a2 + kstep; const char* b3 = b2 + kstep;
            if (last && has_next) S.a_ready(nxt);
            PG8_LDB(B0, 0, 0); PG8_SCHED; PG8_LDA(At, 0, 0); PG8_STAGE(PG8_SA(1, 1), a1 + hstep, voffA);
            PG8_WAIT_L(8); PG8_BAR; PG8_WAIT_L(0); PG8_MMA(0, 0, At, B0); PG8_BAR; PG8_SCHED;
            PG8_LDB(B1, 0, 1); PG8_STAGE(PG8_SB(0, 0), b2, voffB);
            PG8_BAR; PG8_WAIT_L(0); PG8_MMA(0, 1, At, B1); PG8_BAR;
            PG8_LDA(At, 0, 1); PG8_STAGE(PG8_SA(0, 0), a2, voffA);
            PG8_BAR; PG8_WAIT_L(0); PG8_MMA(1, 0, At, B0); PG8_BAR; PG8_SCHED;
            PG8_STAGE(PG8_SB(0, 1), b2 + hstep, voffB);
            PG8_WAIT_V(6); PG8_BAR; PG8_MMA(1, 1, At, B1); PG8_BAR;
            PG8_LDB(B0, 1, 0); PG8_SCHED; PG8_LDA(At, 1, 0); PG8_STAGE(PG8_SA(0, 1), a2 + hstep, voffA);
            PG8_WAIT_L(8); PG8_BAR; PG8_WAIT_L(0); PG8_MMA(0, 0, At, B0); PG8_BAR; PG8_SCHED;
            PG8_LDB(B1, 1, 1); PG8_STAGE(PG8_SB(1, 0), b3, voffB);
            PG8_BAR; PG8_WAIT_L(0); PG8_MMA(0, 1, At, B1); PG8_BAR;
            PG8_LDA(At, 1, 1); PG8_STAGE(PG8_SA(1, 0), a3, voffA);
            PG8_BAR; PG8_WAIT_L(0); PG8_MMA(1, 0, At, B0); PG8_BAR; PG8_SCHED;
            PG8_STAGE(PG8_SB(1, 1), b3 + hstep, voffB);
            PG8_WAIT_V(6); PG8_BAR; PG8_MMA(1, 1, At, B1); PG8_BAR;
        }
        PG8_STAMP();
        if constexpr (!Epi::AFTER_DRAIN) { E(acc, cur, wr, wc, fr, fq, pre8); S.done(cur); }
        PG8_STAMP();
        if (!has_next) break;
#pragma unroll
        for (int a = 0; a < 2; ++a)
#pragma unroll
            for (int b = 0; b < 2; ++b)
#pragma unroll
                for (int m = 0; m < 4; ++m)
#pragma unroll
                    for (int n = 0; n < 2; ++n) acc[a][b][m][n] = (f32x4){0.f, 0.f, 0.f, 0.f};
        cur = nxt; cA = nA; cB = nB; ++ui; E.prefetch(cur, wr, fr, pre8);
    }
    PG8_WAIT_V(0);
    if (wr == 0) PG8_BAR;
    PG8_BAR;
    if constexpr (Epi::AFTER_DRAIN) { E.fused(acc, cur, wr, wc, fr, fq, lds, wid, lane); S.done(cur); }
    PG8_STAMP();
    if (STAMP && wid == 0) { stamps[lane] = lane < nts ? (((unsigned long long)(unsigned)ts_hi << 32) | (unsigned)ts_lo) : 0ull;
        if (lane == 62) stamps[62] = rt_entry; if (lane == 63) stamps[63] = (unsigned long long)wall_clock64(); }
#undef PG8_STAMP
#undef PG8_SA
#undef PG8_SB
#undef PG8_STAGE
#undef PG8_LDA
#undef PG8_LDB
#undef PG8_MMA
#undef PG8_WAIT_V
#undef PG8_WAIT_L
#undef PG8_BAR
#undef PG8_SCHED
}
}

#define LAS __attribute__((address_space(3)))
using pg8::bf16_t; using pg8::bf16x8; using pg8::f32x4; using pg8::u32x4; using pg8::cvt_pk_bf16;
typedef unsigned u32x2 __attribute__((ext_vector_type(2)));

constexpr float EPS = 1e-6f;
constexpr int MROWS = 8320, MPAD = 8448;
constexpr int LDS_BAR_OFF = 157696;
constexpr int LDS_BYTES = LDS_BAR_OFF + 256;
constexpr int NPHASE = 10;
constexpr int LD_DN = 5632 + 64;

constexpr size_t OFF_WTIN = 0;
constexpr size_t OFF_WTOUT = OFF_WTIN + 4864ull * 2048 * 2;
constexpr size_t OFF_WTGU = OFF_WTOUT + 2048ull * 2048 * 2;
constexpr size_t OFF_WTDN = OFF_WTGU + 11264ull * 2048 * 2;
constexpr size_t OFF_SS = OFF_WTDN + 2048ull * LD_DN * 2;
constexpr size_t OFF_CTL = OFF_SS + 8448ull * 8 * 4;
constexpr size_t OFF_EAL = OFF_CTL + 16384;
constexpr size_t OFF_XB = OFF_EAL + 4096;
constexpr size_t OFF_C = OFF_XB + 8448ull * 2048 * 2;
constexpr size_t OFF_PROJ = OFF_C;
constexpr size_t OFF_DT = OFF_PROJ + 8448ull * 4608 * 2;
constexpr size_t OFF_STATES = OFF_DT + 8448ull * 16 * 4;
constexpr size_t OFF_HPREV = OFF_STATES + 64ull * 16 * 8192 * 4;
constexpr size_t OFF_YD = OFF_HPREV + 64ull * 16 * 8192 * 2;
constexpr size_t OFF_CC = OFF_YD + 8192ull * 1024 * 4;
constexpr size_t OFF_EAC = OFF_CC + 8192ull * 256 * 2;
constexpr size_t OFF_BN = OFF_EAC + 8192ull * 16 * 4;
constexpr size_t OFF_BTT = OFF_BN + 8192ull * 256 * 2;
constexpr size_t OFF_FA = OFF_BTT + 64ull * 256 * 128 * 2;
constexpr size_t OFF_FD = OFF_FA + 1024ull * 128 * 4;
constexpr size_t OFF_FW = OFF_FD + 1024ull * 128 * 4;
constexpr size_t END_C1 = OFF_FW + 1024ull * 128 * 4;
constexpr size_t OFF_XT = OFF_HPREV;
constexpr size_t OFF_HB = OFF_C;
constexpr size_t OFF_ACT = OFF_HB + 8448ull * 2048 * 2;
constexpr size_t END_C2 = OFF_ACT + 8448ull * LD_DN * 2;
constexpr size_t OFF_PARTO = OFF_ACT;
constexpr size_t OFF_PARTD = OFF_WTIN;
constexpr size_t OFF_SS2 = END_C1 > END_C2 ? END_C1 : END_C2;
constexpr size_t WS_NEED = OFF_SS2 + 8448ull * 8 * 4;

constexpr size_t O_Y = 0, O_CONVP = 17039360, O_SSMP = 17057792, O_CONVS = 17582080, O_SSMS = 18171904, O_VS = 34949120;

struct Params {
    const float* xp; const float* xs; const float* sconv; const float* sssm; const float* g_mix; const float* w_in; const float* g_cv; const float* w_s; const float* b_s;
    const float* g_co; const float* conv_w; const float* conv_b; const float* dt_bias; const float* a_log; const float* dvec; const float* g_sn; const float* w_out;
    const float* g_ffn; const float* w_gate; const float* w_up; const float* w_down; const float* g_fin;
    float* out; unsigned char* ws; int ph_lo, ph_hi; int repmask, pad;
};

__device__ __forceinline__ float bf2f(unsigned v) { return __uint_as_float(v << 16); }
__device__ __forceinline__ bf16_t f2bf(float x) { return (bf16_t)(cvt_pk_bf16(x, x) & 0xffffu); }
__device__ __forceinline__ float sigmoid_f(float x) { return __builtin_amdgcn_rcpf(1.0f + __expf(-x)); }
__device__ __forceinline__ float silu_f(float x) { return x * sigmoid_f(x); }
__device__ __forceinline__ float gelu_f(float x) { return x * sigmoid_f(1.5957691216f * (x + 0.044715f * x * x * x)); }
__device__ __forceinline__ float softplus_f(float x) { return x > 20.f ? x : log1pf(expf(x)); }
__device__ __forceinline__ f32x4 mfma16(bf16x8 a, bf16x8 b, f32x4 c) { return __builtin_amdgcn_mfma_f32_16x16x32_bf16(a, b, c, 0, 0, 0); }
__device__ __forceinline__ u32x4 pack8(const float* v) { u32x4 o; o.x = cvt_pk_bf16(v[0], v[1]); o.y = cvt_pk_bf16(v[2], v[3]); o.z = cvt_pk_bf16(v[4], v[5]); o.w = cvt_pk_bf16(v[6], v[7]); return o; }

struct EpiProj {
    static constexpr bool PERM = true, AFTER_DRAIN = false;
    bf16_t* proj; float* dt; const float* xss; float* vss;
    __device__ __forceinline__ void prefetch(const pg8::Unit& u, int wr, int fr, float (&pre)[8]) const {
#pragma unroll
        for (int q = 0; q < 8; ++q) pre[q] = xss[u.pm * 256 + wr * 64 + fr + (q >> 2) * 128 + (q & 3) * 16]; }
    __device__ __forceinline__ void operator()(const f32x4 (&acc)[2][2][4][2], const pg8::Unit& u, int wr, int wc, int fr, int fq, const float (&pre)[8]) const {
        const int row0 = u.pm * 256 + wr * 64 + fr, pn = u.pn;
        float rs8[2][4];
#pragma unroll
        for (int ai = 0; ai < 2; ++ai)
#pragma unroll
            for (int m = 0; m < 4; ++m) rs8[ai][m] = rsqrtf(pre[ai * 4 + m] * (1.0f / 2048.0f) + EPS);
        if (pn == 18) {
            if (wc == 0 && fq < 2) {
#pragma unroll
                for (int ai = 0; ai < 2; ++ai)
#pragma unroll
                    for (int m = 0; m < 4; ++m) { const int row = row0 + ai * 128 + m * 16; const float rs = rs8[ai][m];
                        float* d = dt + (size_t)row * 16 + fq * 8; *(f32x4*)d = acc[ai][0][m][0] * rs; *(f32x4*)(d + 4) = acc[ai][0][m][1] * rs; }
            }
            return;
        }
        const int kind = pn < 4 ? 0 : pn < 8 ? 1 : pn < 12 ? 2 : 3;
        const int col0 = pn * 256 + wc * 32 + 8 * fq;
#pragma unroll
        for (int ai = 0; ai < 2; ++ai)
#pragma unroll
            for (int m = 0; m < 4; ++m) { const int row = row0 + ai * 128 + m * 16; const float rs = rs8[ai][m]; float ssq = 0.f;
#pragma unroll
                for (int bj = 0; bj < 2; ++bj) { float v[8];
#pragma unroll
                    for (int j = 0; j < 4; ++j) { v[j] = acc[ai][bj][m][0][j] * rs; v[4 + j] = acc[ai][bj][m][1][j] * rs; }
                    if (kind <= 1) {
#pragma unroll
                        for (int j = 0; j < 8; ++j) v[j] = gelu_f(v[j]);
                    } else if (kind == 2) {
#pragma unroll
                        for (int j = 0; j < 8; ++j) v[j] = silu_f(v[j]);
                    }
                    if (kind == 1) {
#pragma unroll
                        for (int j = 0; j < 8; ++j) ssq += v[j] * v[j];
                    }
                    *(u32x4*)(proj + (size_t)row * 4608 + col0 + bj * 128) = pack8(v); }
                if (kind == 1) { ssq += __shfl_xor(ssq, 16); ssq += __shfl_xor(ssq, 32); if (fq == 0) unsafeAtomicAdd(vss + row, ssq); }
            }
    }
};
struct EpiOut {
    static constexpr bool PERM = false, AFTER_DRAIN = false;
    const float* xp; const float* xs; float* hout; bf16_t* hb; float* hss; float* part;
    __device__ __forceinline__ void prefetch(const pg8::Unit&, int, int, float (&)[8]) const {}
    __device__ __forceinline__ void operator()(const f32x4 (&acc)[2][2][4][2], const pg8::Unit& u, int wr, int wc, int fr, int fq, const float (&pre)[8]) const {
        const int row0 = u.pm * 256 + wr * 64 + fr, col0 = u.pn * 256 + wc * 32 + 4 * fq;
        if (u.nk < 32) {
            float* pp = part + ((size_t)(u.k0 >> 2) * 128 + (wr * 64 + fr)) * 2048 + col0;
#pragma unroll
            for (int m = 0; m < 4; ++m)
#pragma unroll
                for (int bj = 0; bj < 2; ++bj)
#pragma unroll
                    for (int n = 0; n < 2; ++n) *(f32x4*)(pp + (size_t)m * 16 * 2048 + bj * 128 + n * 16) = acc[0][bj][m][n];
            return;
        }
#pragma unroll
        for (int am = 0; am < 4; ++am) { const int ai = am >> 1, mb = (am & 1) * 2;
            f32x4 xv[2][2][2];
#pragma unroll
            for (int mm = 0; mm < 2; ++mm) { const int row = row0 + ai * 128 + (mb + mm) * 16; const float* xr = xp + (size_t)row * 2048 + col0;
#pragma unroll
                for (int bj = 0; bj < 2; ++bj)
#pragma unroll
                    for (int n = 0; n < 2; ++n) xv[mm][bj][n] = *(const f32x4*)(xr + bj * 128 + n * 16); }
#pragma unroll
            for (int mm = 0; mm < 2; ++mm)
#pragma unroll
                for (int bj = 0; bj < 2; ++bj)
#pragma unroll
                    for (int n = 0; n < 2; ++n) asm volatile("" : "+v"(xv[mm][bj][n]));
#pragma unroll
            for (int mm = 0; mm < 2; ++mm) { const int m = mb + mm; const int row = row0 + ai * 128 + m * 16; float ssq = 0.f;
#pragma unroll
                for (int bj = 0; bj < 2; ++bj)
#pragma unroll
                    for (int n = 0; n < 2; ++n) { const f32x4 hv = xv[mm][bj][n] + acc[ai][bj][m][n];
                        ssq += hv[0] * hv[0] + hv[1] * hv[1] + hv[2] * hv[2] + hv[3] * hv[3];
                        u32x2 o; o.x = cvt_pk_bf16(hv[0], hv[1]); o.y = cvt_pk_bf16(hv[2], hv[3]); *(u32x2*)(hb + (size_t)row * 2048 + col0 + bj * 128 + n * 16) = o; }
                ssq += __shfl_xor(ssq, 16); ssq += __shfl_xor(ssq, 32); if (fq == 0) unsafeAtomicAdd(hss + row, ssq);
            }
        }
    }
};
struct OutOrder {
    int c;
    __device__ __forceinline__ bool next(int i, pg8::Unit& u) const {
        if (i == 0) { const int x = c & 7, j = c >> 3; u.pm = 4 * x + (j >> 3); u.pn = j & 7; u.k0 = 0; u.nk = 32; return true; }
        if (i == 1 && c < 64) { u.pm = 32; u.pn = c >> 3; u.k0 = (c & 7) * 4; u.nk = 4; return true; }
        return false;
    }
    __device__ __forceinline__ void a_ready(const pg8::Unit&) const {}
    __device__ __forceinline__ void done(const pg8::Unit&) const {}
};
struct GuDepOrder : pg8::StaticOrder {
    const unsigned* flag;
    __device__ __forceinline__ void a_ready(const pg8::Unit& u) const {
        if (u.pm == 32) {
            if (threadIdx.x < 64) { unsigned spins = 0;
                while ((unsigned)__builtin_amdgcn_readfirstlane(__hip_atomic_load(flag, __ATOMIC_RELAXED, __HIP_MEMORY_SCOPE_AGENT)) < 16u && ++spins < (1u << 20)) __builtin_amdgcn_s_sleep(2);
                __builtin_amdgcn_fence(__ATOMIC_ACQUIRE, "agent");
                asm volatile("s_waitcnt vmcnt(0)" ::: "memory"); }
            asm volatile("" ::: "memory"); __builtin_amdgcn_s_barrier(); asm volatile("" ::: "memory");
        }
    }
};
struct EpiGU {
    static constexpr bool PERM = true, AFTER_DRAIN = false;
    bf16_t* act; const float* hss;
    __device__ __forceinline__ void prefetch(const pg8::Unit& u, int wr, int fr, float (&pre)[8]) const {
#pragma unroll
        for (int q = 0; q < 8; ++q) pre[q] = hss[u.pm * 256 + wr * 64 + fr + (q >> 2) * 128 + (q & 3) * 16]; }
    __device__ __forceinline__ void operator()(const f32x4 (&acc)[2][2][4][2], const pg8::Unit& u, int wr, int wc, int fr, int fq, const float (&pre)[8]) const {
        const int row0 = u.pm * 256 + wr * 64 + fr, col0 = u.pn * 128 + wc * 32 + 8 * fq;
        float rs8[2][4];
#pragma unroll
        for (int ai = 0; ai < 2; ++ai)
#pragma unroll
            for (int m = 0; m < 4; ++m) rs8[ai][m] = rsqrtf(pre[ai * 4 + m] * (1.0f / 2048.0f) + EPS);
#pragma unroll
        for (int ai = 0; ai < 2; ++ai)
#pragma unroll
            for (int m = 0; m < 4; ++m) { const int row = row0 + ai * 128 + m * 16; const float rs = rs8[ai][m]; float v[8];
#pragma unroll
                for (int q = 0; q < 4; ++q) { const int n = q >> 1, j0 = (q & 1) * 2;
                    typedef float f32x2v __attribute__((ext_vector_type(2)));
                    f32x2v g, u; g.x = acc[ai][0][m][n][j0]; g.y = acc[ai][0][m][n][j0 + 1]; u.x = acc[ai][1][m][n][j0]; u.y = acc[ai][1][m][n][j0 + 1];
                    g = g * rs; u = u * rs;
                    const f32x2v a = g * (-1.44269504f);
                    f32x2v e; e.x = __builtin_amdgcn_exp2f(a.x); e.y = __builtin_amdgcn_exp2f(a.y);
                    const f32x2v d = e + 1.0f;
                    f32x2v r; r.x = __builtin_amdgcn_rcpf(d.x); r.y = __builtin_amdgcn_rcpf(d.y);
                    const f32x2v o = (g * u) * r;
                    v[n * 4 + j0] = o.x; v[n * 4 + j0 + 1] = o.y; }
                *(u32x4*)(act + (size_t)row * LD_DN + col0) = pack8(v); }
    }
};
struct EpiDown {
    static constexpr bool PERM = false, AFTER_DRAIN = false;
    bf16_t* hb; float* hdst; float* part;
    __device__ __forceinline__ void prefetch(const pg8::Unit&, int, int, float (&)[8]) const {}
    __device__ __forceinline__ void operator()(const f32x4 (&acc)[2][2][4][2], const pg8::Unit& u, int wr, int wc, int fr, int fq, const float (&pre)[8]) const {
        const int row0 = u.pm * 256 + wr * 64 + fr, col0 = u.pn * 256 + wc * 32 + 4 * fq;
        if (u.nk < 88) {
            float* pp = part + ((size_t)(u.k0 >> 3) * 128 + (wr * 64 + fr)) * 2048 + col0;
#pragma unroll
            for (int m = 0; m < 4; ++m)
#pragma unroll
                for (int bj = 0; bj < 2; ++bj)
#pragma unroll
                    for (int n = 0; n < 2; ++n) *(f32x4*)(pp + (size_t)m * 16 * 2048 + bj * 128 + n * 16) = acc[0][bj][m][n];
            return;
        }
#pragma unroll
        for (int ai = 0; ai < 2; ++ai) {
            u32x2 hv[4][2][2];
#pragma unroll
            for (int m = 0; m < 4; ++m) { const bf16_t* hr = hb + (size_t)(row0 + ai * 128 + m * 16) * 2048 + col0;
#pragma unroll
                for (int bj = 0; bj < 2; ++bj)
#pragma unroll
                    for (int n = 0; n < 2; ++n) hv[m][bj][n] = *(const u32x2*)(hr + bj * 128 + n * 16); }
#pragma unroll
            for (int m = 0; m < 4; ++m)
#pragma unroll
                for (int bj = 0; bj < 2; ++bj)
#pragma unroll
                    for (int n = 0; n < 2; ++n) asm volatile("" : "+v"(hv[m][bj][n]));
#pragma unroll
            for (int m = 0; m < 4; ++m) { bf16_t* hw = hb + (size_t)(row0 + ai * 128 + m * 16) * 2048 + col0;
#pragma unroll
                for (int bj = 0; bj < 2; ++bj)
#pragma unroll
                    for (int n = 0; n < 2; ++n) { const u32x2 q = hv[m][bj][n]; f32x4 hf; hf[0] = __uint_as_float(q.x << 16); hf[1] = __uint_as_float(q.x & 0xffff0000u); hf[2] = __uint_as_float(q.y << 16); hf[3] = __uint_as_float(q.y & 0xffff0000u);
                        const f32x4 o = hf + acc[ai][bj][m][n]; u32x2 ob; ob.x = cvt_pk_bf16(o[0], o[1]); ob.y = cvt_pk_bf16(o[2], o[3]); *(u32x2*)(hw + bj * 128 + n * 16) = ob; } }
        }
    }
};
struct DownOrder {
    int c;
    __device__ __forceinline__ bool next(int i, pg8::Unit& u) const {
        if (i == 0) { const int x = c & 7, j = c >> 3; u.pm = 4 * x + (j >> 3); u.pn = j & 7; u.k0 = 0; u.nk = 88; return true; }
        if (i == 1 && c < 88) { u.pm = 32; u.pn = c / 11; u.k0 = (c % 11) * 8; u.nk = 8; return true; }
        return false;
    }
    __device__ __forceinline__ void a_ready(const pg8::Unit&) const {}
    __device__ __forceinline__ void done(const pg8::Unit&) const {}
};

struct WTile { const float* W; bf16_t* dst; int N, ldt, k0, n0, drow0, gsel; };
__device__ __forceinline__ void wt_decode(const Params& p, int tt, WTile& w) {
    unsigned char* ws = p.ws; int kt, nt;
    if (tt < 1184) { kt = tt & 31; nt = tt >> 5; w.W = p.w_in; w.N = 4624; w.ldt = 2048; w.dst = (bf16_t*)(ws + OFF_WTIN); w.drow0 = nt * 128; w.gsel = 0; }
    else if (tt < 1696) { const int q = tt - 1184; kt = q & 31; nt = q >> 5; w.W = p.w_out; w.N = 2048; w.ldt = 2048; w.dst = (bf16_t*)(ws + OFF_WTOUT); w.drow0 = nt * 128; w.gsel = 1; }
    else if (tt < 3104) { const int q = tt - 1696; kt = q & 31; nt = q >> 5; w.W = p.w_gate; w.N = 5632; w.ldt = 2048; w.dst = (bf16_t*)(ws + OFF_WTGU); w.drow0 = 256 * nt; w.gsel = 2; }
    else if (tt < 4512) { const int q = tt - 3104; kt = q & 31; nt = q >> 5; w.W = p.w_up; w.N = 5632; w.ldt = 2048; w.dst = (bf16_t*)(ws + OFF_WTGU); w.drow0 = 256 * nt + 128; w.gsel = 2; }
    else { const int q = tt - 4512; kt = q % 88; nt = q / 88; w.W = p.w_down; w.N = 2048; w.ldt = LD_DN; w.dst = (bf16_t*)(ws + OFF_WTDN); w.drow0 = nt * 128; w.gsel = 3; }
    w.k0 = kt * 64; w.n0 = nt * 128;
}
__device__ __forceinline__ void wt_load(const Params& p, const WTile& w, int r, int c4, f32x4 (&v)[4], float (&gk)[4]) {
    const bool ok = w.n0 + c4 < w.N; const float* wp = w.W + (ok ? w.n0 + c4 : 0);
#pragma unroll
    for (int q = 0; q < 4; ++q) { const int k = w.k0 + r + 16 * q;
        gk[q] = w.gsel == 0 ? p.g_mix[k] : w.gsel == 1 ? (k < 1024 ? p.g_co[k] : p.g_sn[k - 1024]) : w.gsel == 2 ? p.g_ffn[k] : 1.0f; if (!ok) gk[q] = 0.f;
        v[q] = *(const f32x4*)(wp + (size_t)k * w.N); }
}
__device__ __forceinline__ void wt_convert(const Params& p, LAS unsigned char* lds, int t_begin, int t_end, int worker, int G) {
    const int tid = threadIdx.x;
    {
        LAS float* tile = (LAS float*)lds;
        const int r = tid >> 5, c4 = (tid & 31) * 4;
        WTile ta, tb; f32x4 va[4], vb[4]; float ga[4], gb[4];
        int t = t_begin + worker;
        bool ha = t < t_end, hb = t + G < t_end;
        if (ha) { wt_decode(p, t, ta); wt_load(p, ta, r, c4, va, ga); }
        if (hb) { wt_decode(p, t + G, tb); wt_load(p, tb, r, c4, vb, gb); }
        while (ha) {
            {
#pragma unroll
                for (int q = 0; q < 4; ++q) { LAS float* tp = tile + (r + 16 * q) * 129 + c4; tp[0] = va[q][0] * ga[q]; tp[1] = va[q][1] * ga[q]; tp[2] = va[q][2] * ga[q]; tp[3] = va[q][3] * ga[q]; }
                __syncthreads();
                bf16_t* cdst = ta.dst + (size_t)(ta.drow0 + (tid >> 2)) * ta.ldt + ta.k0 + (tid & 3) * 16;
                const int tn = t + 2 * G; ha = tn < t_end;
                if (ha) { wt_decode(p, tn, ta); wt_load(p, ta, r, c4, va, ga); }
                const int n = tid >> 2, kq = tid & 3; float o[16];
#pragma unroll
                for (int i = 0; i < 16; ++i) o[i] = tile[(kq * 16 + i) * 129 + n];
                *(u32x4*)cdst = pack8(o); *(u32x4*)(cdst + 8) = pack8(o + 8);
                __syncthreads();
            }
            if (hb) {
#pragma unroll
                for (int q = 0; q < 4; ++q) { LAS float* tp = tile + (r + 16 * q) * 129 + c4; tp[0] = vb[q][0] * gb[q]; tp[1] = vb[q][1] * gb[q]; tp[2] = vb[q][2] * gb[q]; tp[3] = vb[q][3] * gb[q]; }
                __syncthreads();
                bf16_t* cdst = tb.dst + (size_t)(tb.drow0 + (tid >> 2)) * tb.ldt + tb.k0 + (tid & 3) * 16;
                const int tn = t + 3 * G; hb = tn < t_end;
                if (hb) { wt_decode(p, tn, tb); wt_load(p, tb, r, c4, vb, gb); }
                const int n = tid >> 2, kq = tid & 3; float o[16];
#pragma unroll
                for (int i = 0; i < 16; ++i) o[i] = tile[(kq * 16 + i) * 129 + n];
                *(u32x4*)cdst = pack8(o); *(u32x4*)(cdst + 8) = pack8(o + 8);
                __syncthreads();
            }
            t += 2 * G;
        }
    }
}
__device__ __forceinline__ void phase_prep(const Params& p, LAS unsigned char* lds) {
    const int tid = threadIdx.x, lane = tid & 63, wv = tid >> 6, G = gridDim.x;
    unsigned char* ws = p.ws;
    float* ss = (float*)(ws + OFF_SS);
    for (int i = blockIdx.x * 512 + tid; i < 8448 * 7; i += G * 512) ss[8448 + i] = 0.f;
    if (blockIdx.x == 0 && tid < 128) ss[MROWS + tid] = 2048.f;
    bf16_t* XB = (bf16_t*)(ws + OFF_XB);
    {
        int row = blockIdx.x * 8 + wv; const int nw = G * 8;
        f32x4 xv[8], xn[8];
        if (row < MROWS) { const float* src = row < 8192 ? p.xp + (size_t)row * 2048 : p.xs + (size_t)(row - 8192) * 2048;
#pragma unroll
            for (int j = 0; j < 8; ++j) xv[j] = *(const f32x4*)(src + j * 256 + lane * 4); }
        while (row < MROWS) {
            const int rn = row + nw;
            if (rn < MROWS) { const float* src = rn < 8192 ? p.xp + (size_t)rn * 2048 : p.xs + (size_t)(rn - 8192) * 2048;
#pragma unroll
                for (int j = 0; j < 8; ++j) xn[j] = *(const f32x4*)(src + j * 256 + lane * 4); }
            float s = 0.f;
#pragma unroll
            for (int j = 0; j < 8; ++j) { const f32x4 v = xv[j]; s += v[0] * v[0] + v[1] * v[1] + v[2] * v[2] + v[3] * v[3];
                u32x2 o; o.x = cvt_pk_bf16(v[0], v[1]); o.y = cvt_pk_bf16(v[2], v[3]); *(u32x2*)(XB + (size_t)row * 2048 + j * 256 + lane * 4) = o; }
#pragma unroll
            for (int o = 32; o >= 1; o >>= 1) s += __shfl_xor(s, o);
            if (lane == 0) ss[row] = s;
#pragma unroll
            for (int j = 0; j < 8; ++j) xv[j] = xn[j];
            row = rn;
        }
    }
    wt_convert(p, lds, 0, 1184, (int)blockIdx.x, G);
    { u32x4* z = (u32x4*)(ws + OFF_WTIN + 4736ull * 2048 * 2); for (int i = blockIdx.x * 512 + tid; i < 32768; i += G * 512) z[i] = (u32x4){0u, 0u, 0u, 0u}; }
}

__device__ __forceinline__ void phase_conv(const Params& p, LAS unsigned char* lds) {
    const int tid = threadIdx.x, G = gridDim.x;
    unsigned char* ws = p.ws;
    const bf16_t* PROJ = (const bf16_t*)(ws + OFF_PROJ);
    bf16_t* XT = (bf16_t*)(ws + OFF_XT); bf16_t* BN = (bf16_t*)(ws + OFF_BN); bf16_t* BTT = (bf16_t*)(ws + OFF_BTT); bf16_t* CC = (bf16_t*)(ws + OFF_CC);
    for (int tsk = blockIdx.x * 512 + tid; tsk < 98304; tsk += G * 512) {
        const int cgi = tsk % 192, rest = tsk / 192, tt0 = (rest & 7) * 16, bc = rest >> 3;
        const int R0 = (bc >> 4) * 2048 + (bc & 15) * 128; const bool first = (bc & 15) == 0;
        const int ch0 = cgi * 8, kind = ch0 < 1024 ? 0 : (ch0 < 1280 ? 1 : 2);
        u32x4 in[19];
#pragma unroll
        for (int j = 0; j < 19; ++j) { const bool ok = !(first && tt0 - 3 + j < 0); const int rr = ok ? (R0 + tt0 - 3 + j) : R0;
            in[j] = *(const u32x4*)(PROJ + (size_t)rr * 4608 + 3072 + ch0); if (!ok) in[j] = (u32x4){0u, 0u, 0u, 0u}; }
        unsigned nat[16][4];
#pragma unroll
        for (int e2 = 0; e2 < 4; ++e2) {
            const int ea = 2 * e2, eb = 2 * e2 + 1; float oa[16], ob[16];
            typedef float f32x2v __attribute__((ext_vector_type(2)));
            const f32x2v q0 = *(const f32x2v*)(p.conv_w + ch0 + ea), q1 = *(const f32x2v*)(p.conv_w + 1536 + ch0 + ea), q2 = *(const f32x2v*)(p.conv_w + 3072 + ch0 + ea), q3 = *(const f32x2v*)(p.conv_w + 4608 + ch0 + ea), qb = *(const f32x2v*)(p.conv_b + ch0 + ea);
            const float w0a = q0.x, w1a = q1.x, w2a = q2.x, w3a = q3.x, cba = qb.x, w0b = q0.y, w1b = q1.y, w2b = q2.y, w3b = q3.y, cbb = qb.y;
#pragma unroll
            for (int t = 0; t < 16; ++t) {
                oa[t] = silu_f(cba + w0a * __uint_as_float(in[t][e2] << 16) + w1a * __uint_as_float(in[t + 1][e2] << 16) + w2a * __uint_as_float(in[t + 2][e2] << 16) + w3a * __uint_as_float(in[t + 3][e2] << 16));
                ob[t] = silu_f(cbb + w0b * __uint_as_float(in[t][e2] & 0xffff0000u) + w1b * __uint_as_float(in[t + 1][e2] & 0xffff0000u) + w2b * __uint_as_float(in[t + 2][e2] & 0xffff0000u) + w3b * __uint_as_float(in[t + 3][e2] & 0xffff0000u));
                nat[t][e2] = cvt_pk_bf16(oa[t], ob[t]); }
            if (kind <= 1) { bf16_t* tp = kind == 0 ? XT + ((size_t)(bc * 1024 + ch0 + ea) * 128 + tt0) : BTT + ((size_t)(bc * 256 + (ch0 - 1024) + ea) * 128 + tt0);
                *(u32x4*)tp = pack8(oa); *(u32x4*)(tp + 8) = pack8(oa + 8); *(u32x4*)(tp + 128) = pack8(ob); *(u32x4*)(tp + 136) = pack8(ob + 8); }
        }
        if (kind >= 1) { bf16_t* np = (kind == 1 ? BN + (ch0 - 1024) : CC + (ch0 - 1280)) + (size_t)(R0 + tt0) * 256;
#pragma unroll
            for (int t = 0; t < 16; ++t) { u32x4 o; o.x = nat[t][0]; o.y = nat[t][1]; o.z = nat[t][2]; o.w = nat[t][3]; *(u32x4*)(np + (size_t)t * 256) = o; } }
    }
    const float* DT = (const float*)(ws + OFF_DT); float* EAC = (float*)(ws + OFF_EAC); float* EAL = (float*)(ws + OFF_EAL);
    float* FA = (float*)(ws + OFF_FA); float* FD = (float*)(ws + OFF_FD); float* FW = (float*)(ws + OFF_FW);
    LAS float* ftot = (LAS float*)lds;
    const int lane = tid & 63, wv8 = tid >> 6;
    for (int s0 = blockIdx.x * 4; s0 < 1024; s0 += G * 4) {
        const int q = tid >> 7, t = tid & 127, seq = s0 + q, bc = seq >> 4, h = seq & 15, R0 = (bc >> 4) * 2048 + (bc & 15) * 128;
        const float dtv = softplus_f(DT[(size_t)(R0 + t) * 16 + h] + p.dt_bias[h]);
        float xa = dtv * (-expf(p.a_log[h]));
#pragma unroll
        for (int o = 1; o < 64; o <<= 1) { const float u = __shfl_up(xa, o); if (lane >= o) xa += u; }
        if (lane == 63) ftot[wv8] = xa;
        __syncthreads();
        if (wv8 & 1) xa += ftot[wv8 - 1];
        if (t == 127) ftot[8 + q] = xa;
        __syncthreads();
        const float a_last = ftot[8 + q];
        FA[seq * 128 + t] = xa; FD[seq * 128 + t] = dtv; FW[seq * 128 + t] = expf(a_last - xa) * dtv; EAC[(size_t)(R0 + t) * 16 + h] = expf(xa);
        if (t == 127) EAL[seq] = expf(a_last);
        __syncthreads();
    }
}

__device__ __forceinline__ void conv16(const Params& p, const bf16_t* PROJ, int R0, int t0, bool first, int ch, float (&o)[16]) {
    float in[19];
    const bf16_t* src = PROJ + (size_t)(R0 + t0) * 4608 + 3072 + ch;
#pragma unroll
    for (int j = 0; j < 19; ++j) { in[j] = 0.f; if (!(first && t0 - 3 + j < 0)) in[j] = bf2f(src[(ptrdiff_t)(j - 3) * 4608]); }
    const float w0 = p.conv_w[ch], w1 = p.conv_w[1536 + ch], w2 = p.conv_w[3072 + ch], w3 = p.conv_w[4608 + ch], cb = p.conv_b[ch];
#pragma unroll
    for (int t = 0; t < 16; ++t) o[t] = silu_f(cb + w0 * in[t] + w1 * in[t + 1] + w2 * in[t + 2] + w3 * in[t + 3]);
}

__device__ __forceinline__ void ssd_local(const Params& p, LAS unsigned char* lds, int b, int c, int h) {
    const int tid = threadIdx.x, lane = tid & 63, w = __builtin_amdgcn_readfirstlane(tid >> 6), g = h >> 3, fr = lane & 15, fq = lane >> 4;
    const int R0 = b * 2048 + c * 128, t0 = w * 16;
    unsigned char* ws = p.ws;
    const bf16_t* PROJ = (const bf16_t*)(ws + OFF_PROJ);
    const float* DT = (const float*)(ws + OFF_DT);
    float* EAC = (float*)(ws + OFF_EAC); float* EAL = (float*)(ws + OFF_EAL);
    LAS unsigned char* CcL = lds; LAS unsigned char* BcL = lds + 34816; LAS unsigned char* BTL = lds + 69632; LAS unsigned char* xTL = lds + 104448;
    LAS unsigned char* ML = lds + 121856;
    LAS float* fa = (LAS float*)(lds + 156672); LAS float* fd = fa + 128;
    {
        const int bc = b * 16 + c, seq = bc * 16 + h;
        const bf16_t* CC = (const bf16_t*)(ws + OFF_CC); const bf16_t* BN = (const bf16_t*)(ws + OFF_BN); const bf16_t* BTT = (const bf16_t*)(ws + OFF_BTT); const bf16_t* XT = (const bf16_t*)(ws + OFF_XT);
        if (tid < 128) { fa[tid] = ((const float*)(ws + OFF_FA))[seq * 128 + tid]; fd[tid] = ((const float*)(ws + OFF_FD))[seq * 128 + tid]; }
        const f32x4 fw0 = *(const f32x4*)((const float*)(ws + OFF_FW) + seq * 128 + (tid & 15) * 8), fw1 = *(const f32x4*)((const float*)(ws + OFF_FW) + seq * 128 + (tid & 15) * 8 + 4);
        u32x4 cv[4], bv[4], tv[4], xv[2];
#pragma unroll
        for (int i = 0; i < 4; ++i) { const int q = tid + 512 * i, row = q >> 4, c16 = q & 15;
            cv[i] = *(const u32x4*)(CC + (size_t)(R0 + row) * 256 + g * 128 + c16 * 8); bv[i] = *(const u32x4*)(BN + (size_t)(R0 + row) * 256 + g * 128 + c16 * 8);
            tv[i] = *(const u32x4*)(BTT + ((size_t)(bc * 256 + g * 128 + row) * 128 + c16 * 8)); }
#pragma unroll
        for (int i = 0; i < 2; ++i) { const int q = tid + 512 * i, row = q >> 4, c16 = q & 15; xv[i] = *(const u32x4*)(XT + ((size_t)(bc * 1024 + h * 64 + row) * 128 + c16 * 8)); }
#pragma unroll
        for (int i = 0; i < 4; ++i) { const int q = tid + 512 * i, row = q >> 4, c16 = q & 15; *(LAS u32x4*)(CcL + row * 272 + c16 * 16) = cv[i]; *(LAS u32x4*)(BcL + row * 272 + c16 * 16) = bv[i]; }
#pragma unroll
        for (int i = 0; i < 2; ++i) { const int q = tid + 512 * i, row = q >> 4, c16 = q & 15; *(LAS u32x4*)(xTL + row * 272 + c16 * 16) = xv[i]; }
#pragma unroll
        for (int i = 0; i < 4; ++i) { const int q = tid + 512 * i, row = q >> 4, c16 = q & 15; float f[8];
#pragma unroll
            for (int e = 0; e < 4; ++e) { const float wa = (2 * e < 4) ? fw0[(2 * e) & 3] : fw1[(2 * e) & 3], wb = (2 * e + 1 < 4) ? fw0[(2 * e + 1) & 3] : fw1[(2 * e + 1) & 3];
                f[2 * e] = __uint_as_float(tv[i][e] << 16) * wa; f[2 * e + 1] = __uint_as_float(tv[i][e] & 0xffff0000u) * wb; }
            *(LAS u32x4*)(BTL + row * 272 + c16 * 16) = pack8(f); }
        __syncthreads();
    }
    f32x4 cbt[8];
#pragma unroll
    for (int j = 0; j < 8; ++j) cbt[j] = (f32x4){0.f, 0.f, 0.f, 0.f};
#pragma unroll
    for (int ks = 0; ks < 4; ++ks) { const bf16x8 a = *(LAS bf16x8*)(CcL + (t0 + fr) * 272 + (ks * 32 + fq * 8) * 2);
#pragma unroll
        for (int j = 0; j < 8; ++j) if (j <= w) { const bf16x8 bb = *(LAS bf16x8*)(BcL + (j * 16 + fr) * 272 + (ks * 32 + fq * 8) * 2); cbt[j] = mfma16(a, bb, cbt[j]); } }
#pragma unroll
    for (int j = 0; j < 8; ++j) if (j <= (w | 1)) {
#pragma unroll
        for (int i = 0; i < 4; ++i) { const int t = t0 + fq * 4 + i, s = j * 16 + fr; float v = 0.f; if (j <= w && s <= t) v = cbt[j][i] * __expf(fa[t] - fa[s]) * fd[s];
            *(LAS bf16_t*)(ML + t * 272 + s * 2) = f2bf(v); } }
    const int nks = (w >> 1) + 1;
    f32x4 yd[4];
#pragma unroll
    for (int j = 0; j < 4; ++j) yd[j] = (f32x4){0.f, 0.f, 0.f, 0.f};
#pragma unroll
    for (int ks = 0; ks < 4; ++ks) if (ks < nks) { const bf16x8 a = *(LAS bf16x8*)(ML + (t0 + fr) * 272 + (ks * 32 + fq * 8) * 2);
#pragma unroll
        for (int pj = 0; pj < 4; ++pj) { const bf16x8 bb = *(LAS bf16x8*)(xTL + (pj * 16 + fr) * 272 + (ks * 32 + fq * 8) * 2); yd[pj] = mfma16(a, bb, yd[pj]); } }
    { float* YD = (float*)(ws + OFF_YD); const float Dh = p.dvec[h];
#pragma unroll
        for (int pj = 0; pj < 4; ++pj)
#pragma unroll
            for (int i = 0; i < 4; ++i) { const int t = t0 + fq * 4 + i, pc = pj * 16 + fr; const float xv = bf2f(*(LAS bf16_t*)(xTL + pc * 272 + t * 2));
                YD[(size_t)(R0 + t) * 1024 + h * 64 + pc] = yd[pj][i] + Dh * xv; } }
    f32x4 st[4];
#pragma unroll
    for (int j = 0; j < 4; ++j) st[j] = (f32x4){0.f, 0.f, 0.f, 0.f};
#pragma unroll
    for (int ks = 0; ks < 4; ++ks) { const bf16x8 bb = *(LAS bf16x8*)(BTL + (t0 + fr) * 272 + (ks * 32 + fq * 8) * 2);
#pragma unroll
        for (int pi = 0; pi < 4; ++pi) { const bf16x8 a = *(LAS bf16x8*)(xTL + (pi * 16 + fr) * 272 + (ks * 32 + fq * 8) * 2); st[pi] = mfma16(a, bb, st[pi]); } }
    { float* S = (float*)(ws + OFF_STATES) + (size_t)((b * 16 + c) * 16 + h) * 8192;
#pragma unroll
        for (int pi = 0; pi < 4; ++pi)
#pragma unroll
            for (int i = 0; i < 4; ++i) S[(pi * 16 + fq * 4 + i) * 128 + t0 + fr] = st[pi][i]; }
    __syncthreads();
}

__device__ __forceinline__ void ssd_group(const Params& p, LAS unsigned char* lds, int b, int c, int g) {
    const int tid = threadIdx.x, lane = tid & 63, w = __builtin_amdgcn_readfirstlane(tid >> 6), fr = lane & 15, fq = lane >> 4;
    const int R0 = b * 2048 + c * 128, t0 = w * 16, bc = b * 16 + c;
    unsigned char* ws = p.ws;
    const bf16_t* CC = (const bf16_t*)(ws + OFF_CC); const bf16_t* BN = (const bf16_t*)(ws + OFF_BN); const bf16_t* BTT = (const bf16_t*)(ws + OFF_BTT); const bf16_t* XT = (const bf16_t*)(ws + OFF_XT);
    const float* FA = (const float*)(ws + OFF_FA); const float* FD = (const float*)(ws + OFF_FD); const float* FW = (const float*)(ws + OFF_FW);
    LAS unsigned char* CcL = lds; LAS unsigned char* BcL = lds + 34816; LAS unsigned char* BTL = lds + 69632;
    LAS unsigned char* ML = lds;
    LAS float* faL = (LAS float*)(lds + 104448); LAS float* fdL = faL + 1024;
    {
        u32x4 cv[4], bv[4], tv[4];
#pragma unroll
        for (int i = 0; i < 4; ++i) { const int q = tid + 512 * i, row = q >> 4, c16 = q & 15;
            cv[i] = *(const u32x4*)(CC + (size_t)(R0 + row) * 256 + g * 128 + c16 * 8); bv[i] = *(const u32x4*)(BN + (size_t)(R0 + row) * 256 + g * 128 + c16 * 8);
            tv[i] = *(const u32x4*)(BTT + ((size_t)(bc * 256 + g * 128 + row) * 128 + c16 * 8)); }
        float fav[2], fdv[2];
#pragma unroll
        for (int k = 0; k < 2; ++k) { const int q = tid + 512 * k; fav[k] = FA[(size_t)(bc * 16 + g * 8) * 128 + q]; fdv[k] = FD[(size_t)(bc * 16 + g * 8) * 128 + q]; }
#pragma unroll
        for (int i = 0; i < 4; ++i) { const int q = tid + 512 * i, row = q >> 4, c16 = q & 15; *(LAS u32x4*)(CcL + row * 272 + c16 * 16) = cv[i]; *(LAS u32x4*)(BcL + row * 272 + c16 * 16) = bv[i]; *(LAS u32x4*)(BTL + row * 272 + c16 * 16) = tv[i]; }
#pragma unroll
        for (int k = 0; k < 2; ++k) { faL[tid + 512 * k] = fav[k]; fdL[tid + 512 * k] = fdv[k]; }
    }
    __syncthreads();
    f32x4 cbt[8];
#pragma unroll
    for (int j = 0; j < 8; ++j) cbt[j] = (f32x4){0.f, 0.f, 0.f, 0.f};
#pragma unroll
    for (int ks = 0; ks < 4; ++ks) { const bf16x8 a = *(LAS bf16x8*)(CcL + (t0 + fr) * 272 + (ks * 32 + fq * 8) * 2);
#pragma unroll
        for (int j = 0; j < 8; ++j) if (j <= w) { const bf16x8 bb = *(LAS bf16x8*)(BcL + (j * 16 + fr) * 272 + (ks * 32 + fq * 8) * 2); cbt[j] = mfma16(a, bb, cbt[j]); } }
    u32x4 xv[2]; f32x4 fw0, fw1;
    { const int seq = bc * 16 + g * 8;
#pragma unroll
        for (int i = 0; i < 2; ++i) { const int q = tid + 512 * i, row = q >> 4, c16 = q & 15; xv[i] = *(const u32x4*)(XT + ((size_t)(bc * 1024 + g * 512 + row) * 128 + c16 * 8)); }
        fw0 = *(const f32x4*)(FW + (size_t)seq * 128 + (tid & 15) * 8); fw1 = *(const f32x4*)(FW + (size_t)seq * 128 + (tid & 15) * 8 + 4); }
    __syncthreads();
    const int nks = (w >> 1) + 1;
    for (int hh = 0; hh < 8; ++hh) {
        const int h = g * 8 + hh;
        LAS float* fa = faL + hh * 128; LAS float* fd = fdL + hh * 128;
        LAS unsigned char* xTL = lds + ((hh & 1) ? 112640 : 34816); LAS unsigned char* xTsL = xTL + 17408;
#pragma unroll
        for (int i = 0; i < 2; ++i) { const int q = tid + 512 * i, row = q >> 4, c16 = q & 15; float f[8];
#pragma unroll
            for (int e = 0; e < 4; ++e) { const float wa = (2 * e < 4) ? fw0[(2 * e) & 3] : fw1[(2 * e) & 3], wb = (2 * e + 1 < 4) ? fw0[(2 * e + 1) & 3] : fw1[(2 * e + 1) & 3];
                f[2 * e] = __uint_as_float(xv[i][e] << 16) * wa; f[2 * e + 1] = __uint_as_float(xv[i][e] & 0xffff0000u) * wb; }
            *(LAS u32x4*)(xTL + row * 272 + c16 * 16) = xv[i]; *(LAS u32x4*)(xTsL + row * 272 + c16 * 16) = pack8(f); }
        if (hh < 7) { const int seq = bc * 16 + h + 1;
#pragma unroll
            for (int i = 0; i < 2; ++i) { const int q = tid + 512 * i, row = q >> 4, c16 = q & 15; xv[i] = *(const u32x4*)(XT + ((size_t)(bc * 1024 + (h + 1) * 64 + row) * 128 + c16 * 8)); }
            fw0 = *(const f32x4*)(FW + (size_t)seq * 128 + (tid & 15) * 8); fw1 = *(const f32x4*)(FW + (size_t)seq * 128 + (tid & 15) * 8 + 4); }
#pragma unroll
        for (int j = 0; j < 8; ++j) if (j <= (w | 1)) {
#pragma unroll
            for (int i = 0; i < 4; ++i) { const int t = t0 + fq * 4 + i, s = j * 16 + fr; float v = 0.f; if (j <= w && s <= t) v = cbt[j][i] * __expf(fa[t] - fa[s]) * fd[s];
                *(LAS bf16_t*)(ML + t * 272 + s * 2) = f2bf(v); } }
        __syncthreads();
        f32x4 yd[4];
#pragma unroll
        for (int j = 0; j < 4; ++j) yd[j] = (f32x4){0.f, 0.f, 0.f, 0.f};
#pragma unroll
        for (int ks = 0; ks < 4; ++ks) if (ks < nks) { const bf16x8 a = *(LAS bf16x8*)(ML + (t0 + fr) * 272 + (ks * 32 + fq * 8) * 2);
#pragma unroll
            for (int pj = 0; pj < 4; ++pj) { const bf16x8 bb = *(LAS bf16x8*)(xTL + (pj * 16 + fr) * 272 + (ks * 32 + fq * 8) * 2); yd[pj] = mfma16(a, bb, yd[pj]); } }
        { float* YD = (float*)(ws + OFF_YD); const float Dh = p.dvec[h];
#pragma unroll
            for (int pj = 0; pj < 4; ++pj)
#pragma unroll
                for (int i = 0; i < 4; ++i) { const int t = t0 + fq * 4 + i, pc = pj * 16 + fr; const float xx = bf2f(*(LAS bf16_t*)(xTL + pc * 272 + t * 2));
                    YD[(size_t)(R0 + t) * 1024 + h * 64 + pc] = yd[pj][i] + Dh * xx; } }
        f32x4 st[4];
#pragma unroll
        for (int j = 0; j < 4; ++j) st[j] = (f32x4){0.f, 0.f, 0.f, 0.f};
#pragma unroll
        for (int ks = 0; ks < 4; ++ks) { const bf16x8 bb = *(LAS bf16x8*)(BTL + (t0 + fr) * 272 + (ks * 32 + fq * 8) * 2);
#pragma unroll
            for (int pi = 0; pi < 4; ++pi) { const bf16x8 a = *(LAS bf16x8*)(xTsL + (pi * 16 + fr) * 272 + (ks * 32 + fq * 8) * 2); st[pi] = mfma16(a, bb, st[pi]); } }
        { float* S = (float*)(ws + OFF_STATES) + (size_t)(bc * 16 + h) * 8192;
#pragma unroll
            for (int pi = 0; pi < 4; ++pi)
#pragma unroll
                for (int i = 0; i < 4; ++i) S[(pi * 16 + fq * 4 + i) * 128 + t0 + fr] = st[pi][i]; }
    }
    __syncthreads();
}

__device__ __forceinline__ void chunk_mlp(const Params& p, LAS unsigned char* lds, int b, int c, int h, bool dry) {
    const int tid = threadIdx.x, lane = tid & 63, w = __builtin_amdgcn_readfirstlane(tid >> 6), fr = lane & 15, fq = lane >> 4;
    const int R0 = b * 2048 + c * 128, t0 = w * 16;
    unsigned char* ws = p.ws;
    const bf16_t* PROJ = (const bf16_t*)(ws + OFF_PROJ);
    float* ss = (float*)(ws + OFF_SS); const float* vss = ss + 8448; float* yss = (float*)(ws + (dry ? OFF_SS2 : OFF_SS)) + 2 * 8448;
    bf16_t* Y = (bf16_t*)(ws + OFF_XB);
    LAS unsigned char* gvT = lds;
    const int nks = (w >> 1) + 1, trow = t0 + fr;
    f32x4 wq[4][2];
#pragma unroll
    for (int ks = 0; ks < 4; ++ks) if (ks < nks) { const float* wp = p.w_s + (size_t)h * 16384 + trow * 128 + ks * 32 + fq * 8; wq[ks][0] = *(const f32x4*)wp; wq[ks][1] = *(const f32x4*)(wp + 4); }
    float uu[4][8], bias4[4];
#pragma unroll
    for (int i = 0; i < 4; ++i) { const int t = t0 + fq * 4 + i; bias4[i] = p.b_s[h * 128 + t];
#pragma unroll
        for (int dj = 0; dj < 8; ++dj) uu[i][dj] = bf2f(PROJ[(size_t)(R0 + t) * 4608 + h * 128 + dj * 16 + fr]); }
    if (tid < 256) { const int d0 = (tid & 15) * 8, tt0 = (tid >> 4) * 8;
        u32x4 in[8]; float rv[8];
#pragma unroll
        for (int j = 0; j < 8; ++j) { in[j] = *(const u32x4*)(PROJ + (size_t)(R0 + tt0 + j) * 4608 + 1024 + h * 128 + d0); rv[j] = vss[R0 + tt0 + j]; }
        f32x4 gq[2]; gq[0] = *(const f32x4*)(p.g_cv + h * 128 + d0); gq[1] = *(const f32x4*)(p.g_cv + h * 128 + d0 + 4);
#pragma unroll
        for (int j = 0; j < 8; ++j) rv[j] = rsqrtf(rv[j] * (1.0f / 1024.0f) + EPS);
#pragma unroll
        for (int e2 = 0; e2 < 4; ++e2) { const int ea = 2 * e2, eb = 2 * e2 + 1; const float ga = gq[ea >> 2][ea & 3], gb = gq[eb >> 2][eb & 3]; float oa[8], ob[8];
#pragma unroll
            for (int j = 0; j < 8; ++j) { oa[j] = __uint_as_float(in[j][e2] << 16) * rv[j] * ga; ob[j] = __uint_as_float(in[j][e2] & 0xffff0000u) * rv[j] * gb; }
            *(LAS u32x4*)(gvT + (d0 + ea) * 272 + tt0 * 2) = pack8(oa); *(LAS u32x4*)(gvT + (d0 + eb) * 272 + tt0 * 2) = pack8(ob); } }
    __syncthreads();
    f32x4 acc[8];
#pragma unroll
    for (int j = 0; j < 8; ++j) acc[j] = (f32x4){0.f, 0.f, 0.f, 0.f};
#pragma unroll
    for (int ks = 0; ks < 4; ++ks) if (ks < nks) { const int s0 = ks * 32 + fq * 8; float wv[8];
#pragma unroll
        for (int e = 0; e < 4; ++e) { wv[e] = (s0 + e <= trow) ? wq[ks][0][e] : 0.f; wv[4 + e] = (s0 + 4 + e <= trow) ? wq[ks][1][e] : 0.f; }
        const bf16x8 a = __builtin_bit_cast(bf16x8, pack8(wv));
#pragma unroll
        for (int dj = 0; dj < 8; ++dj) { const bf16x8 bb = *(LAS bf16x8*)(gvT + (dj * 16 + fr) * 272 + s0 * 2); acc[dj] = mfma16(a, bb, acc[dj]); } }
#pragma unroll
    for (int i = 0; i < 4; ++i) { const int t = t0 + fq * 4 + i; const float bias = bias4[i]; float ssq = 0.f;
#pragma unroll
        for (int dj = 0; dj < 8; ++dj) { const int d = dj * 16 + fr; const float v = uu[i][dj] * (acc[dj][i] + bias);
            ssq += v * v; Y[(size_t)(R0 + t) * 2048 + h * 128 + d] = f2bf(v); }
        ssq += __shfl_xor(ssq, 1); ssq += __shfl_xor(ssq, 2); ssq += __shfl_xor(ssq, 4); ssq += __shfl_xor(ssq, 8);
        if (fr == 0) unsafeAtomicAdd(yss + (size_t)(R0 + t) * 4, ssq); }
    __syncthreads();
}

__device__ __forceinline__ void sample_item(const Params& p, LAS unsigned char* lds, int b, int g, bool dry) {
    const int tid = threadIdx.x, lane = tid & 63, w = __builtin_amdgcn_readfirstlane(tid >> 6), h = g * 8 + w, row = 8192 + b;
    unsigned char* ws = p.ws;
    const bf16_t* PROJ = (const bf16_t*)(ws + OFF_PROJ);
    const float* DT = (const float*)(ws + OFF_DT);
    float* ss = (float*)(ws + OFF_SS); const float* vss = ss + 8448; float* yss = (float*)(ws + (dry ? OFF_SS2 : OFF_SS)) + 2 * 8448;
    bf16_t* Y = (bf16_t*)(ws + OFF_XB);
    LAS float* wl = (LAS float*)(lds + w * 2048);
    const float* sc = p.sconv + (size_t)b * 3 * 1536; float* ocs = p.out + O_CONVS + (size_t)b * 3 * 1536;
    int chs[5]; chs[0] = h * 64 + lane; chs[1] = 1024 + g * 128 + lane; chs[2] = 1024 + g * 128 + 64 + lane; chs[3] = 1280 + g * 128 + lane; chs[4] = 1280 + g * 128 + 64 + lane;
    float s0[5], s1[5], s2[5], xn[5], cv[5];
#pragma unroll
    for (int k = 0; k < 5; ++k) { const int ch = chs[k]; xn[k] = bf2f(PROJ[(size_t)row * 4608 + 3072 + ch]); s0[k] = sc[ch]; s1[k] = sc[1536 + ch]; s2[k] = sc[3072 + ch];
        cv[k] = p.conv_b[ch] + p.conv_w[ch] * s0[k] + p.conv_w[1536 + ch] * s1[k] + p.conv_w[3072 + ch] * s2[k] + p.conv_w[4608 + ch] * xn[k]; }
#pragma unroll
    for (int k = 0; k < 5; ++k) { cv[k] = silu_f(cv[k]); if (k == 0 || w == 0) { const int ch = chs[k]; ocs[ch] = s1[k]; ocs[1536 + ch] = s2[k]; ocs[3072 + ch] = xn[k]; } }
    const float xv = cv[0], B0 = cv[1], B1 = cv[2], C0 = cv[3], C1 = cv[4];
    const float dt = softplus_f(DT[(size_t)row * 16 + h] + p.dt_bias[h]); const float dA = expf(-expf(p.a_log[h]) * dt);
    wl[lane] = B0; wl[64 + lane] = B1; wl[128 + lane] = C0; wl[192 + lane] = C1; wl[256 + lane] = xv * dt; wl[320 + lane] = xv;
    const int nn = (lane & 31) * 4, ph = lane >> 5;
    const f32x4 B4 = *(LAS f32x4*)(wl + nn), C4 = *(LAS f32x4*)(wl + 128 + nn);
    const float* h0 = p.sssm + (size_t)(b * 16 + h) * 8192; float* hn = p.out + O_SSMS + (size_t)(b * 16 + h) * 8192;
    {
        f32x4 hv[2][8];
#pragma unroll
        for (int k = 0; k < 8; ++k) hv[0][k] = *(const f32x4*)(h0 + (k * 2 + ph) * 128 + nn);
#pragma unroll
        for (int bt = 0; bt < 4; ++bt) {
            if (bt < 3) {
#pragma unroll
                for (int k = 0; k < 8; ++k) hv[(bt + 1) & 1][k] = *(const f32x4*)(h0 + (((bt + 1) * 8 + k) * 2 + ph) * 128 + nn);
            }
            float pv[8];
#pragma unroll
            for (int k = 0; k < 8; ++k) { const int pp = ((bt * 8 + k) * 2) + ph; const float xd = wl[256 + pp];
                const f32x4 r = hv[bt & 1][k] * dA + B4 * xd; *(f32x4*)(hn + pp * 128 + nn) = r;
                pv[k] = r[0] * C4[0] + r[1] * C4[1] + r[2] * C4[2] + r[3] * C4[3]; }
#pragma unroll
            for (int i = 0; i < 4; ++i) { const bool hi = (lane & 16) != 0; const float send = hi ? pv[i] : pv[i + 4], keep = hi ? pv[i + 4] : pv[i]; pv[i] = keep + __shfl_xor(send, 16); }
#pragma unroll
            for (int i = 0; i < 2; ++i) { const bool hi = (lane & 8) != 0; const float send = hi ? pv[i] : pv[i + 2], keep = hi ? pv[i + 2] : pv[i]; pv[i] = keep + __shfl_xor(send, 8); }
            { const bool hi = (lane & 4) != 0; const float send = hi ? pv[0] : pv[1], keep = hi ? pv[1] : pv[0]; pv[0] = keep + __shfl_xor(send, 4); }
            pv[0] += __shfl_xor(pv[0], 2); pv[0] += __shfl_xor(pv[0], 1);
            if ((lane & 3) == 0) { const int kk = ((lane >> 4) & 1) * 4 + ((lane >> 3) & 1) * 2 + ((lane >> 2) & 1); wl[384 + ((bt * 8 + kk) * 2) + ph] = pv[0]; }
        }
    }
    float y = wl[384 + lane] + p.dvec[h] * xv;
    y *= bf2f(PROJ[(size_t)row * 4608 + 2048 + h * 64 + lane]);
    float ssq = y * y;
#pragma unroll
    for (int o = 32; o >= 1; o >>= 1) ssq += __shfl_xor(ssq, o);
    if (lane == 0) unsafeAtomicAdd(yss + (size_t)row * 4 + 1 + g, ssq);
    Y[(size_t)row * 2048 + 1024 + h * 64 + lane] = f2bf(y);
    { const int cidx = g * 512 + tid, hh = cidx >> 7; const float gv = bf2f(PROJ[(size_t)row * 4608 + 1024 + cidx]); const float rs = rsqrtf(vss[row] * (1.0f / 1024.0f) + EPS);
        const float vrow = gv * rs * p.g_cv[cidx]; p.out[O_VS + (size_t)b * 1024 + cidx] = vrow;
        const float mixed = p.w_s[(size_t)hh * 16384] * vrow + p.b_s[hh * 128]; const float ya = bf2f(PROJ[(size_t)row * 4608 + cidx]) * mixed;
        Y[(size_t)row * 2048 + cidx] = f2bf(ya); float s2 = ya * ya;
#pragma unroll
        for (int o = 32; o >= 1; o >>= 1) s2 += __shfl_xor(s2, o);
        if (lane == 0) unsafeAtomicAdd(yss + (size_t)row * 4, s2); }
    __syncthreads();
}

__device__ __forceinline__ void phase_mixer(const Params& p, LAS unsigned char* lds, bool dry) {
#ifndef PROBE_SSD
#define PROBE_SSD 0
#define PROBE_CHUNK 0
#define PROBE_SAMPLE 0
#endif
    const int G = gridDim.x, bx = blockIdx.x, half = G >> 1;
    if (bx < half) {
        for (int it = bx; it < 128; it += half) ssd_group(p, lds, it >> 5, (it >> 1) & 15, it & 1);
        for (int j = bx; j < 128; j += half) chunk_mlp(p, lds, j >> 7, (j >> 3) & 15, j & 7, dry);
    } else {
        const int k = bx - half, nk2 = G - half;
        for (int j = k; j < 256; j += nk2) sample_item(p, lds, j >> 1, j & 1, dry);
        for (int j = 128 + k; j < 512; j += nk2) chunk_mlp(p, lds, j >> 7, (j >> 3) & 15, j & 7, dry);
    }
    if (blockIdx.x < 4) { const int b = blockIdx.x; const bf16_t* PROJ = (const bf16_t*)(p.ws + OFF_PROJ);
        for (int i = threadIdx.x; i < 4608; i += 512) { const int k = i / 1536, ch = i - k * 1536;
            p.out[O_CONVP + (size_t)(b * 3 + k) * 1536 + ch] = bf2f(PROJ[(size_t)(b * 2048 + 2045 + k) * 4608 + 3072 + ch]); } }
}

__device__ __forceinline__ void phase_scan(const Params& p, bool dry) {
    const float* STATES = (const float*)(p.ws + OFF_STATES); const float* EAL = (const float*)(p.ws + OFF_EAL); bf16_t* HPREV = (bf16_t*)(p.ws + OFF_HPREV);
    for (int i = blockIdx.x * 512 + threadIdx.x; i < 131072; i += gridDim.x * 512) {
        const int b = i >> 15, e = (i & 32767) * 4, h = e >> 13;
        f32x4 run = (f32x4){0.f, 0.f, 0.f, 0.f}; f32x4 stv[16]; float ealv[16];
#pragma unroll
        for (int c = 0; c < 16; ++c) { stv[c] = *(const f32x4*)(STATES + (size_t)(b * 16 + c) * 131072 + e); ealv[c] = EAL[(b * 16 + c) * 16 + h]; }
#pragma unroll
        for (int c = 0; c < 16; ++c) { u32x2 o; o.x = cvt_pk_bf16(run[0], run[1]); o.y = cvt_pk_bf16(run[2], run[3]); *(u32x2*)(HPREV + (size_t)(b * 16 + c) * 131072 + e) = o;
            run = run * ealv[c] + stv[c]; }
        *(f32x4*)(p.out + O_SSMP + (size_t)b * 131072 + e) = run;
    }
    if (!dry) {
        const float* yss = (const float*)(p.ws + OFF_SS) + 2 * 8448; bf16_t* Y = (bf16_t*)(p.ws + OFF_XB);
        for (int i = blockIdx.x * 512 + threadIdx.x; i < 128 * 256; i += gridDim.x * 512) { const int row = 8192 + (i >> 8), c8 = (i & 255) * 8, seg = c8 < 1024 ? 0 : (c8 < 1536 ? 1 : 2);
            const float rs = rsqrtf(yss[(size_t)row * 4 + seg] * (seg ? (1.0f / 512.0f) : (1.0f / 1024.0f)) + EPS);
            const u32x4 v = *(const u32x4*)(Y + (size_t)row * 2048 + c8); float f[8];
#pragma unroll
            for (int e = 0; e < 4; ++e) { f[2 * e] = __uint_as_float(v[e] << 16) * rs; f[2 * e + 1] = __uint_as_float(v[e] & 0xffff0000u) * rs; }
            *(u32x4*)(Y + (size_t)row * 2048 + c8) = pack8(f); }
    }
}

__device__ __forceinline__ void phase_combine(const Params& p, LAS unsigned char* lds, bool dry) {
    const int tid = threadIdx.x, lane = tid & 63, w = tid >> 6, fr = lane & 15, fq = lane >> 4;
    unsigned char* ws = p.ws;
    const bf16_t* PROJ = (const bf16_t*)(ws + OFF_PROJ); const bf16_t* CC = (const bf16_t*)(ws + OFF_CC); const bf16_t* HPREV = (const bf16_t*)(ws + OFF_HPREV);
    const float* YD = (const float*)(ws + OFF_YD); const float* EAC = (const float*)(ws + OFF_EAC);
    const float* yss = (const float*)(ws + OFF_SS) + 2 * 8448; bf16_t* Y = (bf16_t*)(ws + OFF_XB);
    LAS float* part = (LAS float*)lds;
    for (int it = blockIdx.x; it < 512; it += gridDim.x) {
        const int b = it >> 7, c = (it >> 3) & 15, g = (it >> 2) & 1, rb = it & 3, h = g * 8 + w, Rb = b * 2048 + c * 128 + rb * 32;
        u32x4 ya[4]; float rsa[4];
#pragma unroll
        for (int k = 0; k < 4; ++k) { const int q = tid + 512 * k, row = Rb + (q >> 6), c8 = (q & 63) * 8;
            ya[k] = *(const u32x4*)(Y + (size_t)row * 2048 + g * 512 + c8); rsa[k] = yss[(size_t)row * 4]; }
        f32x4 acc[2][4];
#pragma unroll
        for (int u = 0; u < 2; ++u)
#pragma unroll
            for (int j = 0; j < 4; ++j) acc[u][j] = (f32x4){0.f, 0.f, 0.f, 0.f};
        const bf16_t* ccp = CC + (size_t)(Rb + fr) * 256 + g * 128 + fq * 8;
        const bf16_t* hp = HPREV + (size_t)((b * 16 + c) * 16 + h) * 8192 + fr * 128 + fq * 8;
#pragma unroll
        for (int ks = 0; ks < 4; ++ks) { const bf16x8 a0 = *(const bf16x8*)(ccp + ks * 32), a1 = *(const bf16x8*)(ccp + 16 * 256 + ks * 32);
#pragma unroll
            for (int pj = 0; pj < 4; ++pj) { const bf16x8 bb = *(const bf16x8*)(hp + pj * 2048 + ks * 32); acc[0][pj] = mfma16(a0, bb, acc[0][pj]); acc[1][pj] = mfma16(a1, bb, acc[1][pj]); } }
        float yv[2][4][4], zv[2][4][4], ea[2][4];
#pragma unroll
        for (int u = 0; u < 2; ++u)
#pragma unroll
            for (int i = 0; i < 4; ++i) { const int r = Rb + u * 16 + fq * 4 + i; ea[u][i] = EAC[(size_t)r * 16 + h];
#pragma unroll
                for (int pj = 0; pj < 4; ++pj) { const int pc = pj * 16 + fr; yv[u][i][pj] = YD[(size_t)r * 1024 + h * 64 + pc]; zv[u][i][pj] = bf2f(PROJ[(size_t)r * 4608 + 2048 + h * 64 + pc]); } }
#pragma unroll
        for (int u = 0; u < 2; ++u)
#pragma unroll
            for (int i = 0; i < 4; ++i) { float ssq = 0.f;
#pragma unroll
                for (int pj = 0; pj < 4; ++pj) { const float y = (yv[u][i][pj] + ea[u][i] * acc[u][pj][i]) * zv[u][i][pj]; yv[u][i][pj] = y; ssq += y * y; }
                ssq += __shfl_xor(ssq, 1); ssq += __shfl_xor(ssq, 2); ssq += __shfl_xor(ssq, 4); ssq += __shfl_xor(ssq, 8);
                if (fr == 0) part[(u * 8 + w) * 16 + fq * 4 + i] = ssq; }
        if (!dry) {
#pragma unroll
            for (int k = 0; k < 4; ++k) { const int q = tid + 512 * k, row = Rb + (q >> 6), c8 = (q & 63) * 8; float f[8]; const float rs = rsqrtf(rsa[k] * (1.0f / 1024.0f) + EPS);
#pragma unroll
                for (int e = 0; e < 4; ++e) { f[2 * e] = __uint_as_float(ya[k][e] << 16) * rs; f[2 * e + 1] = __uint_as_float(ya[k][e] & 0xffff0000u) * rs; }
                *(u32x4*)(Y + (size_t)row * 2048 + g * 512 + c8) = pack8(f); } }
        __syncthreads();
#pragma unroll
        for (int u = 0; u < 2; ++u)
#pragma unroll
            for (int i = 0; i < 4; ++i) { float tot = 0.f;
#pragma unroll
                for (int hh = 0; hh < 8; ++hh) tot += part[(u * 8 + hh) * 16 + fq * 4 + i];
                const float rs = rsqrtf(tot * (1.0f / 512.0f) + EPS); const int r = Rb + u * 16 + fq * 4 + i;
#pragma unroll
                for (int pj = 0; pj < 4; ++pj) Y[(size_t)r * 2048 + 1024 + h * 64 + pj * 16 + fr] = f2bf(yv[u][i][pj] * rs); }
        __syncthreads();
    }
}

__device__ __forceinline__ void phase_ynorm(const Params& p, bool dry) {
    const float* yss = (const float*)(p.ws + OFF_SS) + 2 * 8448; bf16_t* Y = (bf16_t*)(p.ws + OFF_XB); bf16_t* Yd = dry ? (bf16_t*)(p.ws + OFF_ACT) : Y;
    const int total = MROWS * 256, stride = gridDim.x * 512;
    for (int base = blockIdx.x * 512 + threadIdx.x; base < total; base += 4 * stride) {
        u32x4 v[4]; float rs[4];
#pragma unroll
        for (int j = 0; j < 4; ++j) { const int i = min(base + j * stride, total - 1); const int row = i >> 8, c8 = (i & 255) * 8, seg = c8 < 1024 ? 0 : (c8 < 1536 ? 1 : 2);
            v[j] = *(const u32x4*)(Y + (size_t)row * 2048 + c8); rs[j] = rsqrtf(yss[(size_t)row * 4 + seg] * (seg ? (1.0f / 512.0f) : (1.0f / 1024.0f)) + EPS); }
#pragma unroll
        for (int j = 0; j < 4; ++j) { const int i = base + j * stride; if (i < total) { const int row = i >> 8, c8 = (i & 255) * 8; float f[8];
            f[0] = bf2f(v[j].x & 0xffffu); f[1] = bf2f(v[j].x >> 16); f[2] = bf2f(v[j].y & 0xffffu); f[3] = bf2f(v[j].y >> 16); f[4] = bf2f(v[j].z & 0xffffu); f[5] = bf2f(v[j].z >> 16); f[6] = bf2f(v[j].w & 0xffffu); f[7] = bf2f(v[j].w >> 16);
#pragma unroll
            for (int e = 0; e < 8; ++e) f[e] *= rs[j];
            *(u32x4*)(Yd + (size_t)row * 2048 + c8) = pack8(f); } }
    }
}
__device__ __forceinline__ void phase_final(const Params& p, LAS unsigned char* lds, bool dry) {
    float* dst = dry ? (float*)(p.ws + OFF_WTIN) : p.out;
    const int tid = threadIdx.x, lane = tid & 63, wv = tid >> 6, G = gridDim.x;
    f32x4 gf[8];
#pragma unroll
    for (int j = 0; j < 8; ++j) gf[j] = *(const f32x4*)(p.g_fin + j * 256 + lane * 4);
    {
        const bf16_t* hb = (const bf16_t*)(p.ws + OFF_HB);
        const int nw = G * 8; int row = blockIdx.x * 8 + wv;
        u32x2 v[8], vn[8];
        if (row < 8192) {
#pragma unroll
            for (int j = 0; j < 8; ++j) v[j] = *(const u32x2*)(hb + (size_t)row * 2048 + j * 256 + lane * 4); }
        while (row < 8192) {
            const int rn = row + nw;
            if (rn < 8192) {
#pragma unroll
                for (int j = 0; j < 8; ++j) vn[j] = *(const u32x2*)(hb + (size_t)rn * 2048 + j * 256 + lane * 4); }
            float s = 0.f; f32x4 f[8];
#pragma unroll
            for (int j = 0; j < 8; ++j) { f[j][0] = __uint_as_float(v[j].x << 16); f[j][1] = __uint_as_float(v[j].x & 0xffff0000u); f[j][2] = __uint_as_float(v[j].y << 16); f[j][3] = __uint_as_float(v[j].y & 0xffff0000u);
                s += f[j][0] * f[j][0] + f[j][1] * f[j][1] + f[j][2] * f[j][2] + f[j][3] * f[j][3]; }
#pragma unroll
            for (int o = 32; o >= 1; o >>= 1) s += __shfl_xor(s, o);
            const float rs = rsqrtf(s * (1.0f / 2048.0f) + EPS);
#pragma unroll
            for (int j = 0; j < 8; ++j) *(f32x4*)(dst + (size_t)row * 2048 + j * 256 + lane * 4) = f[j] * rs * gf[j];
#pragma unroll
            for (int j = 0; j < 8; ++j) v[j] = vn[j];
            row = rn;
        }
    }
    LAS float* red = (LAS float*)lds;
    for (int i = blockIdx.x; i < 128; i += G) { const float* part = (const float*)(p.ws + OFF_PARTD);
        f32x4 v = *(const f32x4*)(p.out + (size_t)(8192 + i) * 2048 + tid * 4);
#pragma unroll
        for (int sg = 0; sg < 11; ++sg) v += *(const f32x4*)(part + ((size_t)sg * 128 + i) * 2048 + tid * 4);
        float s = v[0] * v[0] + v[1] * v[1] + v[2] * v[2] + v[3] * v[3];
#pragma unroll
        for (int o = 32; o >= 1; o >>= 1) s += __shfl_xor(s, o);
        if (lane == 0) red[wv] = s;
        __syncthreads();
        float tot = 0.f;
#pragma unroll
        for (int k = 0; k < 8; ++k) tot += red[k];
        const float rs = rsqrtf(tot * (1.0f / 2048.0f) + EPS);
        const f32x4 g4 = *(const f32x4*)(p.g_fin + tid * 4);
        *(f32x4*)(dst + (size_t)(8192 + i) * 2048 + tid * 4) = v * rs * g4;
        __syncthreads();
    }
}

__device__ __forceinline__ void phase_hfix(const Params& p, bool dry) {
    const int lane = threadIdx.x & 63, wv = threadIdx.x >> 6, i = blockIdx.x * 8 + wv;
    if (i < 128) { const int row = 8192 + i; bf16_t* hb = (bf16_t*)(p.ws + OFF_HB); float* hss = (float*)(p.ws + (dry ? OFF_SS2 : OFF_SS)) + 6 * 8448; const float* part = (const float*)(p.ws + OFF_PARTO); float s = 0.f;
        f32x4 hv[8];
#pragma unroll
        for (int j = 0; j < 8; ++j) { hv[j] = *(const f32x4*)(p.xs + (size_t)i * 2048 + j * 256 + lane * 4);
#pragma unroll
            for (int sg = 0; sg < 8; ++sg) hv[j] += *(const f32x4*)(part + ((size_t)sg * 128 + i) * 2048 + j * 256 + lane * 4); }
#pragma unroll
        for (int j = 0; j < 8; ++j) { const f32x4 v = hv[j]; s += v[0] * v[0] + v[1] * v[1] + v[2] * v[2] + v[3] * v[3];
            *(f32x4*)(p.out + (size_t)row * 2048 + j * 256 + lane * 4) = v;
            u32x2 o; o.x = cvt_pk_bf16(v[0], v[1]); o.y = cvt_pk_bf16(v[2], v[3]); *(u32x2*)(hb + (size_t)row * 2048 + j * 256 + lane * 4) = o; }
#pragma unroll
        for (int o = 32; o >= 1; o >>= 1) s += __shfl_xor(s, o);
        if (lane == 0) hss[row] = s; }
}

#define XB_TMO      128
#define XB_XCNT(j)  (256  + 64 * (j))
#define XB_XSUB(j)  (1280 + 64 * (j))
#define XB_XGEN(j)  (2304 + 64 * (j))
#define XB_TOP      3328
#define XB_TOPGEN   3392
#define XCD_BAR_WORDS 3456
#define XB_SPIN_CAP (1u << 18)

__device__ __forceinline__ unsigned xb_ld(unsigned* p)              { return __hip_atomic_load(p, __ATOMIC_RELAXED, __HIP_MEMORY_SCOPE_AGENT); }
__device__ __forceinline__ unsigned xb_add(unsigned* p, unsigned v) { return __hip_atomic_fetch_add(p, v, __ATOMIC_RELAXED, __HIP_MEMORY_SCOPE_AGENT); }
__device__ __forceinline__ unsigned xb_xcc_id() { return (unsigned)__builtin_amdgcn_s_getreg((3 << 11) | 20) & 0xFu; }
#define XB_SPIN(cond, bar) do { unsigned _sp = 0; while (cond) { __builtin_amdgcn_s_sleep(1); \
    if ((++_sp & 255u) == 0u) { if (xb_ld(&(bar)[XB_TMO])) break; if (_sp > XB_SPIN_CAP) { atomicAdd(&(bar)[XB_TMO], 1u); break; } } } } while (0)

struct XcdBarrier {
    unsigned* bar; unsigned x;
    volatile __attribute__((address_space(3))) unsigned* st;
};

__device__ __forceinline__ XcdBarrier xcd_barrier_post(unsigned* bar, volatile __attribute__((address_space(3))) unsigned* st) {
    XcdBarrier b; b.bar = bar; b.x = xb_xcc_id(); b.st = st;
    if (threadIdx.x == 0) (void)xb_add(&bar[XB_XCNT(b.x)], 1u);
    return b;
}
__device__ __forceinline__ void xcd_barrier_complete(unsigned* bar, unsigned x, unsigned& nloc, unsigned& nx) {
    const unsigned G = gridDim.x * gridDim.y * gridDim.z;
    unsigned sum, cnt, mine, sp = 0u;
    for (;;) {
        sum = 0u; cnt = 0u; mine = 0u;
#pragma unroll
        for (unsigned j = 0; j < 16; ++j) { const unsigned c = xb_ld(&bar[XB_XCNT(j)]); sum += c; cnt += (c > 0u) ? 1u : 0u; mine = (j == x) ? c : mine; }
        if (sum == G) break;
        __builtin_amdgcn_s_sleep(1);
        if ((++sp & 255u) == 0u) { if (xb_ld(&bar[XB_TMO])) break; if (sp > XB_SPIN_CAP) { atomicAdd(&bar[XB_TMO], 1u); break; } }
    }
    nloc = mine > 0u ? mine : 1u; nx = cnt > 0u ? cnt : 1u;
}

__device__ __forceinline__ void xcd_barrier(const XcdBarrier& b) {
    asm volatile("s_waitcnt vmcnt(0)" ::: "memory");
    __syncthreads();
    if (threadIdx.x == 0) {
        unsigned* bar = b.bar;
        __builtin_amdgcn_s_waitcnt(0);
        unsigned nloc = b.st[0], nx = b.st[1];
        if (nloc == 0u) { xcd_barrier_complete(bar, b.x, nloc, nx); b.st[0] = nloc; b.st[1] = nx; }
        const unsigned old = xb_add(&bar[XB_XSUB(b.x)], 1u);
        const unsigned gen = old / nloc;
        if (old + 1u == (gen + 1u) * nloc) {
            __builtin_amdgcn_fence(__ATOMIC_RELEASE, "agent");
            asm volatile("s_waitcnt vmcnt(0)" ::: "memory");
            const unsigned og = xb_add(&bar[XB_TOP], 1u);
            const unsigned tg = og / nx;
            if (og + 1u == (tg + 1u) * nx) xb_add(&bar[XB_TOPGEN], 1u);
            else XB_SPIN(xb_ld(&bar[XB_TOPGEN]) == tg, bar);
            __builtin_amdgcn_fence(__ATOMIC_ACQUIRE, "agent");
            xb_add(&bar[XB_XGEN(b.x)], 1u);
            asm volatile("s_waitcnt vmcnt(0)" ::: "memory");
        } else {
            XB_SPIN(xb_ld(&bar[XB_XGEN(b.x)]) == gen, bar);
            __builtin_amdgcn_fence(__ATOMIC_ACQUIRE, "agent");
            asm volatile("s_waitcnt vmcnt(0)" ::: "memory");
        }
    }
    __syncthreads();
}

__global__ void __launch_bounds__(512, 2) mega(Params p) {
    extern __shared__ __attribute__((aligned(16))) unsigned char lds_raw[];
    LAS unsigned char* lds = (LAS unsigned char*)lds_raw;
    unsigned char* ws = p.ws; float* ss = (float*)(ws + OFF_SS);
    volatile LAS unsigned* bst = (volatile LAS unsigned*)(lds + LDS_BAR_OFF);
    if (threadIdx.x < 4) bst[threadIdx.x] = 0u;
    __syncthreads();
    if (p.ph_hi > 1000) cg::this_grid().sync();
    const XcdBarrier bar = xcd_barrier_post((unsigned*)(ws + OFF_CTL), bst);
#ifndef PHMASK
#define PHMASK 0x3ff
#endif
#define PH_ON(k) ((PHMASK >> (k)) & 1) && p.ph_lo <= (k) && (k) < p.ph_hi
#define PH_SYNC(k) if (p.ph_lo <= (k) && (k) + 1 < p.ph_hi) xcd_barrier(bar);
#ifdef REPMASK
#define REPLOOP(k) for (int rep = ((REPMASK >> (k)) & 1) ? ((p.repmask >> (k)) & 1) : 0; rep >= 0; --rep)
#else
#define REPLOOP(k) for (int rep = 0; rep >= 0; --rep)
#endif
#define REPBAR if (rep) xcd_barrier(bar);
    if (PH_ON(0)) REPLOOP(0) { phase_prep(p, lds); REPBAR }
    PH_SYNC(0)
    if (PH_ON(1)) REPLOOP(1) { pg8::Gemm g; g.A = (const bf16_t*)(ws + OFF_XB); g.Bt = (const bf16_t*)(ws + OFF_WTIN); g.M = MPAD; g.N = 4864; g.K = 2048; g.ld = 2048;
        pg8::StaticOrder S; S.init(MPAD, 4864, (int)gridDim.x, (int)blockIdx.x, 2048);
        EpiProj E; E.proj = (bf16_t*)(ws + OFF_PROJ); E.dt = (float*)(ws + OFF_DT); E.xss = ss; E.vss = (float*)(ws + (rep ? OFF_SS2 : OFF_SS)) + 8448;
        pg8::gemm_phase<EpiProj, pg8::StaticOrder, false>(lds, g, S, E, nullptr);
        if (!rep && blockIdx.x >= 115) wt_convert(p, lds, 1184, 4512, (int)blockIdx.x - 115, (int)gridDim.x - 115);
        REPBAR }
    PH_SYNC(1)
    if (PH_ON(2)) REPLOOP(2) { phase_conv(p, lds); xcd_barrier(bar); phase_mixer(p, lds, rep != 0); REPBAR }
    PH_SYNC(2)
    if (PH_ON(3)) REPLOOP(3) { phase_scan(p, rep != 0); REPBAR }
    PH_SYNC(3)
    if (PH_ON(4)) REPLOOP(4) { phase_combine(p, lds, rep != 0); REPBAR }
    PH_SYNC(4)
    if (PH_ON(6)) REPLOOP(6) { pg8::Gemm g; g.A = (const bf16_t*)(ws + OFF_XB); g.Bt = (const bf16_t*)(ws + OFF_WTOUT); g.M = MPAD; g.N = 2048; g.K = 2048; g.ld = 2048;
        OutOrder S; S.c = (int)blockIdx.x;
        EpiOut E; E.xp = p.xp; E.xs = p.xs; E.hout = p.out; E.hb = (bf16_t*)(ws + OFF_HB); E.part = (float*)(ws + OFF_PARTO); E.hss = (float*)(ws + (rep ? OFF_SS2 : OFF_SS)) + 6 * 8448;
        pg8::gemm_phase<EpiOut, OutOrder, false>(lds, g, S, E, nullptr); REPBAR }
    PH_SYNC(6)
    if (PH_ON(7)) REPLOOP(7) { pg8::Gemm g; g.A = (const bf16_t*)(ws + OFF_HB); g.Bt = (const bf16_t*)(ws + OFF_WTGU); g.M = MPAD; g.N = 11264; g.K = 2048; g.ld = 2048;
        unsigned* hflag = (unsigned*)(ws + OFF_CTL + 15360);
        if (blockIdx.x < 16) { phase_hfix(p, false); __threadfence(); __syncthreads(); if (threadIdx.x == 0) __hip_atomic_fetch_add(hflag, 1u, __ATOMIC_RELAXED, __HIP_MEMORY_SCOPE_AGENT); }
        GuDepOrder S; S.init(MPAD, 11264, (int)gridDim.x, (int)blockIdx.x, 2048); S.flag = hflag;
        EpiGU E; E.act = (bf16_t*)(ws + OFF_ACT); E.hss = ss + 6 * 8448;
        pg8::gemm_phase<EpiGU, GuDepOrder, false>(lds, g, S, E, nullptr);
        if (!rep && blockIdx.x >= 172) wt_convert(p, lds, 4512, 5920, (int)blockIdx.x - 172, (int)gridDim.x - 172);
        REPBAR }
    PH_SYNC(7)
    if (PH_ON(8)) REPLOOP(8) { pg8::Gemm g; g.A = (const bf16_t*)(ws + OFF_ACT); g.Bt = (const bf16_t*)(ws + OFF_WTDN); g.M = MPAD; g.N = 2048; g.K = 5632; g.ld = LD_DN;
        DownOrder S; S.c = (int)blockIdx.x;
        EpiDown E; E.hb = (bf16_t*)(ws + OFF_HB); E.hdst = rep ? (float*)(ws + OFF_WTIN) : p.out; E.part = (float*)(ws + OFF_PARTD);
        pg8::gemm_phase<EpiDown, DownOrder, false>(lds, g, S, E, nullptr); REPBAR }
    PH_SYNC(8)
    if (PH_ON(9)) REPLOOP(9) { phase_final(p, lds, rep != 0); REPBAR }
}

#ifndef N_LAUNCHES
#define N_LAUNCHES 1
#endif
extern "C" void kernel_launch(void* const* d_in, const int* in_sizes, int n_in, void* d_out, int out_size, void* d_ws, size_t ws_size, hipStream_t stream) {
    static int grid = 0;
    if (grid == 0) {
        if (n_in != 22 || ws_size < WS_NEED) { fprintf(stderr, "kernel_launch: bad inputs n_in %d ws %zu need %zu\n", n_in, ws_size, (size_t)WS_NEED); grid = -1; return; }
        int dev = 0, cus = 0, per_cu = 0;
        (void)hipGetDevice(&dev); (void)hipDeviceGetAttribute(&cus, hipDeviceAttributeMultiprocessorCount, dev);
        if (hipFuncSetAttribute((const void*)mega, hipFuncAttributeMaxDynamicSharedMemorySize, LDS_BYTES) != hipSuccess) { fprintf(stderr, "kernel_launch: hipFuncSetAttribute failed\n"); grid = -1; return; }
        if (hipOccupancyMaxActiveBlocksPerMultiprocessor(&per_cu, (const void*)mega, 512, LDS_BYTES) != hipSuccess || per_cu < 1) { fprintf(stderr, "kernel_launch: occupancy query says %d\n", per_cu); per_cu = 1; }
        (void)hipGetLastError();
        grid = cus > 0 ? cus : 256;
    }
    if (grid < 0) return;
    if (hipMemsetAsync((char*)d_ws + OFF_CTL, 0, 16384, stream) != hipSuccess) { fprintf(stderr, "kernel_launch: memset failed\n"); return; }
    Params p{};
    const float** pin = (const float**)&p;
    for (int i = 0; i < 22; ++i) pin[i] = (const float*)d_in[i];
    p.out = (float*)d_out; p.ws = (unsigned char*)d_ws;
#ifdef REPMASK
    p.repmask = REPMASK;
#endif
#if N_LAUNCHES == 1
    p.ph_lo = 0; p.ph_hi = NPHASE;
    void* args[] = {&p};
    hipError_t e = hipLaunchCooperativeKernel((const void*)mega, dim3(grid), dim3(512), args, LDS_BYTES, stream);
    if (e != hipSuccess) fprintf(stderr, "cooperative launch failed: %s (grid %d)\n", hipGetErrorString(e), grid);
#else
    for (int ph = 0; ph < NPHASE; ++ph) { p.ph_lo = ph; p.ph_hi = ph + 1; hipLaunchKernelGGL(mega, dim3(grid), dim3(512), LDS_BYTES, stream, p); }
#endif
}
```

```cpp
#include <hip/hip_runtime.h>
#include <hip/hip_cooperative_groups.h>
#include <cstdio>
namespace cg = cooperative_groups;
namespace pg8 {
#define PG8_LAS __attribute__((address_space(3)))
typedef unsigned short bf16_t;
typedef short bf16x8 __attribute__((ext_vector_type(8)));
typedef float f32x4 __attribute__((ext_vector_type(4)));
typedef unsigned u32x4 __attribute__((ext_vector_type(4)));
constexpr int BM = 256, BK = 64, HALF = 128, HTB = HALF * BK * 2  , STAGE_BYTES = 8 * HTB, NXCD = 8, WGM = 8;

__host__ __device__ __forceinline__ int lds_byte(int r, int c) { const int st = (r >> 4) * 2 + (c >> 5), rr = r & 15, cc = c & 31, ob = rr * 64 + cc * 2; return st * 1024 + (ob ^ (((ob >> 9) & 1) << 5)); }
__host__ __device__ __forceinline__ void stage_rc(int b, int& R, int& C) { const int st = b / 1024, sb = b % 1024, swz = sb ^ (((sb >> 9) & 1) << 5); R = (st >> 1) * 16 + swz / 64; C = (st & 1) * 32 + (swz % 64) / 2; }
__host__ __device__ __forceinline__ int perm32(int rho) { const int n = rho >> 4, i = rho & 15; return 8 * (i >> 2) + 4 * n + (i & 3); }

struct Unit { int pm, pn, k0, nk; };
struct Gemm { const bf16_t* A; const bf16_t* Bt; int M, N, K, ld; };

struct StaticOrder {
    int nM, nN, nwg, G, c, ntk;
    __host__ __device__ void init(int M, int N, int G_, int c_, int K_) { nM = M / BM; nN = N / BM; nwg = nM * nN; G = G_; c = c_; ntk = K_ / BK; }
    __host__ __device__ bool next(int i, Unit& u) const {
        const long L = (long)i * G + c; if (L >= nwg) return false;
        int wgid = (int)L; { const int q = nwg / NXCD, r = nwg % NXCD, xcd = wgid % NXCD, off = wgid / NXCD; wgid = (xcd < r ? xcd * (q + 1) : r * (q + 1) + (xcd - r) * q) + off; }
        const int nig = WGM * nN, gid = wgid / nig, fm = gid * WGM, gsz = (nM - fm) < WGM ? (nM - fm) : WGM;
        u.pm = fm + ((wgid % nig) % gsz); u.pn = (wgid % nig) / gsz; u.k0 = 0; u.nk = ntk; return true;
    }
    __device__ __forceinline__ void a_ready(const Unit&) const {}
    __device__ __forceinline__ void done(const Unit&) const {}
};
__device__ __forceinline__ unsigned cvt_pk_bf16(float lo, float hi) { unsigned r; asm volatile("v_cvt_pk_bf16_f32 %0, %1, %2" : "=v"(r) : "v"(lo), "v"(hi)); return r; }

template <class Epi, class Sched, bool STAMP = false>
__device__ __forceinline__ void gemm_phase(PG8_LAS unsigned char* lds, const Gemm g, const Sched& S, const Epi& E, unsigned long long* stamps) {
    int tid_ = threadIdx.x; asm volatile("" : "+v"(tid_));
    const int tid = tid_, wid = __builtin_amdgcn_readfirstlane(tid >> 6), lane = tid & 63, wr = wid >> 2, wc = wid & 3, fr = lane & 15, fq = lane >> 4;
    const int K = g.ld;
    int ts_lo = 0, ts_hi = 0, nts = 0; const unsigned long long rt_entry = STAMP ? (unsigned long long)wall_clock64() : 0ull;
#define PG8_STAMP() do { if (STAMP && wid == 0 && nts < 64) { const unsigned long long _c = (unsigned long long)clock64(); \
        ts_lo = (lane == nts) ? (int)(unsigned)_c : ts_lo; ts_hi = (lane == nts) ? (int)(unsigned)(_c >> 32) : ts_hi; ++nts; } } while (0)
    PG8_STAMP();
    unsigned voffA[2], voffB[2];
#pragma unroll
    for (int i = 0; i < 2; ++i) { int R, C; stage_rc(tid * 16 + i * 8192, R, C); const int Rb = Epi::PERM ? ((R & ~31) + perm32(R & 31)) : R;
        voffA[i] = (unsigned)(R * K + C) * 2u; voffB[i] = (unsigned)(Rb * K + C) * 2u; }
    const size_t kstep = (size_t)(BK * 2);
    const size_t hstep = (size_t)HALF * K * 2;
    const size_t tstep = 2 * hstep;
    const unsigned ldsw = (unsigned)wid * 1024u;
    const int aoff = lds_byte(wr * 64 + fr, fq * 8), boff = lds_byte(wc * 32 + fr, fq * 8);
#define PG8_SA(b, h) (((b) * 2 + (h)) * HTB)
#define PG8_SB(b, h) ((4 + (b) * 2 + (h)) * HTB)
#define PG8_STAGE(bufoff, gbase, voff) do { _Pragma("unroll") for (int _i = 0; _i < 2; ++_i) \
        __builtin_amdgcn_global_load_lds((const unsigned*)((const char*)(gbase) + (voff)[_i]), (PG8_LAS unsigned*)(lds + (bufoff) + ldsw + _i * 8192), 16, 0, 0); } while (0)
#define PG8_LDA(dst, b, h) do { _Pragma("unroll") for (int m = 0; m < 4; ++m) _Pragma("unroll") for (int k = 0; k < 2; ++k) dst[m][k] = *(const PG8_LAS bf16x8*)(lds + PG8_SA(b, h) + aoff + m * 2048 + k * 1024); } while (0)
#define PG8_LDB(dst, b, h) do { _Pragma("unroll") for (int n = 0; n < 2; ++n) _Pragma("unroll") for (int k = 0; k < 2; ++k) dst[n][k] = *(const PG8_LAS bf16x8*)(lds + PG8_SB(b, h) + boff + n * 2048 + k * 1024); } while (0)
#define PG8_MMA(ai, bj, At, Bt) do { __builtin_amdgcn_s_setprio(1); _Pragma("unroll") for (int m = 0; m < 4; ++m) _Pragma("unroll") for (int n = 0; n < 2; ++n) _Pragma("unroll") for (int k = 0; k < 2; ++k) \
        acc[ai][bj][m][n] = __builtin_amdgcn_mfma_f32_16x16x32_bf16(Bt[n][k], At[m][k], acc[ai][bj][m][n], 0, 0, 0); __builtin_amdgcn_s_setprio(0); } while (0)
#define PG8_WAIT_V(n) asm volatile("s_waitcnt vmcnt(" #n ")" ::: "memory")
#define PG8_WAIT_L(n) asm volatile("s_waitcnt lgkmcnt(" #n ")" ::: "memory")
#define PG8_BAR __builtin_amdgcn_s_barrier()
#define PG8_SCHED __builtin_amdgcn_sched_barrier(0)
    Unit cur, nxt; int ui = 0;
    if (!S.next(0, cur)) return;
    f32x4 acc[2][2][4][2];
#pragma unroll
    for (int a = 0; a < 2; ++a)
#pragma unroll
        for (int b = 0; b < 2; ++b)
#pragma unroll
            for (int m = 0; m < 4; ++m)
#pragma unroll
                for (int n = 0; n < 2; ++n) acc[a][b][m][n] = (f32x4){0.f, 0.f, 0.f, 0.f};
    bf16x8 At[4][2], B0[2][2], B1[2][2];
    const char* cA = (const char*)g.A + (size_t)cur.pm * tstep + (size_t)cur.k0 * kstep; const char* cB = (const char*)g.Bt + (size_t)cur.pn * tstep + (size_t)cur.k0 * kstep;
    S.a_ready(cur);
    float pre8[8]; E.prefetch(cur, wr, fr, pre8);
    PG8_STAGE(PG8_SB(0, 0), cB, voffB); PG8_STAGE(PG8_SA(0, 0), cA, voffA); PG8_STAGE(PG8_SB(0, 1), cB + hstep, voffB); PG8_STAGE(PG8_SA(0, 1), cA + hstep, voffA);
    if (wr == 1) PG8_BAR;
    PG8_WAIT_V(4); PG8_BAR;
    PG8_STAGE(PG8_SB(1, 0), cB + kstep, voffB); PG8_STAGE(PG8_SA(1, 0), cA + kstep, voffA); PG8_STAGE(PG8_SB(1, 1), cB + hstep + kstep, voffB);
    PG8_WAIT_V(6); PG8_BAR;
    PG8_STAMP();
    for (;;) {
        const bool has_next = S.next(ui + 1, nxt);
        const char* nA = has_next ? (const char*)g.A + (size_t)nxt.pm * tstep + (size_t)nxt.k0 * kstep : cA; const char* nB = has_next ? (const char*)g.Bt + (size_t)nxt.pn * tstep + (size_t)nxt.k0 * kstep : cB;
        const int nt = cur.nk;
        for (int t = 0; t < nt; t += 2) {
            const bool last = (t == nt - 2);
            const char* a1 = cA + (size_t)(t + 1) * kstep;
            const char* a2 = last ? nA : cA + (size_t)(t + 2) * kstep; const char* b2 = last ? nB : cB + (size_t)(t + 2) * kstep;
            const char* a3 = a2 + kstep; const char* b3 = b2 + kstep;
            if (last && has_next) S.a_ready(nxt);
            PG8_LDB(B0, 0, 0); PG8_SCHED; PG8_LDA(At, 0, 0); PG8_STAGE(PG8_SA(1, 1), a1 + hstep, voffA);
            PG8_WAIT_L(8); PG8_BAR; PG8_WAIT_L(0); PG8_MMA(0, 0, At, B0); PG8_BAR; PG8_SCHED;
            PG8_LDB(B1, 0, 1); PG8_STAGE(PG8_SB(0, 0), b2, voffB);
            PG8_BAR; PG8_WAIT_L(0); PG8_MMA(0, 1, At, B1); PG8_BAR;
            PG8_LDA(At, 0, 1); PG8_STAGE(PG8_SA(0, 0), a2, voffA);
            PG8_BAR; PG8_WAIT_L(0); PG8_MMA(1, 0, At, B0); PG8_BAR; PG8_SCHED;
            PG8_STAGE(PG8_SB(0, 1), b2 + hstep, voffB);
            PG8_WAIT_V(6); PG8_BAR; PG8_MMA(1, 1, At, B1); PG8_BAR;
            PG8_LDB(B0, 1, 0); PG8_SCHED; PG8_LDA(At, 1, 0); PG8_STAGE(PG8_SA(0, 1), a2 + hstep, voffA);
            PG8_WAIT_L(8); PG8_BAR; PG8_WAIT_L(0); PG8_MMA(0, 0, At, B0); PG8_BAR; PG8_SCHED;
            PG8_LDB(B1, 1, 1); PG8_STAGE(PG8_SB(1, 0), b3, voffB);
            PG8_BAR; PG8_WAIT_L(0); PG8_MMA(0, 1, At, B1); PG8_BAR;
            PG8_LDA(At, 1, 1); PG8_STAGE(PG8_SA(1, 0), a3, voffA);
            PG8_BAR; PG8_WAIT_L(0); PG8_MMA(1, 0, At, B0); PG8_BAR; PG8_SCHED;
            PG8_STAGE(PG8_SB(1, 1), b3 + hstep, voffB);
            PG8_WAIT_V(6); PG8_BAR; PG8_MMA(1, 1, At, B1); PG8_BAR;
        }
        PG8_STAMP();
        if constexpr (!Epi::AFTER_DRAIN) { E(acc, cur, wr, wc, fr, fq, pre8); S.done(cur); }
        PG8_STAMP();
        if (!has_next) break;
#pragma unroll
        for (int a = 0; a < 2; ++a)
#pragma unroll
            for (int b = 0; b < 2; ++b)
#pragma unroll
                for (int m = 0; m < 4; ++m)
#pragma unroll
                    for (int n = 0; n < 2; ++n) acc[a][b][m][n] = (f32x4){0.f, 0.f, 0.f, 0.f};
        cur = nxt; cA = nA; cB = nB; ++ui; E.prefetch(cur, wr, fr, pre8);
    }
    PG8_WAIT_V(0);
    if (wr == 0) PG8_BAR;
    PG8_BAR;
    if constexpr (Epi::AFTER_DRAIN) { E.fused(acc, cur, wr, wc, fr, fq, lds, wid, lane); S.done(cur); }
    PG8_STAMP();
    if (STAMP && wid == 0) { stamps[lane] = lane < nts ? (((unsigned long long)(unsigned)ts_hi << 32) | (unsigned)ts_lo) : 0ull;
        if (lane == 62) stamps[62] = rt_entry; if (lane == 63) stamps[63] = (unsigned long long)wall_clock64(); }
#undef PG8_STAMP
#undef PG8_SA
#undef PG8_SB
#undef PG8_STAGE
#undef PG8_LDA
#undef PG8_LDB
#undef PG8_MMA
#undef PG8_WAIT_V
#undef PG8_WAIT_L
#undef PG8_BAR
#undef PG8_SCHED
}
}

#define LAS __attribute__((address_space(3)))
using pg8::bf16_t; using pg8::bf16x8; using pg8::f32x4; using pg8::u32x4; using pg8::cvt_pk_bf16;
typedef unsigned u32x2 __attribute__((ext_vector_type(2)));

constexpr float EPS = 1e-6f;
constexpr int MROWS = 8320, MPAD = 8448;
constexpr int LDS_BAR_OFF = 157696;
constexpr int LDS_BYTES = LDS_BAR_OFF + 256;
constexpr int NPHASE = 10;
constexpr int LD_DN = 5632 + 64;

constexpr size_t OFF_WTIN = 0;
constexpr size_t OFF_WTOUT = OFF_WTIN + 4864ull * 2048 * 2;
constexpr size_t OFF_WTGU = OFF_WTOUT + 2048ull * 2048 * 2;
constexpr size_t OFF_WTDN = OFF_WTGU + 11264ull * 2048 * 2;
constexpr size_t OFF_SS = OFF_WTDN + 2048ull * LD_DN * 2;
constexpr size_t OFF_CTL = OFF_SS + 8448ull * 8 * 4;
constexpr size_t OFF_EAL = OFF_CTL + 16384;
constexpr size_t OFF_XB = OFF_EAL + 4096;
constexpr size_t OFF_C = OFF_XB + 8448ull * 2048 * 2;
constexpr size_t OFF_PROJ = OFF_C;
constexpr size_t OFF_DT = OFF_PROJ + 8448ull * 4608 * 2;
constexpr size_t OFF_STATES = OFF_DT + 8448ull * 16 * 4;
constexpr size_t OFF_HPREV = OFF_STATES + 64ull * 16 * 8192 * 4;
constexpr size_t OFF_YD = OFF_HPREV + 64ull * 16 * 8192 * 2;
constexpr size_t OFF_CC = OFF_YD + 8192ull * 1024 * 4;
constexpr size_t OFF_EAC = OFF_CC + 8192ull * 256 * 2;
constexpr size_t OFF_BN = OFF_EAC + 8192ull * 16 * 4;
constexpr size_t OFF_BTT = OFF_BN + 8192ull * 256 * 2;
constexpr size_t OFF_FA = OFF_BTT + 64ull * 256 * 128 * 2;
constexpr size_t OFF_FD = OFF_FA + 1024ull * 128 * 4;
constexpr size_t OFF_FW = OFF_FD + 1024ull * 128 * 4;
constexpr size_t END_C1 = OFF_FW + 1024ull * 128 * 4;
constexpr size_t OFF_XT = OFF_HPREV;
constexpr size_t OFF_HB = OFF_C;
constexpr size_t OFF_ACT = OFF_HB + 8448ull * 2048 * 2;
constexpr size_t END_C2 = OFF_ACT + 8448ull * LD_DN * 2;
constexpr size_t OFF_PARTO = OFF_ACT;
constexpr size_t OFF_PARTD = OFF_WTIN;
constexpr size_t OFF_SS2 = END_C1 > END_C2 ? END_C1 : END_C2;
constexpr size_t WS_NEED = OFF_SS2 + 8448ull * 8 * 4;

constexpr size_t O_Y = 0, O_CONVP = 17039360, O_SSMP = 17057792, O_CONVS = 17582080, O_SSMS = 18171904, O_VS = 34949120;

struct Params {
    const float* xp; const float* xs; const float* sconv; const float* sssm; const float* g_mix; const float* w_in; const float* g_cv; const float* w_s; const float* b_s;
    const float* g_co; const float* conv_w; const float* conv_b; const float* dt_bias; const float* a_log; const float* dvec; const float* g_sn; const float* w_out;
    const float* g_ffn; const float* w_gate; const float* w_up; const float* w_down; const float* g_fin;
    float* out; unsigned char* ws; int ph_lo, ph_hi; int repmask, pad;
};

__device__ __forceinline__ float bf2f(unsigned v) { return __uint_as_float(v << 16); }
__device__ __forceinline__ bf16_t f2bf(float x) { return (bf16_t)(cvt_pk_bf16(x, x) & 0xffffu); }
__device__ __forceinline__ float sigmoid_f(float x) { return __builtin_amdgcn_rcpf(1.0f + __expf(-x)); }
__device__ __forceinline__ float silu_f(float x) { return x * sigmoid_f(x); }
__device__ __forceinline__ float gelu_f(float x) { return x * sigmoid_f(1.5957691216f * (x + 0.044715f * x * x * x)); }
__device__ __forceinline__ float softplus_f(float x) { return x > 20.f ? x : log1pf(expf(x)); }
__device__ __forceinline__ f32x4 mfma16(bf16x8 a, bf16x8 b, f32x4 c) { return __builtin_amdgcn_mfma_f32_16x16x32_bf16(a, b, c, 0, 0, 0); }
__device__ __forceinline__ u32x4 pack8(const float* v) { u32x4 o; o.x = cvt_pk_bf16(v[0], v[1]); o.y = cvt_pk_bf16(v[2], v[3]); o.z = cvt_pk_bf16(v[4], v[5]); o.w = cvt_pk_bf16(v[6], v[7]); return o; }

struct EpiProj {
    static constexpr bool PERM = true, AFTER_DRAIN = false;
    bf16_t* proj; float* dt; const float* xss; float* vss;
    __device__ __forceinline__ void prefetch(const pg8::Unit& u, int wr, int fr, float (&pre)[8]) const {
#pragma unroll
        for (int q = 0; q < 8; ++q) pre[q] = xss[u.pm * 256 + wr * 64 + fr + (q >> 2) * 128 + (q & 3) * 16]; }
    __device__ __forceinline__ void operator()(const f32x4 (&acc)[2][2][4][2], const pg8::Unit& u, int wr, int wc, int fr, int fq, const float (&pre)[8]) const {
        const int row0 = u.pm * 256 + wr * 64 + fr, pn = u.pn;
        float rs8[2][4];
#pragma unroll
        for (int ai = 0; ai < 2; ++ai)
#pragma unroll
            for (int m = 0; m < 4; ++m) rs8[ai][m] = rsqrtf(pre[ai * 4 + m] * (1.0f / 2048.0f) + EPS);
        if (pn == 18) {
            if (wc == 0 && fq < 2) {
#pragma unroll
                for (int ai = 0; ai < 2; ++ai)
#pragma unroll
                    for (int m = 0; m < 4; ++m) { const int row = row0 + ai * 128 + m * 16; const float rs = rs8[ai][m];
                        float* d = dt + (size_t)row * 16 + fq * 8; *(f32x4*)d = acc[ai][0][m][0] * rs; *(f32x4*)(d + 4) = acc[ai][0][m][1] * rs; }
            }
            return;
        }
        const int kind = pn < 4 ? 0 : pn < 8 ? 1 : pn < 12 ? 2 : 3;
        const int col0 = pn * 256 + wc * 32 + 8 * fq;
#pragma unroll
        for (int ai = 0; ai < 2; ++ai)
#pragma unroll
            for (int m = 0; m < 4; ++m) { const int row = row0 + ai * 128 + m * 16; const float rs = rs8[ai][m]; float ssq = 0.f;
#pragma unroll
                for (int bj = 0; bj < 2; ++bj) { float v[8];
#pragma unroll
                    for (int j = 0; j < 4; ++j) { v[j] = acc[ai][bj][m][0][j] * rs; v[4 + j] = acc[ai][bj][m][1][j] * rs; }
                    if (kind <= 1) {
#pragma unroll
                        for (int j = 0; j < 8; ++j) v[j] = gelu_f(v[j]);
                    } else if (kind == 2) {
#pragma unroll
                        for (int j = 0; j < 8; ++j) v[j] = silu_f(v[j]);
                    }
                    if (kind == 1) {
#pragma unroll
                        for (int j = 0; j < 8; ++j) ssq += v[j] * v[j];
                    }
                    *(u32x4*)(proj + (size_t)row * 4608 + col0 + bj * 128) = pack8(v); }
                if (kind == 1) { ssq += __shfl_xor(ssq, 16); ssq += __shfl_xor(ssq, 32); if (fq == 0) unsafeAtomicAdd(vss + row, ssq); }
            }
    }
};
struct EpiOut {
    static constexpr bool PERM = false, AFTER_DRAIN = false;
    const float* xp; const float* xs; float* hout; bf16_t* hb; float* hss; float* part;
    __device__ __forceinline__ void prefetch(const pg8::Unit&, int, int, float (&)[8]) const {}
    __device__ __forceinline__ void operator()(const f32x4 (&acc)[2][2][4][2], const pg8::Unit& u, int wr, int wc, int fr, int fq, const float (&pre)[8]) const {
        const int row0 = u.pm * 256 + wr * 64 + fr, col0 = u.pn * 256 + wc * 32 + 4 * fq;
        if (u.nk < 32) {
            float* pp = part + ((size_t)(u.k0 >> 2) * 128 + (wr * 64 + fr)) * 2048 + col0;
#pragma unroll
            for (int m = 0; m < 4; ++m)
#pragma unroll
                for (int bj = 0; bj < 2; ++bj)
#pragma unroll
                    for (int n = 0; n < 2; ++n) *(f32x4*)(pp + (size_t)m * 16 * 2048 + bj * 128 + n * 16) = acc[0][bj][m][n];
            return;
        }
#pragma unroll
        for (int am = 0; am < 4; ++am) { const int ai = am >> 1, mb = (am & 1) * 2;
            f32x4 xv[2][2][2];
#pragma unroll
            for (int mm = 0; mm < 2; ++mm) { const int row = row0 + ai * 128 + (mb + mm) * 16; const float* xr = xp + (size_t)row * 2048 + col0;
#pragma unroll
                for (int bj = 0; bj < 2; ++bj)
#pragma unroll
                    for (int n = 0; n < 2; ++n) xv[mm][bj][n] = *(const f32x4*)(xr + bj * 128 + n * 16); }
#pragma unroll
            for (int mm = 0; mm < 2; ++mm)
#pragma unroll
                for (int bj = 0; bj < 2; ++bj)
#pragma unroll
                    for (int n = 0; n < 2; ++n) asm volatile("" : "+v"(xv[mm][bj][n]));
#pragma unroll
            for (int mm = 0; mm < 2; ++mm) { const int m = mb + mm; const int row = row0 + ai * 128 + m * 16; float ssq = 0.f;
#pragma unroll
                for (int bj = 0; bj < 2; ++bj)
#pragma unroll
                    for (int n = 0; n < 2; ++n) { const f32x4 hv = xv[mm][bj][n] + acc[ai][bj][m][n];
                        ssq += hv[0] * hv[0] + hv[1] * hv[1] + hv[2] * hv[2] + hv[3] * hv[3];
                        u32x2 o; o.x = cvt_pk_bf16(hv[0], hv[1]); o.y = cvt_pk_bf16(hv[2], hv[3]); *(u32x2*)(hb + (size_t)row * 2048 + col0 + bj * 128 + n * 16) = o; }
                ssq += __shfl_xor(ssq, 16); ssq += __shfl_xor(ssq, 32); if (fq == 0) unsafeAtomicAdd(hss + row, ssq);
            }
        }
    }
};
struct OutOrder {
    int c;
    __device__ __forceinline__ bool next(int i, pg8::Unit& u) const {
        if (i == 0) { const int x = c & 7, j = c >> 3; u.pm = 4 * x + (j >> 3); u.pn = j & 7; u.k0 = 0; u.nk = 32; return true; }
        if (i == 1 && c < 64) { u.pm = 32; u.pn = c >> 3; u.k0 = (c & 7) * 4; u.nk = 4; return true; }
        return false;
    }
    __device__ __forceinline__ void a_ready(const pg8::Unit&) const {}
    __device__ __forceinline__ void done(const pg8::Unit&) const {}
};
struct GuDepOrder : pg8::StaticOrder {
    const unsigned* flag;
    __device__ __forceinline__ void a_ready(const pg8::Unit& u) const {
        if (u.pm == 32) {
            if (threadIdx.x < 64) { unsigned spins = 0;
                while ((unsigned)__builtin_amdgcn_readfirstlane(__hip_atomic_load(flag, __ATOMIC_RELAXED, __HIP_MEMORY_SCOPE_AGENT)) < 16u && ++spins < (1u << 20)) __builtin_amdgcn_s_sleep(2);
                __builtin_amdgcn_fence(__ATOMIC_ACQUIRE, "agent");
                asm volatile("s_waitcnt vmcnt(0)" ::: "memory"); }
            asm volatile("" ::: "memory"); __builtin_amdgcn_s_barrier(); asm volatile("" ::: "memory");
        }
    }
};
struct EpiGU {
    static constexpr bool PERM = true, AFTER_DRAIN = false;
    bf16_t* act; const float* hss;
    __device__ __forceinline__ void prefetch(const pg8::Unit& u, int wr, int fr, float (&pre)[8]) const {
#pragma unroll
        for (int q = 0; q < 8; ++q) pre[q] = hss[u.pm * 256 + wr * 64 + fr + (q >> 2) * 128 + (q & 3) * 16]; }
    __device__ __forceinline__ void operator()(const f32x4 (&acc)[2][2][4][2], const pg8::Unit& u, int wr, int wc, int fr, int fq, const float (&pre)[8]) const {
        const int row0 = u.pm * 256 + wr * 64 + fr, col0 = u.pn * 128 + wc * 32 + 8 * fq;
        float rs8[2][4];
#pragma unroll
        for (int ai = 0; ai < 2; ++ai)
#pragma unroll
            for (int m = 0; m < 4; ++m) rs8[ai][m] = rsqrtf(pre[ai * 4 + m] * (1.0f / 2048.0f) + EPS);
#pragma unroll
        for (int ai = 0; ai < 2; ++ai)
#pragma unroll
            for (int m = 0; m < 4; ++m) { const int row = row0 + ai * 128 + m * 16; const float rs = rs8[ai][m]; float v[8];
#pragma unroll
                for (int q = 0; q < 4; ++q) { const int n = q >> 1, j0 = (q & 1) * 2;
                    typedef float f32x2v __attribute__((ext_vector_type(2)));
                    f32x2v g, u; g.x = acc[ai][0][m][n][j0]; g.y = acc[ai][0][m][n][j0 + 1]; u.x = acc[ai][1][m][n][j0]; u.y = acc[ai][1][m][n][j0 + 1];
                    g = g * rs; u = u * rs;
                    const f32x2v a = g * (-1.44269504f);
                    f32x2v e; e.x = __builtin_amdgcn_exp2f(a.x); e.y = __builtin_amdgcn_exp2f(a.y);
                    const f32x2v d = e + 1.0f;
                    f32x2v r; r.x = __builtin_amdgcn_rcpf(d.x); r.y = __builtin_amdgcn_rcpf(d.y);
                    const f32x2v o = (g * u) * r;
                    v[n * 4 + j0] = o.x; v[n * 4 + j0 + 1] = o.y; }
                *(u32x4*)(act + (size_t)row * LD_DN + col0) = pack8(v); }
    }
};
struct EpiDown {
    static constexpr bool PERM = false, AFTER_DRAIN = false;
    bf16_t* hb; float* hdst; float* part;
    __device__ __forceinline__ void prefetch(const pg8::Unit&, int, int, float (&)[8]) const {}
    __device__ __forceinline__ void operator()(const f32x4 (&acc)[2][2][4][2], const pg8::Unit& u, int wr, int wc, int fr, int fq, const float (&pre)[8]) const {
        const int row0 = u.pm * 256 + wr * 64 + fr, col0 = u.pn * 256 + wc * 32 + 4 * fq;
        if (u.nk < 88) {
            float* pp = part + ((size_t)(u.k0 >> 3) * 128 + (wr * 64 + fr)) * 2048 + col0;
#pragma unroll
            for (int m = 0; m < 4; ++m)
#pragma unroll
                for (int bj = 0; bj < 2; ++bj)
#pragma unroll
                    for (int n = 0; n < 2; ++n) *(f32x4*)(pp + (size_t)m * 16 * 2048 + bj * 128 + n * 16) = acc[0][bj][m][n];
            return;
        }
#pragma unroll
        for (int ai = 0; ai < 2; ++ai) {
            u32x2 hv[4][2][2];
#pragma unroll
            for (int m = 0; m < 4; ++m) { const bf16_t* hr = hb + (size_t)(row0 + ai * 128 + m * 16) * 2048 + col0;
#pragma unroll
                for (int bj = 0; bj < 2; ++bj)
#pragma unroll
                    for (int n = 0; n < 2; ++n) hv[m][bj][n] = *(const u32x2*)(hr + bj * 128 + n * 16); }
#pragma unroll
            for (int m = 0; m < 4; ++m)
#pragma unroll
                for (int bj = 0; bj < 2; ++bj)
#pragma unroll
                    for (int n = 0; n < 2; ++n) asm volatile("" : "+v"(hv[m][bj][n]));
#pragma unroll
            for (int m = 0; m < 4; ++m) { bf16_t* hw = hb + (size_t)(row0 + ai * 128 + m * 16) * 2048 + col0;
#pragma unroll
                for (int bj = 0; bj < 2; ++bj)
#pragma unroll
                    for (int n = 0; n < 2; ++n) { const u32x2 q = hv[m][bj][n]; f32x4 hf; hf[0] = __uint_as_float(q.x << 16); hf[1] = __uint_as_float(q.x & 0xffff0000u); hf[2] = __uint_as_float(q.y << 16); hf[3] = __uint_as_float(q.y & 0xffff0000u);
                        const f32x4 o = hf + acc[ai][bj][m][n]; u32x2 ob; ob.x = cvt_pk_bf16(o[0], o[1]); ob.y = cvt_pk_bf16(o[2], o[3]); *(u32x2*)(hw + bj * 128 + n * 16) = ob; } }
        }
    }
};
struct DownOrder {
    int c;
    __device__ __forceinline__ bool next(int i, pg8::Unit& u) const {
        if (i == 0) { const int x = c & 7, j = c >> 3; u.pm = 4 * x + (j >> 3); u.pn = j & 7; u.k0 = 0; u.nk = 88; return true; }
        if (i == 1 && c < 88) { u.pm = 32; u.pn = c / 11; u.k0 = (c % 11) * 8; u.nk = 8; return true; }
        return false;
    }
    __device__ __forceinline__ void a_ready(const pg8::Unit&) const {}
    __device__ __forceinline__ void done(const pg8::Unit&) const {}
};

struct WTile { const float* W; bf16_t* dst; int N, ldt, k0, n0, drow0, gsel; };
__device__ __forceinline__ void wt_decode(const Params& p, int tt, WTile& w) {
    unsigned char* ws = p.ws; int kt, nt;
    if (tt < 1184) { kt = tt & 31; nt = tt >> 5; w.W = p.w_in; w.N = 4624; w.ldt = 2048; w.dst = (bf16_t*)(ws + OFF_WTIN); w.drow0 = nt * 128; w.gsel = 0; }
    else if (tt < 1696) { const int q = tt - 1184; kt = q & 31; nt = q >> 5; w.W = p.w_out; w.N = 2048; w.ldt = 2048; w.dst = (bf16_t*)(ws + OFF_WTOUT); w.drow0 = nt * 128; w.gsel = 1; }
    else if (tt < 3104) { const int q = tt - 1696; kt = q & 31; nt = q >> 5; w.W = p.w_gate; w.N = 5632; w.ldt = 2048; w.dst = (bf16_t*)(ws + OFF_WTGU); w.drow0 = 256 * nt; w.gsel = 2; }
    else if (tt < 4512) { const int q = tt - 3104; kt = q & 31; nt = q >> 5; w.W = p.w_up; w.N = 5632; w.ldt = 2048; w.dst = (bf16_t*)(ws + OFF_WTGU); w.drow0 = 256 * nt + 128; w.gsel = 2; }
    else { const int q = tt - 4512; kt = q % 88; nt = q / 88; w.W = p.w_down; w.N = 2048; w.ldt = LD_DN; w.dst = (bf16_t*)(ws + OFF_WTDN); w.drow0 = nt * 128; w.gsel = 3; }
    w.k0 = kt * 64; w.n0 = nt * 128;
}
__device__ __forceinline__ void wt_load(const Params& p, const WTile& w, int r, int c4, f32x4 (&v)[4], float (&gk)[4]) {
    const bool ok = w.n0 + c4 < w.N; const float* wp = w.W + (ok ? w.n0 + c4 : 0);
#pragma unroll
    for (int q = 0; q < 4; ++q) { const int k = w.k0 + r + 16 * q;
        gk[q] = w.gsel == 0 ? p.g_mix[k] : w.gsel == 1 ? (k < 1024 ? p.g_co[k] : p.g_sn[k - 1024]) : w.gsel == 2 ? p.g_ffn[k] : 1.0f; if (!ok) gk[q] = 0.f;
        v[q] = __builtin_nontemporal_load((const f32x4*)(wp + (size_t)k * w.N)); }
}
__device__ __forceinline__ void wt_convert(const Params& p, LAS unsigned char* lds, int t_begin, int t_end, int worker, int G) {
    const int tid = threadIdx.x;
    {
        LAS float* tile = (LAS float*)lds;
        const int r = tid >> 5, c4 = (tid & 31) * 4;
        WTile ta, tb; f32x4 va[4], vb[4]; float ga[4], gb[4];
        int t = t_begin + worker;
        bool ha = t < t_end, hb = t + G < t_end;
        if (ha) { wt_decode(p, t, ta); wt_load(p, ta, r, c4, va, ga); }
        if (hb) { wt_decode(p, t + G, tb); wt_load(p, tb, r, c4, vb, gb); }
        while (ha) {
            {
#pragma unroll
                for (int q = 0; q < 4; ++q) { LAS float* tp = tile + (r + 16 * q) * 129 + c4; tp[0] = va[q][0] * ga[q]; tp[1] = va[q][1] * ga[q]; tp[2] = va[q][2] * ga[q]; tp[3] = va[q][3] * ga[q]; }
                __syncthreads();
                bf16_t* cdst = ta.dst + (size_t)(ta.drow0 + (tid >> 2)) * ta.ldt + ta.k0 + (tid & 3) * 16;
                const int tn = t + 2 * G; ha = tn < t_end;
                if (ha) { wt_decode(p, tn, ta); wt_load(p, ta, r, c4, va, ga); }
                const int n = tid >> 2, kq = tid & 3; float o[16];
#pragma unroll
                for (int i = 0; i < 16; ++i) o[i] = tile[(kq * 16 + i) * 129 + n];
                *(u32x4*)cdst = pack8(o); *(u32x4*)(cdst + 8) = pack8(o + 8);
                __syncthreads();
            }
            if (hb) {
#pragma unroll
                for (int q = 0; q < 4; ++q) { LAS float* tp = tile + (r + 16 * q) * 129 + c4; tp[0] = vb[q][0] * gb[q]; tp[1] = vb[q][1] * gb[q]; tp[2] = vb[q][2] * gb[q]; tp[3] = vb[q][3] * gb[q]; }
                __syncthreads();
                bf16_t* cdst = tb.dst + (size_t)(tb.drow0 + (tid >> 2)) * tb.ldt + tb.k0 + (tid & 3) * 16;
                const int tn = t + 3 * G; hb = tn < t_end;
                if (hb) { wt_decode(p, tn, tb); wt_load(p, tb, r, c4, vb, gb); }
                const int n = tid >> 2, kq = tid & 3; float o[16];
#pragma unroll
                for (int i = 0; i < 16; ++i) o[i] = tile[(kq * 16 + i) * 129 + n];
                *(u32x4*)cdst = pack8(o); *(u32x4*)(cdst + 8) = pack8(o + 8);
                __syncthreads();
            }
            t += 2 * G;
        }
    }
}
__device__ __forceinline__ void phase_prep(const Params& p, LAS unsigned char* lds) {
    const int tid = threadIdx.x, lane = tid & 63, wv = tid >> 6, G = gridDim.x;
    unsigned char* ws = p.ws;
    float* ss = (float*)(ws + OFF_SS);
    for (int i = blockIdx.x * 512 + tid; i < 8448 * 7; i += G * 512) ss[8448 + i] = 0.f;
    if (blockIdx.x == 0 && tid < 128) ss[MROWS + tid] = 2048.f;
    bf16_t* XB = (bf16_t*)(ws + OFF_XB);
    {
        int row = blockIdx.x * 8 + wv; const int nw = G * 8;
        f32x4 xv[8], xn[8];
        if (row < MROWS) { const float* src = row < 8192 ? p.xp + (size_t)row * 2048 : p.xs + (size_t)(row - 8192) * 2048;
#pragma unroll
            for (int j = 0; j < 8; ++j) xv[j] = __builtin_nontemporal_load((const f32x4*)(src + j * 256 + lane * 4)); }
        while (row < MROWS) {
            const int rn = row + nw;
            if (rn < MROWS) { const float* src = rn < 8192 ? p.xp + (size_t)rn * 2048 : p.xs + (size_t)(rn - 8192) * 2048;
#pragma unroll
                for (int j = 0; j < 8; ++j) xn[j] = __builtin_nontemporal_load((const f32x4*)(src + j * 256 + lane * 4)); }
            float s = 0.f;
#pragma unroll
            for (int j = 0; j < 8; ++j) { const f32x4 v = xv[j]; s += v[0] * v[0] + v[1] * v[1] + v[2] * v[2] + v[3] * v[3];
                u32x2 o; o.x = cvt_pk_bf16(v[0], v[1]); o.y = cvt_pk_bf16(v[2], v[3]); *(u32x2*)(XB + (size_t)row * 2048 + j * 256 + lane * 4) = o; }
#pragma unroll
            for (int o = 32; o >= 1; o >>= 1) s += __shfl_xor(s, o);
            if (lane == 0) ss[row] = s;
#pragma unroll
            for (int j = 0; j < 8; ++j) xv[j] = xn[j];
            row = rn;
        }
    }
    wt_convert(p, lds, 0, 1184, (int)blockIdx.x, G);
    { u32x4* z = (u32x4*)(ws + OFF_WTIN + 4736ull * 2048 * 2); for (int i = blockIdx.x * 512 + tid; i < 32768; i += G * 512) z[i] = (u32x4){0u, 0u, 0u, 0u}; }
}

__device__ __forceinline__ void phase_conv(const Params& p, LAS unsigned char* lds) {
    const int tid = threadIdx.x, G = gridDim.x;
    unsigned char* ws = p.ws;
    const bf16_t* PROJ = (const bf16_t*)(ws + OFF_PROJ);
    bf16_t* XT = (bf16_t*)(ws + OFF_XT); bf16_t* BN = (bf16_t*)(ws + OFF_BN); bf16_t* BTT = (bf16_t*)(ws + OFF_BTT); bf16_t* CC = (bf16_t*)(ws + OFF_CC);
    for (int tsk = blockIdx.x * 512 + tid; tsk < 98304; tsk += G * 512) {
        const int cgi = tsk % 192, rest = tsk / 192, tt0 = (rest & 7) * 16, bc = rest >> 3;
        const int R0 = (bc >> 4) * 2048 + (bc & 15) * 128; const bool first = (bc & 15) == 0;
        const int ch0 = cgi * 8, kind = ch0 < 1024 ? 0 : (ch0 < 1280 ? 1 : 2);
        u32x4 in[19];
#pragma unroll
        for (int j = 0; j < 19; ++j) { const bool ok = !(first && tt0 - 3 + j < 0); const int rr = ok ? (R0 + tt0 - 3 + j) : R0;
            in[j] = *(const u32x4*)(PROJ + (size_t)rr * 4608 + 3072 + ch0); if (!ok) in[j] = (u32x4){0u, 0u, 0u, 0u}; }
        unsigned nat[16][4];
#pragma unroll
        for (int e2 = 0; e2 < 4; ++e2) {
            const int ea = 2 * e2, eb = 2 * e2 + 1; float oa[16], ob[16];
            typedef float f32x2v __attribute__((ext_vector_type(2)));
            const f32x2v q0 = *(const f32x2v*)(p.conv_w + ch0 + ea), q1 = *(const f32x2v*)(p.conv_w + 1536 + ch0 + ea), q2 = *(const f32x2v*)(p.conv_w + 3072 + ch0 + ea), q3 = *(const f32x2v*)(p.conv_w + 4608 + ch0 + ea), qb = *(const f32x2v*)(p.conv_b + ch0 + ea);
            const float w0a = q0.x, w1a = q1.x, w2a = q2.x, w3a = q3.x, cba = qb.x, w0b = q0.y, w1b = q1.y, w2b = q2.y, w3b = q3.y, cbb = qb.y;
#pragma unroll
            for (int t = 0; t < 16; ++t) {
                oa[t] = silu_f(cba + w0a * __uint_as_float(in[t][e2] << 16) + w1a * __uint_as_float(in[t + 1][e2] << 16) + w2a * __uint_as_float(in[t + 2][e2] << 16) + w3a * __uint_as_float(in[t + 3][e2] << 16));
                ob[t] = silu_f(cbb + w0b * __uint_as_float(in[t][e2] & 0xffff0000u) + w1b * __uint_as_float(in[t + 1][e2] & 0xffff0000u) + w2b * __uint_as_float(in[t + 2][e2] & 0xffff0000u) + w3b * __uint_as_float(in[t + 3][e2] & 0xffff0000u));
                nat[t][e2] = cvt_pk_bf16(oa[t], ob[t]); }
            if (kind <= 1) { bf16_t* tp = kind == 0 ? XT + ((size_t)(bc * 1024 + ch0 + ea) * 128 + tt0) : BTT + ((size_t)(bc * 256 + (ch0 - 1024) + ea) * 128 + tt0);
                *(u32x4*)tp = pack8(oa); *(u32x4*)(tp + 8) = pack8(oa + 8); *(u32x4*)(tp + 128) = pack8(ob); *(u32x4*)(tp + 136) = pack8(ob + 8); }
        }
        if (kind >= 1) { bf16_t* np = (kind == 1 ? BN + (ch0 - 1024) : CC + (ch0 - 1280)) + (size_t)(R0 + tt0) * 256;
#pragma unroll
            for (int t = 0; t < 16; ++t) { u32x4 o; o.x = nat[t][0]; o.y = nat[t][1]; o.z = nat[t][2]; o.w = nat[t][3]; *(u32x4*)(np + (size_t)t * 256) = o; } }
    }
    const float* DT = (const float*)(ws + OFF_DT); float* EAC = (float*)(ws + OFF_EAC); float* EAL = (float*)(ws + OFF_EAL);
    float* FA = (float*)(ws + OFF_FA); float* FD = (float*)(ws + OFF_FD); float* FW = (float*)(ws + OFF_FW);
    LAS float* ftot = (LAS float*)lds;
    const int lane = tid & 63, wv8 = tid >> 6;
    for (int s0 = blockIdx.x * 4; s0 < 1024; s0 += G * 4) {
        const int q = tid >> 7, t = tid & 127, seq = s0 + q, bc = seq >> 4, h = seq & 15, R0 = (bc >> 4) * 2048 + (bc & 15) * 128;
        const float dtv = softplus_f(DT[(size_t)(R0 + t) * 16 + h] + p.dt_bias[h]);
        float xa = dtv * (-expf(p.a_log[h]));
#pragma unroll
        for (int o = 1; o < 64; o <<= 1) { const float u = __shfl_up(xa, o); if (lane >= o) xa += u; }
        if (lane == 63) ftot[wv8] = xa;
        __syncthreads();
        if (wv8 & 1) xa += ftot[wv8 - 1];
        if (t == 127) ftot[8 + q] = xa;
        __syncthreads();
        const float a_last = ftot[8 + q];
        FA[seq * 128 + t] = xa; FD[seq * 128 + t] = dtv; FW[seq * 128 + t] = expf(a_last - xa) * dtv; EAC[(size_t)(R0 + t) * 16 + h] = expf(xa);
        if (t == 127) EAL[seq] = expf(a_last);
        __syncthreads();
    }
}

__device__ __forceinline__ void conv16(const Params& p, const bf16_t* PROJ, int R0, int t0, bool first, int ch, float (&o)[16]) {
    float in[19];
    const bf16_t* src = PROJ + (size_t)(R0 + t0) * 4608 + 3072 + ch;
#pragma unroll
    for (int j = 0; j < 19; ++j) { in[j] = 0.f; if (!(first && t0 - 3 + j < 0)) in[j] = bf2f(src[(ptrdiff_t)(j - 3) * 4608]); }
    const float w0 = p.conv_w[ch], w1 = p.conv_w[1536 + ch], w2 = p.conv_w[3072 + ch], w3 = p.conv_w[4608 + ch], cb = p.conv_b[ch];
#pragma unroll
    for (int t = 0; t < 16; ++t) o[t] = silu_f(cb + w0 * in[t] + w1 * in[t + 1] + w2 * in[t + 2] + w3 * in[t + 3]);
}

__device__ __forceinline__ void ssd_local(const Params& p, LAS unsigned char* lds, int b, int c, int h) {
    const int tid = threadIdx.x, lane = tid & 63, w = __builtin_amdgcn_readfirstlane(tid >> 6), g = h >> 3, fr = lane & 15, fq = lane >> 4;
    const int R0 = b * 2048 + c * 128, t0 = w * 16;
    unsigned char* ws = p.ws;
    const bf16_t* PROJ = (const bf16_t*)(ws + OFF_PROJ);
    const float* DT = (const float*)(ws + OFF_DT);
    float* EAC = (float*)(ws + OFF_EAC); float* EAL = (float*)(ws + OFF_EAL);
    LAS unsigned char* CcL = lds; LAS unsigned char* BcL = lds + 34816; LAS unsigned char* BTL = lds + 69632; LAS unsigned char* xTL = lds + 104448;
    LAS unsigned char* ML = lds + 121856;
    LAS float* fa = (LAS float*)(lds + 156672); LAS float* fd = fa + 128;
    {
        const int bc = b * 16 + c, seq = bc * 16 + h;
        const bf16_t* CC = (const bf16_t*)(ws + OFF_CC); const bf16_t* BN = (const bf16_t*)(ws + OFF_BN); const bf16_t* BTT = (const bf16_t*)(ws + OFF_BTT); const bf16_t* XT = (const bf16_t*)(ws + OFF_XT);
        if (tid < 128) { fa[tid] = ((const float*)(ws + OFF_FA))[seq * 128 + tid]; fd[tid] = ((const float*)(ws + OFF_FD))[seq * 128 + tid]; }
        const f32x4 fw0 = *(const f32x4*)((const float*)(ws + OFF_FW) + seq * 128 + (tid & 15) * 8), fw1 = *(const f32x4*)((const float*)(ws + OFF_FW) + seq * 128 + (tid & 15) * 8 + 4);
        u32x4 cv[4], bv[4], tv[4], xv[2];
#pragma unroll
        for (int i = 0; i < 4; ++i) { const int q = tid + 512 * i, row = q >> 4, c16 = q & 15;
            cv[i] = *(const u32x4*)(CC + (size_t)(R0 + row) * 256 + g * 128 + c16 * 8); bv[i] = *(const u32x4*)(BN + (size_t)(R0 + row) * 256 + g * 128 + c16 * 8);
            tv[i] = *(const u32x4*)(BTT + ((size_t)(bc * 256 + g * 128 + row) * 128 + c16 * 8)); }
#pragma unroll
        for (int i = 0; i < 2; ++i) { const int q = tid + 512 * i, row = q >> 4, c16 = q & 15; xv[i] = *(const u32x4*)(XT + ((size_t)(bc * 1024 + h * 64 + row) * 128 + c16 * 8)); }
#pragma unroll
        for (int i = 0; i < 4; ++i) { const int q = tid + 512 * i, row = q >> 4, c16 = q & 15; *(LAS u32x4*)(CcL + row * 272 + c16 * 16) = cv[i]; *(LAS u32x4*)(BcL + row * 272 + c16 * 16) = bv[i]; }
#pragma unroll
        for (int i = 0; i < 2; ++i) { const int q = tid + 512 * i, row = q >> 4, c16 = q & 15; *(LAS u32x4*)(xTL + row * 272 + c16 * 16) = xv[i]; }
#pragma unroll
        for (int i = 0; i < 4; ++i) { const int q = tid + 512 * i, row = q >> 4, c16 = q & 15; float f[8];
#pragma unroll
            for (int e = 0; e < 4; ++e) { const float wa = (2 * e < 4) ? fw0[(2 * e) & 3] : fw1[(2 * e) & 3], wb = (2 * e + 1 < 4) ? fw0[(2 * e + 1) & 3] : fw1[(2 * e + 1) & 3];
                f[2 * e] = __uint_as_float(tv[i][e] << 16) * wa; f[2 * e + 1] = __uint_as_float(tv[i][e] & 0xffff0000u) * wb; }
            *(LAS u32x4*)(BTL + row * 272 + c16 * 16) = pack8(f); }
        __syncthreads();
    }
    f32x4 cbt[8];
#pragma unroll
    for (int j = 0; j < 8; ++j) cbt[j] = (f32x4){0.f, 0.f, 0.f, 0.f};
#pragma unroll
    for (int ks = 0; ks < 4; ++ks) { const bf16x8 a = *(LAS bf16x8*)(CcL + (t0 + fr) * 272 + (ks * 32 + fq * 8) * 2);
#pragma unroll
        for (int j = 0; j < 8; ++j) if (j <= w) { const bf16x8 bb = *(LAS bf16x8*)(BcL + (j * 16 + fr) * 272 + (ks * 32 + fq * 8) * 2); cbt[j] = mfma16(a, bb, cbt[j]); } }
#pragma unroll
    for (int j = 0; j < 8; ++j) if (j <= (w | 1)) {
#pragma unroll
        for (int i = 0; i < 4; ++i) { const int t = t0 + fq * 4 + i, s = j * 16 + fr; float v = 0.f; if (j <= w && s <= t) v = cbt[j][i] * __expf(fa[t] - fa[s]) * fd[s];
            *(LAS bf16_t*)(ML + t * 272 + s * 2) = f2bf(v); } }
    const int nks = (w >> 1) + 1;
    f32x4 yd[4];
#pragma unroll
    for (int j = 0; j < 4; ++j) yd[j] = (f32x4){0.f, 0.f, 0.f, 0.f};
#pragma unroll
    for (int ks = 0; ks < 4; ++ks) if (ks < nks) { const bf16x8 a = *(LAS bf16x8*)(ML + (t0 + fr) * 272 + (ks * 32 + fq * 8) * 2);
#pragma unroll
        for (int pj = 0; pj < 4; ++pj) { const bf16x8 bb = *(LAS bf16x8*)(xTL + (pj * 16 + fr) * 272 + (ks * 32 + fq * 8) * 2); yd[pj] = mfma16(a, bb, yd[pj]); } }
    { float* YD = (float*)(ws + OFF_YD); const float Dh = p.dvec[h];
#pragma unroll
        for (int pj = 0; pj < 4; ++pj)
#pragma unroll
            for (int i = 0; i < 4; ++i) { const int t = t0 + fq * 4 + i, pc = pj * 16 + fr; const float xv = bf2f(*(LAS bf16_t*)(xTL + pc * 272 + t * 2));
                YD[(size_t)(R0 + t) * 1024 + h * 64 + pc] = yd[pj][i] + Dh * xv; } }
    f32x4 st[4];
#pragma unroll
    for (int j = 0; j < 4; ++j) st[j] = (f32x4){0.f, 0.f, 0.f, 0.f};
#pragma unroll
    for (int ks = 0; ks < 4; ++ks) { const bf16x8 bb = *(LAS bf16x8*)(BTL + (t0 + fr) * 272 + (ks * 32 + fq * 8) * 2);
#pragma unroll
        for (int pi = 0; pi < 4; ++pi) { const bf16x8 a = *(LAS bf16x8*)(xTL + (pi * 16 + fr) * 272 + (ks * 32 + fq * 8) * 2); st[pi] = mfma16(a, bb, st[pi]); } }
    { float* S = (float*)(ws + OFF_STATES) + (size_t)((b * 16 + c) * 16 + h) * 8192;
#pragma unroll
        for (int pi = 0; pi < 4; ++pi)
#pragma unroll
            for (int i = 0; i < 4; ++i) S[(pi * 16 + fq * 4 + i) * 128 + t0 + fr] = st[pi][i]; }
    __syncthreads();
}

__device__ __forceinline__ void ssd_group(const Params& p, LAS unsigned char* lds, int b, int c, int g) {
    const int tid = threadIdx.x, lane = tid & 63, w = __builtin_amdgcn_readfirstlane(tid >> 6), fr = lane & 15, fq = lane >> 4;
    const int R0 = b * 2048 + c * 128, t0 = w * 16, bc = b * 16 + c;
    unsigned char* ws = p.ws;
    const bf16_t* CC = (const bf16_t*)(ws + OFF_CC); const bf16_t* BN = (const bf16_t*)(ws + OFF_BN); const bf16_t* BTT = (const bf16_t*)(ws + OFF_BTT); const bf16_t* XT = (const bf16_t*)(ws + OFF_XT);
    const float* FA = (const float*)(ws + OFF_FA); const float* FD = (const float*)(ws + OFF_FD); const float* FW = (const float*)(ws + OFF_FW);
    LAS unsigned char* CcL = lds; LAS unsigned char* BcL = lds + 34816; LAS unsigned char* BTL = lds + 69632;
    LAS unsigned char* ML = lds;
    LAS float* faL = (LAS float*)(lds + 104448); LAS float* fdL = faL + 1024;
    {
        u32x4 cv[4], bv[4], tv[4];
#pragma unroll
        for (int i = 0; i < 4; ++i) { const int q = tid + 512 * i, row = q >> 4, c16 = q & 15;
            cv[i] = *(const u32x4*)(CC + (size_t)(R0 + row) * 256 + g * 128 + c16 * 8); bv[i] = *(const u32x4*)(BN + (size_t)(R0 + row) * 256 + g * 128 + c16 * 8);
            tv[i] = *(const u32x4*)(BTT + ((size_t)(bc * 256 + g * 128 + row) * 128 + c16 * 8)); }
        float fav[2], fdv[2];
#pragma unroll
        for (int k = 0; k < 2; ++k) { const int q = tid + 512 * k; fav[k] = FA[(size_t)(bc * 16 + g * 8) * 128 + q]; fdv[k] = FD[(size_t)(bc * 16 + g * 8) * 128 + q]; }
#pragma unroll
        for (int i = 0; i < 4; ++i) { const int q = tid + 512 * i, row = q >> 4, c16 = q & 15; *(LAS u32x4*)(CcL + row * 272 + c16 * 16) = cv[i]; *(LAS u32x4*)(BcL + row * 272 + c16 * 16) = bv[i]; *(LAS u32x4*)(BTL + row * 272 + c16 * 16) = tv[i]; }
#pragma unroll
        for (int k = 0; k < 2; ++k) { faL[tid + 512 * k] = fav[k]; fdL[tid + 512 * k] = fdv[k]; }
    }
    __syncthreads();
    f32x4 cbt[8];
#pragma unroll
    for (int j = 0; j < 8; ++j) cbt[j] = (f32x4){0.f, 0.f, 0.f, 0.f};
#pragma unroll
    for (int ks = 0; ks < 4; ++ks) { const bf16x8 a = *(LAS bf16x8*)(CcL + (t0 + fr) * 272 + (ks * 32 + fq * 8) * 2);
#pragma unroll
        for (int j = 0; j < 8; ++j) if (j <= w) { const bf16x8 bb = *(LAS bf16x8*)(BcL + (j * 16 + fr) * 272 + (ks * 32 + fq * 8) * 2); cbt[j] = mfma16(a, bb, cbt[j]); } }
    u32x4 xv[2]; f32x4 fw0, fw1;
    { const int seq = bc * 16 + g * 8;
#pragma unroll
        for (int i = 0; i < 2; ++i) { const int q = tid + 512 * i, row = q >> 4, c16 = q & 15; xv[i] = *(const u32x4*)(XT + ((size_t)(bc * 1024 + g * 512 + row) * 128 + c16 * 8)); }
        fw0 = *(const f32x4*)(FW + (size_t)seq * 128 + (tid & 15) * 8); fw1 = *(const f32x4*)(FW + (size_t)seq * 128 + (tid & 15) * 8 + 4); }
    __syncthreads();
    const int nks = (w >> 1) + 1;
    for (int hh = 0; hh < 8; ++hh) {
        const int h = g * 8 + hh;
        LAS float* fa = faL + hh * 128; LAS float* fd = fdL + hh * 128;
        LAS unsigned char* xTL = lds + ((hh & 1) ? 112640 : 34816); LAS unsigned char* xTsL = xTL + 17408;
#pragma unroll
        for (int i = 0; i < 2; ++i) { const int q = tid + 512 * i, row = q >> 4, c16 = q & 15; float f[8];
#pragma unroll
            for (int e = 0; e < 4; ++e) { const float wa = (2 * e < 4) ? fw0[(2 * e) & 3] : fw1[(2 * e) & 3], wb = (2 * e + 1 < 4) ? fw0[(2 * e + 1) & 3] : fw1[(2 * e + 1) & 3];
                f[2 * e] = __uint_as_float(xv[i][e] << 16) * wa; f[2 * e + 1] = __uint_as_float(xv[i][e] & 0xffff0000u) * wb; }
            *(LAS u32x4*)(xTL + row * 272 + c16 * 16) = xv[i]; *(LAS u32x4*)(xTsL + row * 272 + c16 * 16) = pack8(f); }
        if (hh < 7) { const int seq = bc * 16 + h + 1;
#pragma unroll
            for (int i = 0; i < 2; ++i) { const int q = tid + 512 * i, row = q >> 4, c16 = q & 15; xv[i] = *(const u32x4*)(XT + ((size_t)(bc * 1024 + (h + 1) * 64 + row) * 128 + c16 * 8)); }
            fw0 = *(const f32x4*)(FW + (size_t)seq * 128 + (tid & 15) * 8); fw1 = *(const f32x4*)(FW + (size_t)seq * 128 + (tid & 15) * 8 + 4); }
#pragma unroll
        for (int j = 0; j < 8; ++j) if (j <= (w | 1)) {
#pragma unroll
            for (int i = 0; i < 4; ++i) { const int t = t0 + fq * 4 + i, s = j * 16 + fr; float v = 0.f; if (j <= w && s <= t) v = cbt[j][i] * __expf(fa[t] - fa[s]) * fd[s];
                *(LAS bf16_t*)(ML + t * 272 + s * 2) = f2bf(v); } }
        __syncthreads();
        f32x4 yd[4];
#pragma unroll
        for (int j = 0; j < 4; ++j) yd[j] = (f32x4){0.f, 0.f, 0.f, 0.f};
#pragma unroll
        for (int ks = 0; ks < 4; ++ks) if (ks < nks) { const bf16x8 a = *(LAS bf16x8*)(ML + (t0 + fr) * 272 + (ks * 32 + fq * 8) * 2);
#pragma unroll
            for (int pj = 0; pj < 4; ++pj) { const bf16x8 bb = *(LAS bf16x8*)(xTL + (pj * 16 + fr) * 272 + (ks * 32 + fq * 8) * 2); yd[pj] = mfma16(a, bb, yd[pj]); } }
        { float* YD = (float*)(ws + OFF_YD); const float Dh = p.dvec[h];
#pragma unroll
            for (int pj = 0; pj < 4; ++pj)
#pragma unroll
                for (int i = 0; i < 4; ++i) { const int t = t0 + fq * 4 + i, pc = pj * 16 + fr; const float xx = bf2f(*(LAS bf16_t*)(xTL + pc * 272 + t * 2));
                    YD[(size_t)(R0 + t) * 1024 + h * 64 + pc] = yd[pj][i] + Dh * xx; } }
        f32x4 st[4];
#pragma unroll
        for (int j = 0; j < 4; ++j) st[j] = (f32x4){0.f, 0.f, 0.f, 0.f};
#pragma unroll
        for (int ks = 0; ks < 4; ++ks) { const bf16x8 bb = *(LAS bf16x8*)(BTL + (t0 + fr) * 272 + (ks * 32 + fq * 8) * 2);
#pragma unroll
            for (int pi = 0; pi < 4; ++pi) { const bf16x8 a = *(LAS bf16x8*)(xTsL + (pi * 16 + fr) * 272 + (ks * 32 + fq * 8) * 2); st[pi] = mfma16(a, bb, st[pi]); } }
        { float* S = (float*)(ws + OFF_STATES) + (size_t)(bc * 16 + h) * 8192;
#pragma unroll
            for (int pi = 0; pi < 4; ++pi)
#pragma unroll
                for (int i = 0; i < 4; ++i) S[(pi * 16 + fq * 4 + i) * 128 + t0 + fr] = st[pi][i]; }
    }
    __syncthreads();
}

__device__ __forceinline__ void chunk_mlp(const Params& p, LAS unsigned char* lds, int b, int c, int h, bool dry) {
    const int tid = threadIdx.x, lane = tid & 63, w = __builtin_amdgcn_readfirstlane(tid >> 6), fr = lane & 15, fq = lane >> 4;
    const int R0 = b * 2048 + c * 128, t0 = w * 16;
    unsigned char* ws = p.ws;
    const bf16_t* PROJ = (const bf16_t*)(ws + OFF_PROJ);
    float* ss = (float*)(ws + OFF_SS); const float* vss = ss + 8448; float* yss = (float*)(ws + (dry ? OFF_SS2 : OFF_SS)) + 2 * 8448;
    bf16_t* Y = (bf16_t*)(ws + OFF_XB);
    LAS unsigned char* gvT = lds;
    const int nks = (w >> 1) + 1, trow = t0 + fr;
    f32x4 wq[4][2];
#pragma unroll
    for (int ks = 0; ks < 4; ++ks) if (ks < nks) { const float* wp = p.w_s + (size_t)h * 16384 + trow * 128 + ks * 32 + fq * 8; wq[ks][0] = *(const f32x4*)wp; wq[ks][1] = *(const f32x4*)(wp + 4); }
    float uu[4][8], bias4[4];
#pragma unroll
    for (int i = 0; i < 4; ++i) { const int t = t0 + fq * 4 + i; bias4[i] = p.b_s[h * 128 + t];
#pragma unroll
        for (int dj = 0; dj < 8; ++dj) uu[i][dj] = bf2f(PROJ[(size_t)(R0 + t) * 4608 + h * 128 + dj * 16 + fr]); }
    if (tid < 256) { const int d0 = (tid & 15) * 8, tt0 = (tid >> 4) * 8;
        u32x4 in[8]; float rv[8];
#pragma unroll
        for (int j = 0; j < 8; ++j) { in[j] = *(const u32x4*)(PROJ + (size_t)(R0 + tt0 + j) * 4608 + 1024 + h * 128 + d0); rv[j] = vss[R0 + tt0 + j]; }
        f32x4 gq[2]; gq[0] = *(const f32x4*)(p.g_cv + h * 128 + d0); gq[1] = *(const f32x4*)(p.g_cv + h * 128 + d0 + 4);
#pragma unroll
        for (int j = 0; j < 8; ++j) rv[j] = rsqrtf(rv[j] * (1.0f / 1024.0f) + EPS);
#pragma unroll
        for (int e2 = 0; e2 < 4; ++e2) { const int ea = 2 * e2, eb = 2 * e2 + 1; const float ga = gq[ea >> 2][ea & 3], gb = gq[eb >> 2][eb & 3]; float oa[8], ob[8];
#pragma unroll
            for (int j = 0; j < 8; ++j) { oa[j] = __uint_as_float(in[j][e2] << 16) * rv[j] * ga; ob[j] = __uint_as_float(in[j][e2] & 0xffff0000u) * rv[j] * gb; }
            *(LAS u32x4*)(gvT + (d0 + ea) * 272 + tt0 * 2) = pack8(oa); *(LAS u32x4*)(gvT + (d0 + eb) * 272 + tt0 * 2) = pack8(ob); } }
    __syncthreads();
    f32x4 acc[8];
#pragma unroll
    for (int j = 0; j < 8; ++j) acc[j] = (f32x4){0.f, 0.f, 0.f, 0.f};
#pragma unroll
    for (int ks = 0; ks < 4; ++ks) if (ks < nks) { const int s0 = ks * 32 + fq * 8; float wv[8];
#pragma unroll
        for (int e = 0; e < 4; ++e) { wv[e] = (s0 + e <= trow) ? wq[ks][0][e] : 0.f; wv[4 + e] = (s0 + 4 + e <= trow) ? wq[ks][1][e] : 0.f; }
        const bf16x8 a = __builtin_bit_cast(bf16x8, pack8(wv));
#pragma unroll
        for (int dj = 0; dj < 8; ++dj) { const bf16x8 bb = *(LAS bf16x8*)(gvT + (dj * 16 + fr) * 272 + s0 * 2); acc[dj] = mfma16(a, bb, acc[dj]); } }
#pragma unroll
    for (int i = 0; i < 4; ++i) { const int t = t0 + fq * 4 + i; const float bias = bias4[i]; float ssq = 0.f;
#pragma unroll
        for (int dj = 0; dj < 8; ++dj) { const int d = dj * 16 + fr; const float v = uu[i][dj] * (acc[dj][i] + bias);
            ssq += v * v; Y[(size_t)(R0 + t) * 2048 + h * 128 + d] = f2bf(v); }
        ssq += __shfl_xor(ssq, 1); ssq += __shfl_xor(ssq, 2); ssq += __shfl_xor(ssq, 4); ssq += __shfl_xor(ssq, 8);
        if (fr == 0) unsafeAtomicAdd(yss + (size_t)(R0 + t) * 4, ssq); }
    __syncthreads();
}

__device__ __forceinline__ void sample_item(const Params& p, LAS unsigned char* lds, int b, int g, bool dry) {
    const int tid = threadIdx.x, lane = tid & 63, w = __builtin_amdgcn_readfirstlane(tid >> 6), h = g * 8 + w, row = 8192 + b;
    unsigned char* ws = p.ws;
    const bf16_t* PROJ = (const bf16_t*)(ws + OFF_PROJ);
    const float* DT = (const float*)(ws + OFF_DT);
    float* ss = (float*)(ws + OFF_SS); const float* vss = ss + 8448; float* yss = (float*)(ws + (dry ? OFF_SS2 : OFF_SS)) + 2 * 8448;
    bf16_t* Y = (bf16_t*)(ws + OFF_XB);
    LAS float* wl = (LAS float*)(lds + w * 2048);
    const float* sc = p.sconv + (size_t)b * 3 * 1536; float* ocs = p.out + O_CONVS + (size_t)b * 3 * 1536;
    int chs[5]; chs[0] = h * 64 + lane; chs[1] = 1024 + g * 128 + lane; chs[2] = 1024 + g * 128 + 64 + lane; chs[3] = 1280 + g * 128 + lane; chs[4] = 1280 + g * 128 + 64 + lane;
    float s0[5], s1[5], s2[5], xn[5], cv[5];
#pragma unroll
    for (int k = 0; k < 5; ++k) { const int ch = chs[k]; xn[k] = bf2f(PROJ[(size_t)row * 4608 + 3072 + ch]); s0[k] = sc[ch]; s1[k] = sc[1536 + ch]; s2[k] = sc[3072 + ch];
        cv[k] = p.conv_b[ch] + p.conv_w[ch] * s0[k] + p.conv_w[1536 + ch] * s1[k] + p.conv_w[3072 + ch] * s2[k] + p.conv_w[4608 + ch] * xn[k]; }
#pragma unroll
    for (int k = 0; k < 5; ++k) { cv[k] = silu_f(cv[k]); if (k == 0 || w == 0) { const int ch = chs[k]; ocs[ch] = s1[k]; ocs[1536 + ch] = s2[k]; ocs[3072 + ch] = xn[k]; } }
    const float xv = cv[0], B0 = cv[1], B1 = cv[2], C0 = cv[3], C1 = cv[4];
    const float dt = softplus_f(DT[(size_t)row * 16 + h] + p.dt_bias[h]); const float dA = expf(-expf(p.a_log[h]) * dt);
    wl[lane] = B0; wl[64 + lane] = B1; wl[128 + lane] = C0; wl[192 + lane] = C1; wl[256 + lane] = xv * dt; wl[320 + lane] = xv;
    const int nn = (lane & 31) * 4, ph = lane >> 5;
    const f32x4 B4 = *(LAS f32x4*)(wl + nn), C4 = *(LAS f32x4*)(wl + 128 + nn);
    const float* h0 = p.sssm + (size_t)(b * 16 + h) * 8192; float* hn = p.out + O_SSMS + (size_t)(b * 16 + h) * 8192;
    {
        f32x4 hv[2][8];
#pragma unroll
        for (int k = 0; k < 8; ++k) hv[0][k] = __builtin_nontemporal_load((const f32x4*)(h0 + (k * 2 + ph) * 128 + nn));
#pragma unroll
        for (int bt = 0; bt < 4; ++bt) {
            if (bt < 3) {
#pragma unroll
                for (int k = 0; k < 8; ++k) hv[(bt + 1) & 1][k] = __builtin_nontemporal_load((const f32x4*)(h0 + (((bt + 1) * 8 + k) * 2 + ph) * 128 + nn));
            }
            float pv[8];
#pragma unroll
            for (int k = 0; k < 8; ++k) { const int pp = ((bt * 8 + k) * 2) + ph; const float xd = wl[256 + pp];
                const f32x4 r = hv[bt & 1][k] * dA + B4 * xd; *(f32x4*)(hn + pp * 128 + nn) = r;
                pv[k] = r[0] * C4[0] + r[1] * C4[1] + r[2] * C4[2] + r[3] * C4[3]; }
#pragma unroll
            for (int i = 0; i < 4; ++i) { const bool hi = (lane & 16) != 0; const float send = hi ? pv[i] : pv[i + 4], keep = hi ? pv[i + 4] : pv[i]; pv[i] = keep + __shfl_xor(send, 16); }
#pragma unroll
            for (int i = 0; i < 2; ++i) { const bool hi = (lane & 8) != 0; const float send = hi ? pv[i] : pv[i + 2], keep = hi ? pv[i + 2] : pv[i]; pv[i] = keep + __shfl_xor(send, 8); }
            { const bool hi = (lane & 4) != 0; const float send = hi ? pv[0] : pv[1], keep = hi ? pv[1] : pv[0]; pv[0] = keep + __shfl_xor(send, 4); }
            pv[0] += __shfl_xor(pv[0], 2); pv[0] += __shfl_xor(pv[0], 1);
            if ((lane & 3) == 0) { const int kk = ((lane >> 4) & 1) * 4 + ((lane >> 3) & 1) * 2 + ((lane >> 2) & 1); wl[384 + ((bt * 8 + kk) * 2) + ph] = pv[0]; }
        }
    }
    float y = wl[384 + lane] + p.dvec[h] * xv;
    y *= bf2f(PROJ[(size_t)row * 4608 + 2048 + h * 64 + lane]);
    float ssq = y * y;
#pragma unroll
    for (int o = 32; o >= 1; o >>= 1) ssq += __shfl_xor(ssq, o);
    if (lane == 0) unsafeAtomicAdd(yss + (size_t)row * 4 + 1 + g, ssq);
    Y[(size_t)row * 2048 + 1024 + h * 64 + lane] = f2bf(y);
    { const int cidx = g * 512 + tid, hh = cidx >> 7; const float gv = bf2f(PROJ[(size_t)row * 4608 + 1024 + cidx]); const float rs = rsqrtf(vss[row] * (1.0f / 1024.0f) + EPS);
        const float vrow = gv * rs * p.g_cv[cidx]; p.out[O_VS + (size_t)b * 1024 + cidx] = vrow;
        const float mixed = p.w_s[(size_t)hh * 16384] * vrow + p.b_s[hh * 128]; const float ya = bf2f(PROJ[(size_t)row * 4608 + cidx]) * mixed;
        Y[(size_t)row * 2048 + cidx] = f2bf(ya); float s2 = ya * ya;
#pragma unroll
        for (int o = 32; o >= 1; o >>= 1) s2 += __shfl_xor(s2, o);
        if (lane == 0) unsafeAtomicAdd(yss + (size_t)row * 4, s2); }
    __syncthreads();
}

__device__ __forceinline__ void phase_mixer(const Params& p, LAS unsigned char* lds, bool dry) {
#ifndef PROBE_SSD
#define PROBE_SSD 0
#define PROBE_CHUNK 0
#define PROBE_SAMPLE 0
#endif
    const int G = gridDim.x, bx = blockIdx.x, half = G >> 1;
    if (bx < half) {
        for (int it = bx; it < 128; it += half) ssd_group(p, lds, it >> 5, (it >> 1) & 15, it & 1);
        for (int j = bx; j < 128; j += half) chunk_mlp(p, lds, j >> 7, (j >> 3) & 15, j & 7, dry);
    } else {
        const int k = bx - half, nk2 = G - half;
        for (int j = k; j < 256; j += nk2) sample_item(p, lds, j >> 1, j & 1, dry);
        for (int j = 128 + k; j < 512; j += nk2) chunk_mlp(p, lds, j >> 7, (j >> 3) & 15, j & 7, dry);
    }
    if (blockIdx.x < 4) { const int b = blockIdx.x; const bf16_t* PROJ = (const bf16_t*)(p.ws + OFF_PROJ);
        for (int i = threadIdx.x; i < 4608; i += 512) { const int k = i / 1536, ch = i - k * 1536;
            p.out[O_CONVP + (size_t)(b * 3 + k) * 1536 + ch] = bf2f(PROJ[(size_t)(b * 2048 + 2045 + k) * 4608 + 3072 + ch]); } }
}

__device__ __forceinline__ void phase_scan(const Params& p, bool dry) {
    const float* STATES = (const float*)(p.ws + OFF_STATES); const float* EAL = (const float*)(p.ws + OFF_EAL); bf16_t* HPREV = (bf16_t*)(p.ws + OFF_HPREV);
    for (int i = blockIdx.x * 512 + threadIdx.x; i < 131072; i += gridDim.x * 512) {
        const int b = i >> 15, e = (i & 32767) * 4, h = e >> 13;
        f32x4 run = (f32x4){0.f, 0.f, 0.f, 0.f}; f32x4 stv[16]; float ealv[16];
#pragma unroll
        for (int c = 0; c < 16; ++c) { stv[c] = *(const f32x4*)(STATES + (size_t)(b * 16 + c) * 131072 + e); ealv[c] = EAL[(b * 16 + c) * 16 + h]; }
#pragma unroll
        for (int c = 0; c < 16; ++c) { u32x2 o; o.x = cvt_pk_bf16(run[0], run[1]); o.y = cvt_pk_bf16(run[2], run[3]); *(u32x2*)(HPREV + (size_t)(b * 16 + c) * 131072 + e) = o;
            run = run * ealv[c] + stv[c]; }
        *(f32x4*)(p.out + O_SSMP + (size_t)b * 131072 + e) = run;
    }
    if (!dry) {
        const float* yss = (const float*)(p.ws + OFF_SS) + 2 * 8448; bf16_t* Y = (bf16_t*)(p.ws + OFF_XB);
        for (int i = blockIdx.x * 512 + threadIdx.x; i < 128 * 256; i += gridDim.x * 512) { const int row = 8192 + (i >> 8), c8 = (i & 255) * 8, seg = c8 < 1024 ? 0 : (c8 < 1536 ? 1 : 2);
            const float rs = rsqrtf(yss[(size_t)row * 4 + seg] * (seg ? (1.0f / 512.0f) : (1.0f / 1024.0f)) + EPS);
            const u32x4 v = *(const u32x4*)(Y + (size_t)row * 2048 + c8); float f[8];
#pragma unroll
            for (int e = 0; e < 4; ++e) { f[2 * e] = __uint_as_float(v[e] << 16) * rs; f[2 * e + 1] = __uint_as_float(v[e] & 0xffff0000u) * rs; }
            *(u32x4*)(Y + (size_t)row * 2048 + c8) = pack8(f); }
    }
}

__device__ __forceinline__ void phase_combine(const Params& p, LAS unsigned char* lds, bool dry) {
    const int tid = threadIdx.x, lane = tid & 63, w = tid >> 6, fr = lane & 15, fq = lane >> 4;
    unsigned char* ws = p.ws;
    const bf16_t* PROJ = (const bf16_t*)(ws + OFF_PROJ); const bf16_t* CC = (const bf16_t*)(ws + OFF_CC); const bf16_t* HPREV = (const bf16_t*)(ws + OFF_HPREV);
    const float* YD = (const float*)(ws + OFF_YD); const float* EAC = (const float*)(ws + OFF_EAC);
    const float* yss = (const float*)(ws + OFF_SS) + 2 * 8448; bf16_t* Y = (bf16_t*)(ws + OFF_XB);
    LAS float* part = (LAS float*)lds;
    for (int it = blockIdx.x; it < 512; it += gridDim.x) {
        const int b = it >> 7, c = (it >> 3) & 15, g = (it >> 2) & 1, rb = it & 3, h = g * 8 + w, Rb = b * 2048 + c * 128 + rb * 32;
        u32x4 ya[4]; float rsa[4];
#pragma unroll
        for (int k = 0; k < 4; ++k) { const int q = tid + 512 * k, row = Rb + (q >> 6), c8 = (q & 63) * 8;
            ya[k] = *(const u32x4*)(Y + (size_t)row * 2048 + g * 512 + c8); rsa[k] = yss[(size_t)row * 4]; }
        f32x4 acc[2][4];
#pragma unroll
        for (int u = 0; u < 2; ++u)
#pragma unroll
            for (int j = 0; j < 4; ++j) acc[u][j] = (f32x4){0.f, 0.f, 0.f, 0.f};
        const bf16_t* ccp = CC + (size_t)(Rb + fr) * 256 + g * 128 + fq * 8;
        const bf16_t* hp = HPREV + (size_t)((b * 16 + c) * 16 + h) * 8192 + fr * 128 + fq * 8;
#pragma unroll
        for (int ks = 0; ks < 4; ++ks) { const bf16x8 a0 = *(const bf16x8*)(ccp + ks * 32), a1 = *(const bf16x8*)(ccp + 16 * 256 + ks * 32);
#pragma unroll
            for (int pj = 0; pj < 4; ++pj) { const bf16x8 bb = *(const bf16x8*)(hp + pj * 2048 + ks * 32); acc[0][pj] = mfma16(a0, bb, acc[0][pj]); acc[1][pj] = mfma16(a1, bb, acc[1][pj]); } }
        float yv[2][4][4], zv[2][4][4], ea[2][4];
#pragma unroll
        for (int u = 0; u < 2; ++u)
#pragma unroll
            for (int i = 0; i < 4; ++i) { const int r = Rb + u * 16 + fq * 4 + i; ea[u][i] = EAC[(size_t)r * 16 + h];
#pragma unroll
                for (int pj = 0; pj < 4; ++pj) { const int pc = pj * 16 + fr; yv[u][i][pj] = YD[(size_t)r * 1024 + h * 64 + pc]; zv[u][i][pj] = bf2f(PROJ[(size_t)r * 4608 + 2048 + h * 64 + pc]); } }
#pragma unroll
        for (int u = 0; u < 2; ++u)
#pragma unroll
            for (int i = 0; i < 4; ++i) { float ssq = 0.f;
#pragma unroll
                for (int pj = 0; pj < 4; ++pj) { const float y = (yv[u][i][pj] + ea[u][i] * acc[u][pj][i]) * zv[u][i][pj]; yv[u][i][pj] = y; ssq += y * y; }
                ssq += __shfl_xor(ssq, 1); ssq += __shfl_xor(ssq, 2); ssq += __shfl_xor(ssq, 4); ssq += __shfl_xor(ssq, 8);
                if (fr == 0) part[(u * 8 + w) * 16 + fq * 4 + i] = ssq; }
        if (!dry) {
#pragma unroll
            for (int k = 0; k < 4; ++k) { const int q = tid + 512 * k, row = Rb + (q >> 6), c8 = (q & 63) * 8; float f[8]; const float rs = rsqrtf(rsa[k] * (1.0f / 1024.0f) + EPS);
#pragma unroll
                for (int e = 0; e < 4; ++e) { f[2 * e] = __uint_as_float(ya[k][e] << 16) * rs; f[2 * e + 1] = __uint_as_float(ya[k][e] & 0xffff0000u) * rs; }
                *(u32x4*)(Y + (size_t)row * 2048 + g * 512 + c8) = pack8(f); } }
        __syncthreads();
#pragma unroll
        for (int u = 0; u < 2; ++u)
#pragma unroll
            for (int i = 0; i < 4; ++i) { float tot = 0.f;
#pragma unroll
                for (int hh = 0; hh < 8; ++hh) tot += part[(u * 8 + hh) * 16 + fq * 4 + i];
                const float rs = rsqrtf(tot * (1.0f / 512.0f) + EPS); const int r = Rb + u * 16 + fq * 4 + i;
#pragma unroll
                for (int pj = 0; pj < 4; ++pj) Y[(size_t)r * 2048 + 1024 + h * 64 + pj * 16 + fr] = f2bf(yv[u][i][pj] * rs); }
        __syncthreads();
    }
}

__device__ __forceinline__ void phase_ynorm(const Params& p, bool dry) {
    const float* yss = (const float*)(p.ws + OFF_SS) + 2 * 8448; bf16_t* Y = (bf16_t*)(p.ws + OFF_XB); bf16_t* Yd = dry ? (bf16_t*)(p.ws + OFF_ACT) : Y;
    const int total = MROWS * 256, stride = gridDim.x * 512;
    for (int base = blockIdx.x * 512 + threadIdx.x; base < total; base += 4 * stride) {
        u32x4 v[4]; float rs[4];
#pragma unroll
        for (int j = 0; j < 4; ++j) { const int i = min(base + j * stride, total - 1); const int row = i >> 8, c8 = (i & 255) * 8, seg = c8 < 1024 ? 0 : (c8 < 1536 ? 1 : 2);
            v[j] = *(const u32x4*)(Y + (size_t)row * 2048 + c8); rs[j] = rsqrtf(yss[(size_t)row * 4 + seg] * (seg ? (1.0f / 512.0f) : (1.0f / 1024.0f)) + EPS); }
#pragma unroll
        for (int j = 0; j < 4; ++j) { const int i = base + j * stride; if (i < total) { const int row = i >> 8, c8 = (i & 255) * 8; float f[8];
            f[0] = bf2f(v[j].x & 0xffffu); f[1] = bf2f(v[j].x >> 16); f[2] = bf2f(v[j].y & 0xffffu); f[3] = bf2f(v[j].y >> 16); f[4] = bf2f(v[j].z & 0xffffu); f[5] = bf2f(v[j].z >> 16); f[6] = bf2f(v[j].w & 0xffffu); f[7] = bf2f(v[j].w >> 16);
#pragma unroll
            for (int e = 0; e < 8; ++e) f[e] *= rs[j];
            *(u32x4*)(Yd + (size_t)row * 2048 + c8) = pack8(f); } }
    }
}
__device__ __forceinline__ void phase_final(const Params& p, LAS unsigned char* lds, bool dry) {
    float* dst = dry ? (float*)(p.ws + OFF_WTIN) : p.out;
    const int tid = threadIdx.x, lane = tid & 63, wv = tid >> 6, G = gridDim.x;
    f32x4 gf[8];
#pragma unroll
    for (int j = 0; j < 8; ++j) gf[j] = *(const f32x4*)(p.g_fin + j * 256 + lane * 4);
    {
        const bf16_t* hb = (const bf16_t*)(p.ws + OFF_HB);
        const int nw = G * 8; int row = blockIdx.x * 8 + wv;
        u32x2 v[8], vn[8];
        if (row < 8192) {
#pragma unroll
            for (int j = 0; j < 8; ++j) v[j] = *(const u32x2*)(hb + (size_t)row * 2048 + j * 256 + lane * 4); }
        while (row < 8192) {
            const int rn = row + nw;
            if (rn < 8192) {
#pragma unroll
                for (int j = 0; j < 8; ++j) vn[j] = *(const u32x2*)(hb + (size_t)rn * 2048 + j * 256 + lane * 4); }
            float s = 0.f; f32x4 f[8];
#pragma unroll
            for (int j = 0; j < 8; ++j) { f[j][0] = __uint_as_float(v[j].x << 16); f[j][1] = __uint_as_float(v[j].x & 0xffff0000u); f[j][2] = __uint_as_float(v[j].y << 16); f[j][3] = __uint_as_float(v[j].y & 0xffff0000u);
                s += f[j][0] * f[j][0] + f[j][1] * f[j][1] + f[j][2] * f[j][2] + f[j][3] * f[j][3]; }
#pragma unroll
            for (int o = 32; o >= 1; o >>= 1) s += __shfl_xor(s, o);
            const float rs = rsqrtf(s * (1.0f / 2048.0f) + EPS);
#pragma unroll
            for (int j = 0; j < 8; ++j) *(f32x4*)(dst + (size_t)row * 2048 + j * 256 + lane * 4) = f[j] * rs * gf[j];
#pragma unroll
            for (int j = 0; j < 8; ++j) v[j] = vn[j];
            row = rn;
        }
    }
    LAS float* red = (LAS float*)lds;
    for (int i = blockIdx.x; i < 128; i += G) { const float* part = (const float*)(p.ws + OFF_PARTD);
        f32x4 v = *(const f32x4*)(p.out + (size_t)(8192 + i) * 2048 + tid * 4);
#pragma unroll
        for (int sg = 0; sg < 11; ++sg) v += *(const f32x4*)(part + ((size_t)sg * 128 + i) * 2048 + tid * 4);
        float s = v[0] * v[0] + v[1] * v[1] + v[2] * v[2] + v[3] * v[3];
#pragma unroll
        for (int o = 32; o >= 1; o >>= 1) s += __shfl_xor(s, o);
        if (lane == 0) red[wv] = s;
        __syncthreads();
        float tot = 0.f;
#pragma unroll
        for (int k = 0; k < 8; ++k) tot += red[k];
        const float rs = rsqrtf(tot * (1.0f / 2048.0f) + EPS);
        const f32x4 g4 = *(const f32x4*)(p.g_fin + tid * 4);
        *(f32x4*)(dst + (size_t)(8192 + i) * 2048 + tid * 4) = v * rs * g4;
        __syncthreads();
    }
}

__device__ __forceinline__ void phase_hfix(const Params& p, bool dry) {
    const int lane = threadIdx.x & 63, wv = threadIdx.x >> 6, i = blockIdx.x * 8 + wv;
    if (i < 128) { const int row = 8192 + i; bf16_t* hb = (bf16_t*)(p.ws + OFF_HB); float* hss = (float*)(p.ws + (dry ? OFF_SS2 : OFF_SS)) + 6 * 8448; const float* part = (const float*)(p.ws + OFF_PARTO); float s = 0.f;
        f32x4 hv[8];
#pragma unroll
        for (int j = 0; j < 8; ++j) { hv[j] = *(const f32x4*)(p.xs + (size_t)i * 2048 + j * 256 + lane * 4);
#pragma unroll
            for (int sg = 0; sg < 8; ++sg) hv[j] += *(const f32x4*)(part + ((size_t)sg * 128 + i) * 2048 + j * 256 + lane * 4); }
#pragma unroll
        for (int j = 0; j < 8; ++j) { const f32x4 v = hv[j]; s += v[0] * v[0] + v[1] * v[1] + v[2] * v[2] + v[3] * v[3];
            *(f32x4*)(p.out + (size_t)row * 2048 + j * 256 + lane * 4) = v;
            u32x2 o; o.x = cvt_pk_bf16(v[0], v[1]); o.y = cvt_pk_bf16(v[2], v[3]); *(u32x2*)(hb + (size_t)row * 2048 + j * 256 + lane * 4) = o; }
#pragma unroll
        for (int o = 32; o >= 1; o >>= 1) s += __shfl_xor(s, o);
        if (lane == 0) hss[row] = s; }
}

#define XB_TMO      128
#define XB_XCNT(j)  (256  + 64 * (j))
#define XB_XSUB(j)  (1280 + 64 * (j))
#define XB_XGEN(j)  (2304 + 64 * (j))
#define XB_TOP      3328
#define XB_TOPGEN   3392
#define XCD_BAR_WORDS 3456
#define XB_SPIN_CAP (1u << 18)

__device__ __forceinline__ unsigned xb_ld(unsigned* p)              { return __hip_atomic_load(p, __ATOMIC_RELAXED, __HIP_MEMORY_SCOPE_AGENT); }
__device__ __forceinline__ unsigned xb_add(unsigned* p, unsigned v) { return __hip_atomic_fetch_add(p, v, __ATOMIC_RELAXED, __HIP_MEMORY_SCOPE_AGENT); }
__device__ __forceinline__ unsigned xb_xcc_id() { return (unsigned)__builtin_amdgcn_s_getreg((3 << 11) | 20) & 0xFu; }
#define XB_SPIN(cond, bar) do { unsigned _sp = 0; while (cond) { __builtin_amdgcn_s_sleep(1); \
    if ((++_sp & 255u) == 0u) { if (xb_ld(&(bar)[XB_TMO])) break; if (_sp > XB_SPIN_CAP) { atomicAdd(&(bar)[XB_TMO], 1u); break; } } } } while (0)

struct XcdBarrier {
    unsigned* bar; unsigned x;
    volatile __attribute__((address_space(3))) unsigned* st;
};

__device__ __forceinline__ XcdBarrier xcd_barrier_post(unsigned* bar, volatile __attribute__((address_space(3))) unsigned* st) {
    XcdBarrier b; b.bar = bar; b.x = xb_xcc_id(); b.st = st;
    if (threadIdx.x == 0) (void)xb_add(&bar[XB_XCNT(b.x)], 1u);
    return b;
}
__device__ __forceinline__ void xcd_barrier_complete(unsigned* bar, unsigned x, unsigned& nloc, unsigned& nx) {
    const unsigned G = gridDim.x * gridDim.y * gridDim.z;
    unsigned sum, cnt, mine, sp = 0u;
    for (;;) {
        sum = 0u; cnt = 0u; mine = 0u;
#pragma unroll
        for (unsigned j = 0; j < 16; ++j) { const unsigned c = xb_ld(&bar[XB_XCNT(j)]); sum += c; cnt += (c > 0u) ? 1u : 0u; mine = (j == x) ? c : mine; }
        if (sum == G) break;
        __builtin_amdgcn_s_sleep(1);
        if ((++sp & 255u) == 0u) { if (xb_ld(&bar[XB_TMO])) break; if (sp > XB_SPIN_CAP) { atomicAdd(&bar[XB_TMO], 1u); break; } }
    }
    nloc = mine > 0u ? mine : 1u; nx = cnt > 0u ? cnt : 1u;
}

__device__ __forceinline__ void xcd_barrier(const XcdBarrier& b) {
    asm volatile("s_waitcnt vmcnt(0)" ::: "memory");
    __syncthreads();
    if (threadIdx.x == 0) {
        unsigned* bar = b.bar;
        __builtin_amdgcn_s_waitcnt(0);
        unsigned nloc = b.st[0], nx = b.st[1];
        if (nloc == 0u) { xcd_barrier_complete(bar, b.x, nloc, nx); b.st[0] = nloc; b.st[1] = nx; }
        const unsigned old = xb_add(&bar[XB_XSUB(b.x)], 1u);
        const unsigned gen = old / nloc;
        if (old + 1u == (gen + 1u) * nloc) {
            __builtin_amdgcn_fence(__ATOMIC_RELEASE, "agent");
            asm volatile("s_waitcnt vmcnt(0)" ::: "memory");
            const unsigned og = xb_add(&bar[XB_TOP], 1u);
            const unsigned tg = og / nx;
            if (og + 1u == (tg + 1u) * nx) xb_add(&bar[XB_TOPGEN], 1u);
            else XB_SPIN(xb_ld(&bar[XB_TOPGEN]) == tg, bar);
            __builtin_amdgcn_fence(__ATOMIC_ACQUIRE, "agent");
            xb_add(&bar[XB_XGEN(b.x)], 1u);
            asm volatile("s_waitcnt vmcnt(0)" ::: "memory");
        } else {
            XB_SPIN(xb_ld(&bar[XB_XGEN(b.x)]) == gen, bar);
            __builtin_amdgcn_fence(__ATOMIC_ACQUIRE, "agent");
            asm volatile("s_waitcnt vmcnt(0)" ::: "memory");
        }
    }
    __syncthreads();
}

__global__ void __launch_bounds__(512, 2) mega(Params p) {
    extern __shared__ __attribute__((aligned(16))) unsigned char lds_raw[];
    LAS unsigned char* lds = (LAS unsigned char*)lds_raw;
    unsigned char* ws = p.ws; float* ss = (float*)(ws + OFF_SS);
    volatile LAS unsigned* bst = (volatile LAS unsigned*)(lds + LDS_BAR_OFF);
    if (threadIdx.x < 4) bst[threadIdx.x] = 0u;
    __syncthreads();
    if (p.ph_hi > 1000) cg::this_grid().sync();
    const XcdBarrier bar = xcd_barrier_post((unsigned*)(ws + OFF_CTL), bst);
#ifndef PHMASK
#define PHMASK 0x3ff
#endif
#define PH_ON(k) ((PHMASK >> (k)) & 1) && p.ph_lo <= (k) && (k) < p.ph_hi
#define PH_SYNC(k) if (p.ph_lo <= (k) && (k) + 1 < p.ph_hi) xcd_barrier(bar);
#ifdef REPMASK
#define REPLOOP(k) for (int rep = ((REPMASK >> (k)) & 1) ? ((p.repmask >> (k)) & 1) : 0; rep >= 0; --rep)
#else
#define REPLOOP(k) for (int rep = 0; rep >= 0; --rep)
#endif
#define REPBAR if (rep) xcd_barrier(bar);
    if (PH_ON(0)) REPLOOP(0) { phase_prep(p, lds); REPBAR }
    PH_SYNC(0)
    if (PH_ON(1)) REPLOOP(1) { pg8::Gemm g; g.A = (const bf16_t*)(ws + OFF_XB); g.Bt = (const bf16_t*)(ws + OFF_WTIN); g.M = MPAD; g.N = 4864; g.K = 2048; g.ld = 2048;
        pg8::StaticOrder S; S.init(MPAD, 4864, (int)gridDim.x, (int)blockIdx.x, 2048);
        EpiProj E; E.proj = (bf16_t*)(ws + OFF_PROJ); E.dt = (float*)(ws + OFF_DT); E.xss = ss; E.vss = (float*)(ws + (rep ? OFF_SS2 : OFF_SS)) + 8448;
        pg8::gemm_phase<EpiProj, pg8::StaticOrder, false>(lds, g, S, E, nullptr);
        if (!rep && blockIdx.x >= 115) wt_convert(p, lds, 1184, 4512, (int)blockIdx.x - 115, (int)gridDim.x - 115);
        REPBAR }
    PH_SYNC(1)
    if (PH_ON(2)) REPLOOP(2) { phase_conv(p, lds); xcd_barrier(bar); phase_mixer(p, lds, rep != 0); REPBAR }
    PH_SYNC(2)
    if (PH_ON(3)) REPLOOP(3) { phase_scan(p, rep != 0); REPBAR }
    PH_SYNC(3)
    if (PH_ON(4)) REPLOOP(4) { phase_combine(p, lds, rep != 0); REPBAR }
    PH_SYNC(4)
    if (PH_ON(6)) REPLOOP(6) { pg8::Gemm g; g.A = (const bf16_t*)(ws + OFF_XB); g.Bt = (const bf16_t*)(ws + OFF_WTOUT); g.M = MPAD; g.N = 2048; g.K = 2048; g.ld = 2048;
        OutOrder S; S.c = (int)blockIdx.x;
        EpiOut E; E.xp = p.xp; E.xs = p.xs; E.hout = p.out; E.hb = (bf16_t*)(ws + OFF_HB); E.part = (float*)(ws + OFF_PARTO); E.hss = (float*)(ws + (rep ? OFF_SS2 : OFF_SS)) + 6 * 8448;
        pg8::gemm_phase<EpiOut, OutOrder, false>(lds, g, S, E, nullptr); REPBAR }
    PH_SYNC(6)
    if (PH_ON(7)) REPLOOP(7) { pg8::Gemm g; g.A = (const bf16_t*)(ws + OFF_HB); g.Bt = (const bf16_t*)(ws + OFF_WTGU); g.M = MPAD; g.N = 11264; g.K = 2048; g.ld = 2048;
        unsigned* hflag = (unsigned*)(ws + OFF_CTL + 15360);
        if (blockIdx.x < 16) { phase_hfix(p, false); __threadfence(); __syncthreads(); if (threadIdx.x == 0) __hip_atomic_fetch_add(hflag, 1u, __ATOMIC_RELAXED, __HIP_MEMORY_SCOPE_AGENT); }
        GuDepOrder S; S.init(MPAD, 11264, (int)gridDim.x, (int)blockIdx.x, 2048); S.flag = hflag;
        EpiGU E; E.act = (bf16_t*)(ws + OFF_ACT); E.hss = ss + 6 * 8448;
        pg8::gemm_phase<EpiGU, GuDepOrder, false>(lds, g, S, E, nullptr);
        if (!rep && blockIdx.x >= 172) wt_convert(p, lds, 4512, 5920, (int)blockIdx.x - 172, (int)gridDim.x - 172);
        REPBAR }
    PH_SYNC(7)
    if (PH_ON(8)) REPLOOP(8) { pg8::Gemm g; g.A = (const bf16_t*)(ws + OFF_ACT); g.Bt = (const bf16_t*)(ws + OFF_WTDN); g.M = MPAD; g.N = 2048; g.K = 5632; g.ld = LD_DN;
        DownOrder S; S.c = (int)blockIdx.x;
        EpiDown E; E.hb = (bf16_t*)(ws + OFF_HB); E.hdst = rep ? (float*)(ws + OFF_WTIN) : p.out; E.part = (float*)(ws + OFF_PARTD);
        pg8::gemm_phase<EpiDown, DownOrder, false>(lds, g, S, E, nullptr); REPBAR }
    PH_SYNC(8)
    if (PH_ON(9)) REPLOOP(9) { phase_final(p, lds, rep != 0); REPBAR }
}

#ifndef N_LAUNCHES
#define N_LAUNCHES 1
#endif
extern "C" void kernel_launch(void* const* d_in, const int* in_sizes, int n_in, void* d_out, int out_size, void* d_ws, size_t ws_size, hipStream_t stream) {
    static int grid = 0;
    if (grid == 0) {
        if (n_in != 22 || ws_size < WS_NEED) { fprintf(stderr, "kernel_launch: bad inputs n_in %d ws %zu need %zu\n", n_in, ws_size, (size_t)WS_NEED); grid = -1; return; }
        int dev = 0, cus = 0, per_cu = 0;
        (void)hipGetDevice(&dev); (void)hipDeviceGetAttribute(&cus, hipDeviceAttributeMultiprocessorCount, dev);
        if (hipFuncSetAttribute((const void*)mega, hipFuncAttributeMaxDynamicSharedMemorySize, LDS_BYTES) != hipSuccess) { fprintf(stderr, "kernel_launch: hipFuncSetAttribute failed\n"); grid = -1; return; }
        if (hipOccupancyMaxActiveBlocksPerMultiprocessor(&per_cu, (const void*)mega, 512, LDS_BYTES) != hipSuccess || per_cu < 1) { fprintf(stderr, "kernel_launch: occupancy query says %d\n", per_cu); per_cu = 1; }
        (void)hipGetLastError();
        grid = cus > 0 ? cus : 256;
    }
    if (grid < 0) return;
    if (hipMemsetAsync((char*)d_ws + OFF_CTL, 0, 16384, stream) != hipSuccess) { fprintf(stderr, "kernel_launch: memset failed\n"); return; }
    Params p{};
    const float** pin = (const float**)&p;
    for (int i = 0; i < 22; ++i) pin[i] = (const float*)d_in[i];
    p.out = (float*)d_out; p.ws = (unsigned char*)d_ws;
#ifdef REPMASK
    p.repmask = REPMASK;
#endif
#if N_LAUNCHES == 1
    p.ph_lo = 0; p.ph_hi = NPHASE;
    void* args[] = {&p};
    hipError_t e = hipLaunchCooperativeKernel((const void*)mega, dim3(grid), dim3(512), args, LDS_BYTES, stream);
    if (e != hipSuccess) fprintf(stderr, "cooperative launch failed: %s (grid %d)\n", hipGetErrorString(e), grid);
#else
    for (int ph = 0; ph < NPHASE; ++ph) { p.ph_lo = ph; p.ph_hi = ph + 1; hipLaunchKernelGGL(mega, dim3(grid), dim3(512), LDS_BYTES, stream, p); }
#endif
}
```
